# Optimizing an MI355X kernel written in HIP

```python
import math
import jax
import jax.numpy as jnp
from jax import lax
import numpy as np

D_MODEL = 2048
BATCH = 4
SEQ = 4096
DEPTH = 4

CTX_LEN = 256
GRID_W = 64
HEAD_DIM = 128
N_DIFF_HEADS = D_MODEL // (2 * HEAD_DIM)
N_SUB_HEADS = 2 * N_DIFF_HEADS
V_HEAD_DIM = 2 * HEAD_DIM
ATT_W = N_DIFF_HEADS * V_HEAD_DIM
HY_W = D_MODEL
OFF_K = ATT_W
OFF_V = 2 * ATT_W
OFF_HY = 3 * ATT_W
OFF_G = 3 * ATT_W + 3 * HY_W
IN_COLS = OFF_G + 2 * D_MODEL
ROPE_BASE = 10000.0
ROT_FREQS = HEAD_DIM // 4
Q_BLOCK = 128
HY_EMB = 33
HY_BANDS = (HY_EMB - 1) // 2
HY_FH = 64
HY_N_FILT = 2
HY_TARGET = 1e-2
HY_FAST_PCT = 0.3
HY_SLOW_PCT = 1.5
HY_FILTER_OUT_STD = 0.005
D_FF = 5632
N_EXPERTS = 8
TOP_K = 2
N_DENSE = (DEPTH + 1) // 2
N_MOE = DEPTH // 2
EPS = 1e-6

kernel_name = "hybrid_diffattn_hyena_moe_dit"


def rmsnorm(x, g):
    xf = x.astype(jnp.float32)
    y = xf * lax.rsqrt(jnp.mean(xf * xf, axis=-1, keepdims=True) + EPS)
    return (y * g.astype(jnp.float32)).astype(x.dtype)


def modulate(h, shift, scale):
    return h * (1 + scale) + shift


def adaln_params(cvec, w, b):
    return jnp.split(jax.nn.silu(cvec) @ w + b, 6, axis=-1)


def axial_rope_tables(rows):
    row = jnp.repeat(jnp.arange(rows), GRID_W).astype(jnp.float32)
    col = jnp.tile(jnp.arange(GRID_W), rows).astype(jnp.float32)
    inv = ROPE_BASE ** (-jnp.arange(ROT_FREQS, dtype=jnp.float32) / ROT_FREQS)
    ang = jnp.stack([row[:, None] * inv, col[:, None] * inv], axis=1)
    return jnp.cos(ang), jnp.sin(ang)


def rope2d(x, cos, sin):
    xs = x.reshape(x.shape[:-1] + (2, 2, ROT_FREQS)).astype(jnp.float32)
    a, b = xs[..., 0, :], xs[..., 1, :]
    c = cos[None, :, None]
    s = sin[None, :, None]
    out = jnp.stack([a * c - b * s, a * s + b * c], axis=-2)
    return out.reshape(x.shape).astype(x.dtype)


def diff_attend(q, k, v, lam):
    s = jnp.einsum('bqhd,bkhd->bhqk', q, k, preferred_element_type=jnp.float32) / math.sqrt(HEAD_DIM)
    p = jax.nn.softmax(s, axis=-1)
    bsz, _, nq, nk = p.shape
    p = p.reshape(bsz, N_DIFF_HEADS, 2, nq, nk)
    a = p[:, :, 0] - lam * p[:, :, 1]
    return jnp.einsum('bhqk,bkhd->bqhd', a.astype(v.dtype), v)


def latent_diff_attention(q, k_all, v_all, lam):
    bsz, s = q.shape[:2]
    qb = q.reshape(bsz, s // Q_BLOCK, Q_BLOCK, N_SUB_HEADS, HEAD_DIM).swapaxes(0, 1)
    out = lax.map(lambda qi: diff_attend(qi, k_all, v_all, lam), qb)
    return out.swapaxes(0, 1).reshape(bsz, s, N_DIFF_HEADS, V_HEAD_DIM)


def diff_head_out(o, g, lam_init):
    o = rmsnorm(o, g) * (1.0 - lam_init)
    return o.reshape(o.shape[:2] + (ATT_W,))


def short_conv3(u, w, b):
    up = jnp.pad(u, ((0, 0), (1, 1), (0, 0)))
    return up[:, :-2] * w[0] + up[:, 1:-1] * w[1] + up[:, 2:] * w[2] + b


def hyena_filters(L, w1, b1, w2, b2, w3, b3, w4, freq):
    t = jnp.linspace(0.0, 1.0, L, dtype=jnp.float32)[:, None]
    w = 2.0 * math.pi * jnp.arange(L, dtype=jnp.float32)[:, None] / L
    f = jnp.linspace(1e-4, HY_BANDS - 1, HY_BANDS, dtype=jnp.float32)
    z = jnp.concatenate([t, jnp.cos(w * f), -jnp.sin(w * f)], axis=-1)
    hid = jnp.sin(freq * (z @ w1 + b1))
    hid = jnp.sin(freq * (hid @ w2 + b2))
    hid = jnp.sin(freq * (hid @ w3 + b3))
    h = (hid @ w4).reshape(L, HY_N_FILT, 2, HY_W)
    deltas = jnp.abs(jnp.linspace(math.log(HY_TARGET) / HY_SLOW_PCT,
                                  math.log(HY_TARGET) / HY_FAST_PCT, HY_W, dtype=jnp.float32))
    decay = jnp.exp(-t * deltas)
    return h * decay[:, None, None, :]


def bidir_long_conv(u, h_fwd, h_bwd):
    L = u.shape[1]
    k = jnp.concatenate([h_fwd, jnp.zeros_like(h_fwd[:1]), h_bwd[:0:-1]], axis=0)
    kf = jnp.fft.rfft(k.astype(jnp.float32), n=2 * L, axis=0)
    uf = jnp.fft.rfft(u.astype(jnp.float32), n=2 * L, axis=1)
    y = jnp.fft.irfft(uf * kf[None], n=2 * L, axis=1)[:, :L]
    return y.astype(u.dtype)


def hyena_mix(u, conv_w, conv_b, w1, b1, w2, b2, w3, b3, w4, freq, bias_d):
    u = short_conv3(u, conv_w, conv_b)
    v, x1, x2 = jnp.split(u, 3, axis=-1)
    h = hyena_filters(u.shape[1], w1, b1, w2, b2, w3, b3, w4, freq)
    z = x1 * (bidir_long_conv(v, h[:, 0, 0], h[:, 0, 1]) + bias_d[0] * v)
    return x2 * (bidir_long_conv(z, h[:, 1, 0], h[:, 1, 1]) + bias_d[1] * z)


def merge_branches(ya, yb, gate_logits, b_gate, w_br_a, w_br_b, w_out):
    g = jax.nn.sigmoid(gate_logits + b_gate)
    ga, gb = jnp.split(g, 2, axis=-1)
    return (ga * (ya @ w_br_a) + gb * (yb @ w_br_b)) @ w_out


def swiglu(t, w1, w3, w2):
    return (jax.nn.silu(t @ w1) * (t @ w3)) @ w2


def moe_swiglu(t, router, w1, w3, w2):
    logits = (t @ router).astype(jnp.float32)
    top_v, top_i = lax.top_k(logits, TOP_K)
    wts = jax.nn.softmax(top_v, axis=-1)
    combine = jnp.einsum('nk,nke->ne', wts, jax.nn.one_hot(top_i, N_EXPERTS, dtype=jnp.float32)).astype(t.dtype)
    y = jnp.zeros_like(t)
    for e in range(N_EXPERTS):
        y = y + combine[:, e:e + 1] * swiglu(t, w1[e], w3[e], w2[e])
    return y


def channel_mixer(l, t, ffn_w1, ffn_w3, ffn_w2, router, moe_w1, moe_w3, moe_w2):
    i = l // 2
    if l % 2 == 0:
        return swiglu(t, ffn_w1[i], ffn_w3[i], ffn_w2[i])
    return moe_swiglu(t, router[i], moe_w1[i], moe_w3[i], moe_w2[i])


def setup_inputs(seed: int = 0) -> dict:
    key = jax.random.key(seed)
    ks = iter(jax.random.split(key, 48))
    D = D_MODEL

    def nrm(shape, scale):
        return jax.random.normal(next(ks), shape, jnp.float32) * scale

    def gain(shape):
        return 1.0 + nrm(shape, 0.02)

    return {
        'x': nrm((BATCH, SEQ, D), 1.0),
        'c': nrm((BATCH, D), 1.0),
        'ctx': nrm((BATCH, CTX_LEN, D), 1.0),
        'c_ctx': nrm((D,), 1.0),
        'w_ada': nrm((DEPTH, D, 6 * D), D ** -0.5),
        'b_ada': nrm((DEPTH, 6 * D), 0.02),
        'norm1': gain((DEPTH, D)),
        'norm2': gain((DEPTH, D)),
        'w_in': nrm((DEPTH, D, IN_COLS), D ** -0.5),
        'b_gate': nrm((DEPTH, 2 * D), 0.02),
        'q_norm': gain((DEPTH, HEAD_DIM)),
        'k_norm': gain((DEPTH, HEAD_DIM)),
        'lam_q1': nrm((DEPTH, HEAD_DIM), 0.1),
        'lam_k1': nrm((DEPTH, HEAD_DIM), 0.1),
        'lam_q2': nrm((DEPTH, HEAD_DIM), 0.1),
        'lam_k2': nrm((DEPTH, HEAD_DIM), 0.1),
        'sub_norm': gain((DEPTH, V_HEAD_DIM)),
        'hy_conv_w': nrm((DEPTH, 3, 3 * HY_W), 3 ** -0.5),
        'hy_conv_b': nrm((DEPTH, 3 * HY_W), 0.02),
        'hy_w1': nrm((DEPTH, HY_EMB, HY_FH), HY_EMB ** -0.5),
        'hy_b1': nrm((DEPTH, HY_FH), 0.02),
        'hy_w2': nrm((DEPTH, HY_FH, HY_FH), HY_FH ** -0.5),
        'hy_b2': nrm((DEPTH, HY_FH), 0.02),
        'hy_w3': nrm((DEPTH, HY_FH, HY_FH), HY_FH ** -0.5),
        'hy_b3': nrm((DEPTH, HY_FH), 0.02),
        'hy_w4': nrm((DEPTH, HY_FH, HY_N_FILT * 2 * HY_W), HY_FILTER_OUT_STD),
        'hy_freq': gain((DEPTH, HY_FH)),
        'hy_bias': nrm((DEPTH, HY_N_FILT, HY_W), 0.5),
        'w_br_a': nrm((DEPTH, ATT_W, D), ATT_W ** -0.5),
        'w_br_b': nrm((DEPTH, HY_W, D), HY_W ** -0.5),
        'w_out': nrm((DEPTH, D, D), D ** -0.5),
        'ffn_w1': nrm((N_DENSE, D, D_FF), D ** -0.5),
        'ffn_w3': nrm((N_DENSE, D, D_FF), D ** -0.5),
        'ffn_w2': nrm((N_DENSE, D_FF, D), D_FF ** -0.5),
        'router': nrm((N_MOE, D, N_EXPERTS), D ** -0.5),
        'moe_w1': nrm((N_MOE, N_EXPERTS, D, D_FF), D ** -0.5),
        'moe_w3': nrm((N_MOE, N_EXPERTS, D, D_FF), D ** -0.5),
        'moe_w2': nrm((N_MOE, N_EXPERTS, D_FF, D), D_FF ** -0.5),
    }


def reference(x, c, ctx, c_ctx, w_ada, b_ada, norm1, norm2, w_in, b_gate, q_norm, k_norm,
              lam_q1, lam_k1, lam_q2, lam_k2, sub_norm, hy_conv_w, hy_conv_b,
              hy_w1, hy_b1, hy_w2, hy_b2, hy_w3, hy_b3, hy_w4, hy_freq, hy_bias,
              w_br_a, w_br_b, w_out, ffn_w1, ffn_w3, ffn_w2, router, moe_w1, moe_w3, moe_w2):
    B, S, D = x.shape
    Lc = ctx.shape[1]
    rows = S // GRID_W
    cos, sin = axial_rope_tables(rows)
    xl, xc = x, ctx
    for l in range(DEPTH):
        last = l == DEPTH - 1
        lam_init = 0.8 - 0.6 * math.exp(-0.3 * l)
        lam = (jnp.exp(jnp.sum(lam_q1[l].astype(jnp.float32) * lam_k1[l].astype(jnp.float32)))
               - jnp.exp(jnp.sum(lam_q2[l].astype(jnp.float32) * lam_k2[l].astype(jnp.float32)))
               + lam_init)
        sh1, sc1, g1, sh2, sc2, g2 = adaln_params(c, w_ada[l], b_ada[l])
        sh1c, sc1c, g1c, sh2c, sc2c, g2c = adaln_params(c_ctx, w_ada[l], b_ada[l])
        hl = modulate(rmsnorm(xl, norm1[l]), sh1[:, None], sc1[:, None])
        hc = modulate(rmsnorm(xc, norm1[l]), sh1c, sc1c)
        w_l = w_in[l]
        pl = hl @ w_l
        base = OFF_K if last else 0
        pc = hc @ (w_l[:, OFF_K:OFF_HY] if last else w_l)
        kc = rmsnorm(pc[..., OFF_K - base:OFF_V - base].reshape(B, Lc, N_SUB_HEADS, HEAD_DIM), k_norm[l])
        vc = pc[..., OFF_V - base:OFF_HY - base].reshape(B, Lc, N_DIFF_HEADS, V_HEAD_DIM)
        q = rope2d(rmsnorm(pl[..., :OFF_K].reshape(B, S, N_SUB_HEADS, HEAD_DIM), q_norm[l]), cos, sin)
        k = rope2d(rmsnorm(pl[..., OFF_K:OFF_V].reshape(B, S, N_SUB_HEADS, HEAD_DIM), k_norm[l]), cos, sin)
        v = pl[..., OFF_V:OFF_HY].reshape(B, S, N_DIFF_HEADS, V_HEAD_DIM)
        ya = latent_diff_attention(q, jnp.concatenate([kc, k], axis=1), jnp.concatenate([vc, v], axis=1), lam)
        hp = (hy_conv_w[l], hy_conv_b[l], hy_w1[l], hy_b1[l], hy_w2[l], hy_b2[l], hy_w3[l], hy_b3[l],
              hy_w4[l], hy_freq[l], hy_bias[l])
        yb = hyena_mix(pl[..., OFF_HY:OFF_G], *hp)
        out = merge_branches(diff_head_out(ya, sub_norm[l], lam_init), yb, pl[..., OFF_G:],
                             b_gate[l], w_br_a[l], w_br_b[l], w_out[l])
        xl = xl + g1[:, None] * out
        h2l = modulate(rmsnorm(xl, norm2[l]), sh2[:, None], sc2[:, None]).reshape(B * S, D)
        if last:
            f = channel_mixer(l, h2l, ffn_w1, ffn_w3, ffn_w2, router, moe_w1, moe_w3, moe_w2)
            xl = xl + g2[:, None] * f.reshape(B, S, D)
        else:
            qc = rmsnorm(pc[..., :OFF_K].reshape(B, Lc, N_SUB_HEADS, HEAD_DIM), q_norm[l])
            yac = diff_attend(qc, kc, vc, lam)
            ybc = hyena_mix(pc[..., OFF_HY:OFF_G], *hp)
            outc = merge_branches(diff_head_out(yac, sub_norm[l], lam_init), ybc, pc[..., OFF_G:],
                                  b_gate[l], w_br_a[l], w_br_b[l], w_out[l])
            xc = xc + g1c * outc
            h2c = modulate(rmsnorm(xc, norm2[l]), sh2c, sc2c).reshape(B * Lc, D)
            f = channel_mixer(l, jnp.concatenate([h2l, h2c], axis=0),
                              ffn_w1, ffn_w3, ffn_w2, router, moe_w1, moe_w3, moe_w2)
            xl = xl + g2[:, None] * f[:B * S].reshape(B, S, D)
            xc = xc + g2c * f[B * S:].reshape(B, Lc, D)
    return xl
```

```cpp
#include <hip/hip_runtime.h>
#include <cstdio>
#include <cstdint>

#ifndef PROBE
#define PROBE 0
#endif
#ifndef MK_ONE_LAUNCH
#define MK_ONE_LAUNCH 1
#endif

#define LAS __attribute__((address_space(3)))
typedef unsigned short bf16_t;
typedef short bf16x8 __attribute__((ext_vector_type(8)));
typedef short s16x4 __attribute__((ext_vector_type(4)));
typedef float f32x2 __attribute__((ext_vector_type(2)));
typedef float f32x4 __attribute__((ext_vector_type(4)));
typedef float f32x16 __attribute__((ext_vector_type(16)));
typedef unsigned u32x2 __attribute__((ext_vector_type(2)));
typedef unsigned u32x4 __attribute__((ext_vector_type(4)));

constexpr int DM = 2048, NB = 4, SEQ = 4096, LC = 256, ML = NB * SEQ, MC = NB * LC, MT = ML + MC;
constexpr int DEPTH = 4, NIN = 16384, DFF = 5632, NEXP = 8, CAP = MT, SKV = SEQ + LC;
constexpr int NQKVG = 10240;
constexpr int HYW = 6144;
constexpr int MAXSLOT = 36864;
constexpr float EPS = 1e-6f;
constexpr int NWAVES = 8, NTHR = 512;

constexpr size_t MiB = 1u << 20;
constexpr size_t WS_CTL = 0;
constexpr size_t WS_MOD = 1 * MiB;
constexpr size_t WS_LAM = 2 * MiB;
constexpr size_t WS_ROPE = 2 * MiB + 4096;
constexpr size_t WS_HID = 3 * MiB;
constexpr size_t WS_HIDC = WS_HID + 4 * MiB;
constexpr size_t WS_TOK = 8 * MiB;
constexpr size_t WS_RC = 9 * MiB;
constexpr size_t WS_R = 41 * MiB;
constexpr size_t WS_X = 313 * MiB;
constexpr size_t WS_WIN = 449 * MiB;
constexpr size_t WS_WBRA = WS_WIN + 256 * MiB;
constexpr size_t WS_WBRB = WS_WBRA + 32 * MiB;
constexpr size_t WS_WOUT = WS_WBRB + 32 * MiB;
constexpr size_t WS_WUP = WS_WOUT + 32 * MiB;
constexpr size_t WS_WDN = WS_WUP + 18 * 44 * MiB;
constexpr size_t WS_AR = WS_WDN + 18 * 22 * MiB;
constexpr size_t AR_H = WS_AR, AR_Q = WS_AR + 68 * MiB, AR_KRAW = WS_AR + 136 * MiB, AR_KC = WS_AR + 204 * MiB, AR_VC = WS_AR + 272 * MiB;
constexpr size_t AR_UT = WS_AR + 340 * MiB, AR_UT2 = WS_AR + 544 * MiB, AR_GATE = WS_AR + 748 * MiB, AR_O = WS_AR + 884 * MiB, AR_YBT = WS_AR + 1156 * MiB;
constexpr size_t AR_YAN = AR_KRAW, AR_YB = AR_KC, AR_M = AR_VC;
constexpr size_t AR_ACT = WS_AR + 68 * MiB, AR_YS = WS_AR + 464 * MiB, AR_H2S = WS_AR + 680 * MiB;
constexpr size_t AR_YSC = WS_AR + 1224 * MiB;
constexpr size_t WS_END = WS_AR + 1256 * MiB;
static_assert(WS_AR == 1989 * MiB, "map");
constexpr int CW_BAR = 4096;
constexpr int CW_CNT = 16384;

constexpr int LDS_EPI = 131072;
constexpr int LDS_TAB = 143360;
constexpr int LDS_ROPE = 147456;
constexpr int LDS_BYTES = 163840;

__device__ __forceinline__ unsigned cvt_pk_bf16(float lo, float hi) { unsigned r; asm volatile("v_cvt_pk_bf16_f32 %0, %1, %2" : "=v"(r) : "v"(lo), "v"(hi)); return r; }
__device__ __forceinline__ float bf_lo(unsigned w) { return __uint_as_float(w << 16); }
__device__ __forceinline__ float bf_hi(unsigned w) { return __uint_as_float(w & 0xffff0000u); }
__device__ __forceinline__ float bf2f(bf16_t b) { return __uint_as_float(((unsigned)b) << 16); }
__device__ __forceinline__ float shx(float v, int k, int lane) { return __int_as_float(__builtin_amdgcn_ds_bpermute((lane ^ k) << 2, __float_as_int(v))); }
__device__ __forceinline__ float wave_sum(float v, int lane) {
#pragma unroll
    for (int o = 1; o < 64; o <<= 1) v += shx(v, o, lane);
    return v;
}
__device__ __forceinline__ int opaque(int v) { asm volatile("" : "+v"(v)); return v; }
__device__ __forceinline__ int lane_id() { int r; asm volatile("v_mbcnt_lo_u32_b32 %0, -1, 0\n\tv_mbcnt_hi_u32_b32 %0, -1, %0" : "=v"(r)); return r; }
__device__ __forceinline__ int hw_tid(int wave) { return opaque(wave * 64 + lane_id()); }
#define LDS_WAIT() asm volatile("s_waitcnt lgkmcnt(0)" ::: "memory")
#define VM_WAIT() asm volatile("s_waitcnt vmcnt(0)" ::: "memory")

#define XB_TMO      128
#define XB_XCNT(j)  (256  + 64 * (j))
#define XB_XSUB(j)  (1280 + 64 * (j))
#define XB_XGEN(j)  (2304 + 64 * (j))
#define XB_TOP      3328
#define XB_TOPGEN   3392
#define XCD_BAR_WORDS 3456
#define XB_SPIN_CAP (1u << 18)
__device__ __forceinline__ unsigned xb_ld(unsigned* p)              { return __hip_atomic_load(p, __ATOMIC_RELAXED, __HIP_MEMORY_SCOPE_AGENT); }
__device__ __forceinline__ unsigned xb_add(unsigned* p, unsigned v) { return __hip_atomic_fetch_add(p, v, __ATOMIC_RELAXED, __HIP_MEMORY_SCOPE_AGENT); }
__device__ __forceinline__ unsigned xb_xcc_id() { return (unsigned)__builtin_amdgcn_s_getreg((3 << 11) | 20) & 0xFu; }
#define XB_SPIN(cond, bar) do { unsigned _sp = 0; while (cond) { __builtin_amdgcn_s_sleep(1); \
    if ((++_sp & 255u) == 0u) { if (xb_ld(&(bar)[XB_TMO])) break; if (_sp > XB_SPIN_CAP) { atomicAdd(&(bar)[XB_TMO], 1u); break; } } } } while (0)
struct XcdBarrier { unsigned* bar; unsigned x; volatile LAS unsigned* st; int wave; };
__device__ __forceinline__ XcdBarrier xcd_barrier_post(unsigned* bar, volatile LAS unsigned* st, int wave) {
    XcdBarrier b; b.bar = bar; b.x = xb_xcc_id(); b.st = st; b.wave = wave;
    if (threadIdx.x == 0) (void)xb_add(&bar[XB_XCNT(b.x)], 1u);
    return b;
}
__device__ __forceinline__ void xcd_barrier_complete(unsigned* bar, unsigned x, unsigned& nloc, unsigned& nx) {
    const unsigned G = gridDim.x * gridDim.y * gridDim.z;
    unsigned sum, cnt, mine, sp = 0u;
    for (;;) {
        sum = 0u; cnt = 0u; mine = 0u;
#pragma unroll
        for (unsigned j = 0; j < 16; ++j) { const unsigned c = xb_ld(&bar[XB_XCNT(j)]); sum += c; cnt += (c > 0u) ? 1u : 0u; mine = (j == x) ? c : mine; }
        if (sum == G) break;
        __builtin_amdgcn_s_sleep(1);
        if ((++sp & 255u) == 0u) { if (xb_ld(&bar[XB_TMO])) break; if (sp > XB_SPIN_CAP) { atomicAdd(&bar[XB_TMO], 1u); break; } }
    }
    nloc = mine > 0u ? mine : 1u; nx = cnt > 0u ? cnt : 1u;
}
__device__ __forceinline__ void xcd_barrier(const XcdBarrier& b) {
    asm volatile("s_waitcnt vmcnt(0)" ::: "memory");
    __syncthreads();
    if (b.wave == 0 && lane_id() == 0) {
        unsigned* bar = b.bar;
        __builtin_amdgcn_s_waitcnt(0);
        unsigned nloc = b.st[0], nx = b.st[1];
        if (nloc == 0u) { xcd_barrier_complete(bar, b.x, nloc, nx); b.st[0] = nloc; b.st[1] = nx; }
        const unsigned old = xb_add(&bar[XB_XSUB(b.x)], 1u);
        const unsigned gen = old / nloc;
        if (old + 1u == (gen + 1u) * nloc) {
            __builtin_amdgcn_fence(__ATOMIC_RELEASE, "agent");
            asm volatile("s_waitcnt vmcnt(0)" ::: "memory");
            const unsigned og = xb_add(&bar[XB_TOP], 1u);
            const unsigned tg = og / nx;
            if (og + 1u == (tg + 1u) * nx) xb_add(&bar[XB_TOPGEN], 1u);
            else XB_SPIN(xb_ld(&bar[XB_TOPGEN]) == tg, bar);
            __builtin_amdgcn_fence(__ATOMIC_ACQUIRE, "agent");
            xb_add(&bar[XB_XGEN(b.x)], 1u);
            asm volatile("s_waitcnt vmcnt(0)" ::: "memory");
        } else {
            XB_SPIN(xb_ld(&bar[XB_XGEN(b.x)]) == gen, bar);
            __builtin_amdgcn_fence(__ATOMIC_ACQUIRE, "agent");
            asm volatile("s_waitcnt vmcnt(0)" ::: "memory");
        }
    }
    __syncthreads();
}

namespace pg8 {
constexpr int BM = 256, BK = 64, HALF = 128, HTB = HALF * BK * 2, STAGE_BYTES = 8 * HTB;
__host__ __device__ __forceinline__ int lds_byte(int r, int c) { const int st = (r >> 4) * 2 + (c >> 5), rr = r & 15, cc = c & 31, ob = rr * 64 + cc * 2; return st * 1024 + (ob ^ (((ob >> 9) & 1) << 5)); }
__host__ __device__ __forceinline__ void stage_rc(int b, int& R, int& C) { const int st = b / 1024, sb = b % 1024, swz = sb ^ (((sb >> 9) & 1) << 5); R = (st >> 1) * 16 + swz / 64; C = (st & 1) * 32 + (swz % 64) / 2; }
__host__ __device__ __forceinline__ int perm32(int rho) { const int n = rho >> 4, i = rho & 15; return 8 * (i >> 2) + 4 * n + (i & 3); }
struct Unit { int pm, pn; const char* a; const char* b; int kind; };

template <class Epi, class Sched>
__device__ __forceinline__ void gemm_phase(LAS unsigned char* lds, const int wave_, const int K, const Sched& S, const Epi& E, const int ld_ = 0) {
    const int tid = hw_tid(wave_), wid = __builtin_amdgcn_readfirstlane(tid >> 6), lane = tid & 63, wr = wid >> 2, wc = wid & 3, fr = lane & 15, fq = lane >> 4;
    const int nt = K / BK, ld = ld_ ? ld_ : K;
    unsigned voffA[2], voffB[2];
#pragma unroll
    for (int i = 0; i < 2; ++i) { int R, C; stage_rc(tid * 16 + i * 8192, R, C); const int Rb = Epi::PERM ? ((R & ~31) + perm32(R & 31)) : R;
        voffA[i] = (unsigned)(R * ld + C) * 2u; voffB[i] = (unsigned)(Rb * ld + C) * 2u; }
    const size_t kstep = (size_t)(BK * 2);
    const size_t hstep = (size_t)HALF * ld * 2;
    const unsigned ldsw = (unsigned)wid * 1024u;
    const int aoff = lds_byte(wr * 64 + fr, fq * 8), boff = lds_byte(wc * 32 + fr, fq * 8);
#define PG8_SA(b, h) (((b) * 2 + (h)) * HTB)
#define PG8_SB(b, h) ((4 + (b) * 2 + (h)) * HTB)
#define PG8_STAGE(bufoff, gbase, voff) do { _Pragma("unroll") for (int _i = 0; _i < 2; ++_i) \
        __builtin_amdgcn_global_load_lds((const unsigned*)((const char*)(gbase) + (voff)[_i]), (LAS unsigned*)(lds + (bufoff) + ldsw + _i * 8192), 16, 0, 0); } while (0)
#define PG8_LDA(dst, b, h) do { _Pragma("unroll") for (int m = 0; m < 4; ++m) _Pragma("unroll") for (int k = 0; k < 2; ++k) dst[m][k] = *(const LAS bf16x8*)(lds + PG8_SA(b, h) + aoff + m * 2048 + k * 1024); } while (0)
#define PG8_LDB(dst, b, h) do { _Pragma("unroll") for (int n = 0; n < 2; ++n) _Pragma("unroll") for (int k = 0; k < 2; ++k) dst[n][k] = *(const LAS bf16x8*)(lds + PG8_SB(b, h) + boff + n * 2048 + k * 1024); } while (0)
#define PG8_MMA(ai, bj, At, Bt) do { __builtin_amdgcn_s_setprio(1); _Pragma("unroll") for (int m = 0; m < 4; ++m) _Pragma("unroll") for (int n = 0; n < 2; ++n) _Pragma("unroll") for (int k = 0; k < 2; ++k) \
        acc[ai][bj][m][n] = __builtin_amdgcn_mfma_f32_16x16x32_bf16(Bt[n][k], At[m][k], acc[ai][bj][m][n], 0, 0, 0); __builtin_amdgcn_s_setprio(0); } while (0)
#define PG8_WAIT_V(n) asm volatile("s_waitcnt vmcnt(" #n ")" ::: "memory")
#define PG8_WAIT_L(n) asm volatile("s_waitcnt lgkmcnt(" #n ")" ::: "memory")
#define PG8_BAR __builtin_amdgcn_s_barrier()
#define PG8_SCHED __builtin_amdgcn_sched_barrier(0)
    Unit cur, nxt; int ui = 0;
    if (!S.next(0, cur)) return;
    f32x4 acc[2][2][4][2];
#pragma unroll
    for (int a = 0; a < 2; ++a)
#pragma unroll
        for (int b = 0; b < 2; ++b)
#pragma unroll
            for (int m = 0; m < 4; ++m)
#pragma unroll
                for (int n = 0; n < 2; ++n) acc[a][b][m][n] = (f32x4){0.f, 0.f, 0.f, 0.f};
    bf16x8 At[4][2], B0[2][2], B1[2][2];
    const char* cA = cur.a; const char* cB = cur.b;
    PG8_STAGE(PG8_SB(0, 0), cB, voffB); PG8_STAGE(PG8_SA(0, 0), cA, voffA); PG8_STAGE(PG8_SB(0, 1), cB + hstep, voffB); PG8_STAGE(PG8_SA(0, 1), cA + hstep, voffA);
    if (wr == 1) PG8_BAR;
    PG8_WAIT_V(4); PG8_BAR;
    PG8_STAGE(PG8_SB(1, 0), cB + kstep, voffB); PG8_STAGE(PG8_SA(1, 0), cA + kstep, voffA); PG8_STAGE(PG8_SB(1, 1), cB + hstep + kstep, voffB);
    PG8_WAIT_V(6); PG8_BAR;
    for (;;) {
        const bool has_next = S.next(ui + 1, nxt);
        const char* nA = has_next ? nxt.a : cA; const char* nB = has_next ? nxt.b : cB;
        for (int t = 0; t < nt; t += 2) {
            const bool last = (t == nt - 2);
            const char* a1 = cA + (size_t)(t + 1) * kstep;
            const char* a2 = last ? nA : cA + (size_t)(t + 2) * kstep; const char* b2 = last ? nB : cB + (size_t)(t + 2) * kstep;
            const char* a3 = a2 + kstep; const char* b3 = b2 + kstep;
            PG8_LDB(B0, 0, 0); PG8_SCHED; PG8_LDA(At, 0, 0); PG8_STAGE(PG8_SA(1, 1), a1 + hstep, voffA);
            PG8_WAIT_L(8); PG8_BAR; PG8_WAIT_L(0); PG8_MMA(0, 0, At, B0); PG8_BAR; PG8_SCHED;
            PG8_LDB(B1, 0, 1); PG8_STAGE(PG8_SB(0, 0), b2, voffB);
            PG8_BAR; PG8_WAIT_L(0); PG8_MMA(0, 1, At, B1); PG8_BAR;
            PG8_LDA(At, 0, 1); PG8_STAGE(PG8_SA(0, 0), a2, voffA);
            PG8_BAR; PG8_WAIT_L(0); PG8_MMA(1, 0, At, B0); PG8_BAR; PG8_SCHED;
            PG8_STAGE(PG8_SB(0, 1), b2 + hstep, voffB);
            PG8_WAIT_V(6); PG8_BAR; PG8_MMA(1, 1, At, B1); PG8_BAR;
            PG8_LDB(B0, 1, 0); PG8_SCHED; PG8_LDA(At, 1, 0); PG8_STAGE(PG8_SA(0, 1), a2 + hstep, voffA);
            PG8_WAIT_L(8); PG8_BAR; PG8_WAIT_L(0); PG8_MMA(0, 0, At, B0); PG8_BAR; PG8_SCHED;
            PG8_LDB(B1, 1, 1); PG8_STAGE(PG8_SB(1, 0), b3, voffB);
            PG8_BAR; PG8_WAIT_L(0); PG8_MMA(0, 1, At, B1); PG8_BAR;
            PG8_LDA(At, 1, 1); PG8_STAGE(PG8_SA(1, 0), a3, voffA);
            PG8_BAR; PG8_WAIT_L(0); PG8_MMA(1, 0, At, B0); PG8_BAR; PG8_SCHED;
            PG8_STAGE(PG8_SB(1, 1), b3 + hstep, voffB);
            PG8_WAIT_V(6); PG8_BAR; PG8_MMA(1, 1, At, B1); PG8_BAR;
        }
        bool keep = false;
        if constexpr (Epi::CARRY) keep = E.carry(acc, cur, wr, wc, fr, fq); else E(acc, cur, wr, wc, fr, fq);
        if (!has_next) break;
        if (!keep) {
#pragma unroll
        for (int a = 0; a < 2; ++a)
#pragma unroll
            for (int b = 0; b < 2; ++b)
#pragma unroll
                for (int m = 0; m < 4; ++m)
#pragma unroll
                    for (int n = 0; n < 2; ++n) acc[a][b][m][n] = (f32x4){0.f, 0.f, 0.f, 0.f}; }
        cur = nxt; cA = nA; cB = nB; ++ui;
    }
    PG8_WAIT_V(0);
    if (wr == 0) PG8_BAR;
    PG8_BAR;
#undef PG8_SA
#undef PG8_SB
#undef PG8_STAGE
#undef PG8_LDA
#undef PG8_LDB
#undef PG8_MMA
#undef PG8_WAIT_V
#undef PG8_WAIT_L
#undef PG8_BAR
#undef PG8_SCHED
}

#ifndef WGM_MOE
#define WGM_MOE 4
#endif
#ifndef WGM_INP
#define WGM_INP 4
#endif
constexpr int NXCD = 8, WGM = 4;
struct StaticOrder {
    int nM, nN, nwg, G, c, rep, wgm; const char* A; const char* Bt; size_t tstep;
    __device__ void init(const void* A_, const void* Bt_, int M, int N, int K, int G_, int c_, int rep_ = 1, int wgm_ = WGM) { nM = M / BM; nN = N / BM; nwg = nM * nN; G = G_; c = c_; rep = rep_; wgm = wgm_; A = (const char*)A_; Bt = (const char*)Bt_; tstep = (size_t)BM * K * 2; }
    __device__ bool next(int i, Unit& u) const {
        const long L = (long)i * G + c; if (L >= (long)nwg * rep) return false;
        map((int)(L % nwg), u); u.kind = 0; return true;
    }
    __device__ void map(int wgid, Unit& u) const {
        { const int q = nwg / NXCD, r = nwg % NXCD, xcd = wgid % NXCD, off = wgid / NXCD; wgid = (xcd < r ? xcd * (q + 1) : r * (q + 1) + (xcd - r) * q) + off; }
        const int nig = wgm * nN, gid = wgid / nig, fm = gid * wgm, gsz = (nM - fm) < wgm ? (nM - fm) : wgm;
        u.pm = fm + ((wgid % nig) % gsz); u.pn = (wgid % nig) / gsz; u.a = A + (size_t)u.pm * tstep; u.b = Bt + (size_t)u.pn * tstep;
    }
};
struct DualOrder {
    StaticOrder S1, S2;
    __device__ bool next(int i, Unit& u) const {
        const int L = i * S1.G + S1.c; if (L < S1.nwg) { S1.map(L, u); u.kind = 0; return true; }
        if (L - S1.nwg < S2.nwg) { S2.map(L - S1.nwg, u); u.kind = 1; return true; }
        return false;
    }
};
struct PairOrder {
    StaticOrder S0; const char* A1; const char* Bt1;
    __device__ bool next(int i, Unit& u) const {
        const int w = (i >> 1) * S0.G + S0.c; if (w >= S0.nwg) return false;
        S0.map(w, u); u.kind = i & 1;
        if (i & 1) { u.a = A1 + (size_t)u.pm * S0.tstep; u.b = Bt1 + (size_t)u.pn * S0.tstep; }
        return true;
    }
};
struct SplitKOrder {
    int pm0, nN, nT, S, G, c; const char* A; const char* Bt; size_t tstep, kbytes;
    __device__ bool next(int i, Unit& u) const {
        const int L = i * G + c; if (L >= nT * S) return false;
        const int un = L / S, ks = L - un * S; u.pm = pm0 + un / nN; u.pn = un % nN; u.kind = ks;
        u.a = A + (size_t)u.pm * tstep + (size_t)ks * kbytes; u.b = Bt + (size_t)u.pn * tstep + (size_t)ks * kbytes; return true;
    }
};
struct MoeOrder {
    const LAS int* tab; int nN, G, c, rep, wgm; const char* A; const char* W; size_t a_estride, a_tstep, w_estride, w_tstep; bool a_by_slot;
    __device__ bool next(int i, Unit& u) const {
        int L = i * G + c; const int total = tab[16] * nN; if (L >= total * rep) return false; if (L >= total) L -= total;
        int e = 0;
#pragma unroll
        for (int k = 1; k < 8; ++k) e += (L >= tab[8 + k] * nN) ? 1 : 0;
        const int te = tab[e], ts = tab[8 + e]; const int ne = te * nN; int idx = L - ts * nN;
        { const int q = ne / NXCD, r = ne % NXCD, xcd = idx % NXCD, off = idx / NXCD; idx = (xcd < r ? xcd * (q + 1) : r * (q + 1) + (xcd - r) * q) + off; }
        const int nig = wgm * nN, gid = idx / nig, fm = gid * wgm, gsz = (te - fm) < wgm ? (te - fm) : wgm;
        const int r = fm + ((idx % nig) % gsz), pn = (idx % nig) / gsz;
        const int ee = __builtin_amdgcn_readfirstlane(e), pnn = __builtin_amdgcn_readfirstlane(pn), rr = __builtin_amdgcn_readfirstlane(r), tss = __builtin_amdgcn_readfirstlane(ts);
        u.pm = tss + rr; u.pn = pnn; u.kind = 0;
        u.a = a_by_slot ? A + (size_t)u.pm * a_tstep : A + (size_t)ee * a_estride + (size_t)rr * a_tstep;
        u.b = W + (size_t)ee * w_estride + (size_t)pnn * w_tstep; return true;
    }
};
}

namespace att {
constexpr int D = 128, DV = 256, NW = 8, QBLK = 32, KVBLK = 32;
constexpr float SCALE = 0.088388347648318440f;
constexpr float THR = 8.f;
#ifndef ATT_SDEPTH
#define ATT_SDEPTH 1
#endif
constexpr int SDEPTH = ATT_SDEPTH;
constexpr int LDQ = DM, LDK = DM, LDO = 4096;
constexpr size_t SHM_V = KVBLK * DV * 2, SHM_K = KVBLK * D * 2, SHM_Q0 = 2 * SHM_V + 2 * SHM_K + NW * 64 * 4, SHM_ATTN = SHM_Q0 + NW * 8192;
#define KSWZ(row, colB) ((row) * 256 + ((colB) ^ (((row) & 7) << 4)))
#define SBAR() __builtin_amdgcn_sched_barrier(0)
__device__ __forceinline__ int crow(int r, int hi) { return (r & 3) + 8 * (r >> 2) + 4 * hi; }
__device__ __forceinline__ unsigned cvtpk(float lo, float hi) { unsigned r; asm volatile("v_cvt_pk_bf16_f32 %0, %1, %2" : "=v"(r) : "v"(lo), "v"(hi)); return r; }
__device__ __forceinline__ void partialSM(f32x16& p0, float& m_reg, float& mn, float& alpha) {
  constexpr float C = SCALE * 1.4426950408889634f;
  float pmax = p0[0]; for (int r = 1; r < 16; ++r) pmax = fmaxf(pmax, p0[r]);
  { auto rr = __builtin_amdgcn_permlane32_swap(__float_as_uint(pmax), __float_as_uint(pmax), false, false);
    pmax = fmaxf(__uint_as_float(rr[0]), __uint_as_float(rr[1])); }
  if (__builtin_expect(__all(pmax - m_reg <= THR / SCALE), 1)) { mn = m_reg; alpha = 1.f; }
  else { mn = fmaxf(m_reg, pmax); alpha = __builtin_amdgcn_exp2f((m_reg - mn) * C); m_reg = mn; }
  float mnC = -mn * C;
  for (int r = 0; r < 16; ++r) p0[r] = fmaf(p0[r], C, mnC);
  for (int r = 0; r < 8; ++r) p0[r] = __builtin_amdgcn_exp2f(p0[r]);
}
__device__ __forceinline__ void finishSM(f32x16& p0, float alpha, float& l_reg, bf16x8& pa0, bf16x8& pa1) {
  for (int r = 8; r < 16; ++r) p0[r] = __builtin_amdgcn_exp2f(p0[r]);
  float ps = 0; for (int r = 0; r < 16; ++r) ps += p0[r];
  { auto rr = __builtin_amdgcn_permlane32_swap(__float_as_uint(ps), __float_as_uint(ps), false, false);
    ps = __uint_as_float(rr[0]) + __uint_as_float(rr[1]); }
  l_reg = l_reg * alpha + ps;
#define PK4(P, BASE, OUT) do { unsigned a0 = cvtpk(P[BASE + 0], P[BASE + 1]), a1 = cvtpk(P[BASE + 2], P[BASE + 3]);   \
    unsigned b0 = cvtpk(P[BASE + 4], P[BASE + 5]), b1 = cvtpk(P[BASE + 6], P[BASE + 7]);                              \
    auto r0 = __builtin_amdgcn_permlane32_swap(a0, b0, false, false); auto r1 = __builtin_amdgcn_permlane32_swap(a1, b1, false, false); \
    u32x4 w = {r0[0], r1[0], r0[1], r1[1]}; OUT = *reinterpret_cast<bf16x8*>(&w); } while (0)
  PK4(p0, 0, pa0); PK4(p0, 8, pa1);
#undef PK4
}
#ifndef ATT_QLDS
#define ATT_QLDS 0
#endif
#if ATT_QLDS
typedef const char* qfrag_t;
#define QV(d0) (*reinterpret_cast<const bf16x8*>(qp + (d0) * 1024))
#else
typedef const bf16x8* qfrag_t;
#define QV(d0) (qp[d0])
#endif
__device__ __forceinline__ void qkt(f32x16& p0, const bf16_t* Ks, qfrag_t qp, int r32, int hi) {
  p0 = f32x16{};
  for (int d0 = 0; d0 < 8; ++d0) { int cb = (d0 * 16 + hi * 8) * 2; const bf16x8 qv = QV(d0);
    bf16x8 b0 = *reinterpret_cast<const bf16x8*>((const char*)Ks + KSWZ(r32, cb));
    p0 = __builtin_amdgcn_mfma_f32_32x32x16_bf16(b0, qv, p0, 0, 0, 0); }
}
__device__ __forceinline__ int v_st(int k, int c) { const int kk = (k & ~0xC) | ((k & 4) << 1) | ((k & 8) >> 1); return ((kk >> 3) * 8 + (c >> 5)) * 512 + ((kk & 7) * 32 + (c & 31)) * 2; }
__device__ __forceinline__ int v_rd_base(int lane) { return ((lane & 3) << 3) | (((lane >> 2) & 3) << 6) | (((lane >> 4) & 1) << 5) | (((lane >> 5) & 1) << 8); }
constexpr int v_rd_off(int d0, int ks, int half) { return d0 * 512 + ks * 8192 + half * 4096; }
template <int OFF> __device__ __forceinline__ s16x4 tr_read(int vb) {
  s16x4 r; asm volatile("ds_read_b64_tr_b16 %0, %1 offset:%2" : "=&v"(r) : "v"(vb), "i"(OFF) : "memory"); return r;
}
template <int D0> __device__ __forceinline__ void pv_two(f32x16& oa, f32x16& ob, int vb, bf16x8 pa0, bf16x8 pa1) {
  const s16x4 l0 = tr_read<v_rd_off(D0, 0, 0)>(vb), h0 = tr_read<v_rd_off(D0, 0, 1)>(vb), l1 = tr_read<v_rd_off(D0, 1, 0)>(vb), h1 = tr_read<v_rd_off(D0, 1, 1)>(vb);
  const s16x4 l2 = tr_read<v_rd_off(D0 + 1, 0, 0)>(vb), h2 = tr_read<v_rd_off(D0 + 1, 0, 1)>(vb), l3 = tr_read<v_rd_off(D0 + 1, 1, 0)>(vb), h3 = tr_read<v_rd_off(D0 + 1, 1, 1)>(vb);
  asm volatile("s_waitcnt lgkmcnt(0)" ::: "memory"); SBAR();
#define PK(L, H) (bf16x8){L[0], L[1], L[2], L[3], H[0], H[1], H[2], H[3]}
  oa = __builtin_amdgcn_mfma_f32_32x32x16_bf16(pa0, PK(l0, h0), oa, 0, 0, 0);
  oa = __builtin_amdgcn_mfma_f32_32x32x16_bf16(pa1, PK(l1, h1), oa, 0, 0, 0);
  ob = __builtin_amdgcn_mfma_f32_32x32x16_bf16(pa0, PK(l2, h2), ob, 0, 0, 0);
  ob = __builtin_amdgcn_mfma_f32_32x32x16_bf16(pa1, PK(l3, h3), ob, 0, 0, 0);
#undef PK
}
#ifndef ATT_PV1
#define ATT_PV1 1
#endif
template <int D0> __device__ __forceinline__ void pv_one(f32x16& oa, int vb, bf16x8 pa0, bf16x8 pa1) {
  const s16x4 l0 = tr_read<v_rd_off(D0, 0, 0)>(vb), h0 = tr_read<v_rd_off(D0, 0, 1)>(vb), l1 = tr_read<v_rd_off(D0, 1, 0)>(vb), h1 = tr_read<v_rd_off(D0, 1, 1)>(vb);
  asm volatile("s_waitcnt lgkmcnt(0)" ::: "memory"); SBAR();
#define PK(L, H) (bf16x8){L[0], L[1], L[2], L[3], H[0], H[1], H[2], H[3]}
  oa = __builtin_amdgcn_mfma_f32_32x32x16_bf16(pa0, PK(l0, h0), oa, 0, 0, 0);
  oa = __builtin_amdgcn_mfma_f32_32x32x16_bf16(pa1, PK(l1, h1), oa, 0, 0, 0);
#undef PK
}
#ifndef ATT_PVPIPE
#define ATT_PVPIPE 1
#endif
#define PVR(D0, l0, h0, l1, h1) do { l0 = tr_read<v_rd_off(D0, 0, 0)>(vb); h0 = tr_read<v_rd_off(D0, 0, 1)>(vb); l1 = tr_read<v_rd_off(D0, 1, 0)>(vb); h1 = tr_read<v_rd_off(D0, 1, 1)>(vb); } while (0)
#define PVM(OA, l0, h0, l1, h1) do { OA = __builtin_amdgcn_mfma_f32_32x32x16_bf16(pa0, ((bf16x8){l0[0], l0[1], l0[2], l0[3], h0[0], h0[1], h0[2], h0[3]}), OA, 0, 0, 0); \
    OA = __builtin_amdgcn_mfma_f32_32x32x16_bf16(pa1, ((bf16x8){l1[0], l1[1], l1[2], l1[3], h1[0], h1[1], h1[2], h1[3]}), OA, 0, 0, 0); } while (0)
#define PIN(x) asm volatile("" : "+v"(x))
#define PVW(n) do { asm volatile("s_waitcnt lgkmcnt(" #n ")" ::: "memory"); SBAR(); } while (0)
__device__ __forceinline__ void pv_all_pipe(f32x16* o, int vb, bf16x8 pa0, bf16x8 pa1) {
  s16x4 a0, a1, a2, a3, b0, b1, b2, b3;
  PVR(0, a0, a1, a2, a3);
  PVR(1, b0, b1, b2, b3); PVW(4); PVM(o[0], a0, a1, a2, a3);
  PVR(2, a0, a1, a2, a3); PVW(4); PVM(o[1], b0, b1, b2, b3);
  PVR(3, b0, b1, b2, b3); PVW(4); PVM(o[2], a0, a1, a2, a3);
  PVR(4, a0, a1, a2, a3); PVW(4); PVM(o[3], b0, b1, b2, b3);
  PVR(5, b0, b1, b2, b3); PVW(4); PVM(o[4], a0, a1, a2, a3);
  PVR(6, a0, a1, a2, a3); PVW(4); PVM(o[5], b0, b1, b2, b3);
  PVR(7, b0, b1, b2, b3); PVW(4); PVM(o[6], a0, a1, a2, a3);
  PVW(0); PVM(o[7], b0, b1, b2, b3);
}
__device__ __forceinline__ void pv_all_sm(f32x16& o0, f32x16& o1, f32x16& o2, f32x16& o3, f32x16& o4, f32x16& o5, f32x16& o6, f32x16& o7, int vb, bf16x8 pa0, bf16x8 pa1,
                                          f32x16& p0, float& m_reg, float& mn, float& alpha) {
  constexpr float C = SCALE * 1.4426950408889634f;
  s16x4 a0, a1, a2, a3, b0, b1, b2, b3;
  float t0, t1, mnC;
  PVR(0, a0, a1, a2, a3);
  PVR(1, b0, b1, b2, b3);
  t0 = fmaxf(fmaxf(fmaxf(p0[0], p0[1]), fmaxf(p0[2], p0[3])), fmaxf(fmaxf(p0[4], p0[5]), fmaxf(p0[6], p0[7]))); PIN(t0);
  PVW(4); PVM(o0, a0, a1, a2, a3);
  PVR(2, a0, a1, a2, a3);
  t1 = fmaxf(fmaxf(fmaxf(p0[8], p0[9]), fmaxf(p0[10], p0[11])), fmaxf(fmaxf(p0[12], p0[13]), fmaxf(p0[14], p0[15])));
  t0 = fmaxf(t0, t1);
  { auto rr = __builtin_amdgcn_permlane32_swap(__float_as_uint(t0), __float_as_uint(t0), false, false); t0 = fmaxf(__uint_as_float(rr[0]), __uint_as_float(rr[1])); } PIN(t0);
  PVW(4); PVM(o1, b0, b1, b2, b3);
  PVR(3, b0, b1, b2, b3);
  { const bool keep = __all(t0 - m_reg <= THR / SCALE);
    mn = keep ? m_reg : fmaxf(m_reg, t0); alpha = keep ? 1.f : __builtin_amdgcn_exp2f((m_reg - mn) * C); m_reg = mn; mnC = -mn * C; PIN(alpha); PIN(mnC); }
  PVW(4); PVM(o2, a0, a1, a2, a3);
  PVR(4, a0, a1, a2, a3);
#pragma unroll
  for (int r = 0; r < 8; ++r) { p0[r] = fmaf(p0[r], C, mnC); PIN(p0[r]); }
  PVW(4); PVM(o3, b0, b1, b2, b3);
  PVR(5, b0, b1, b2, b3);
#pragma unroll
  for (int r = 8; r < 16; ++r) { p0[r] = fmaf(p0[r], C, mnC); PIN(p0[r]); }
  PVW(4); PVM(o4, a0, a1, a2, a3);
  PVR(6, a0, a1, a2, a3);
#pragma unroll
  for (int r = 0; r < 3; ++r) { p0[r] = __builtin_amdgcn_exp2f(p0[r]); PIN(p0[r]); }
  PVW(4); PVM(o5, b0, b1, b2, b3);
  PVR(7, b0, b1, b2, b3);
#pragma unroll
  for (int r = 3; r < 6; ++r) { p0[r] = __builtin_amdgcn_exp2f(p0[r]); PIN(p0[r]); }
  PVW(4); PVM(o6, a0, a1, a2, a3);
#pragma unroll
  for (int r = 6; r < 8; ++r) { p0[r] = __builtin_amdgcn_exp2f(p0[r]); PIN(p0[r]); }
  PVW(0); PVM(o7, b0, b1, b2, b3);
}
__device__ __forceinline__ void qkt_fsm(f32x16& pn, const bf16_t* Ks, const bf16x8 (&q)[8], int r32, int hi, f32x16& p0, float alpha, float& l_reg, bf16x8& pa0, bf16x8& pa1) {
  pn = f32x16{};
  const char* kbp = (const char*)Ks;
  bf16x8 kf[2];
  kf[0] = *reinterpret_cast<const bf16x8*>(kbp + KSWZ(r32, (hi * 8) * 2));
  float ps = 0.f; unsigned c0 = 0, c1 = 0, c2 = 0, c3 = 0, e0 = 0, e1 = 0, e2 = 0, e3 = 0;
#define QSTEP(d0, ...) do { if ((d0) < 7) kf[((d0) + 1) & 1] = *reinterpret_cast<const bf16x8*>(kbp + KSWZ(r32, (((d0) + 1) * 16 + hi * 8) * 2)); \
    pn = __builtin_amdgcn_mfma_f32_32x32x16_bf16(kf[(d0) & 1], q[d0], pn, 0, 0, 0); __VA_ARGS__; SBAR(); } while (0)
  QSTEP(0, { p0[8] = __builtin_amdgcn_exp2f(p0[8]); p0[9] = __builtin_amdgcn_exp2f(p0[9]); PIN(p0[8]); PIN(p0[9]); });
  QSTEP(1, { p0[10] = __builtin_amdgcn_exp2f(p0[10]); p0[11] = __builtin_amdgcn_exp2f(p0[11]); PIN(p0[10]); PIN(p0[11]); });
  QSTEP(2, { p0[12] = __builtin_amdgcn_exp2f(p0[12]); p0[13] = __builtin_amdgcn_exp2f(p0[13]); PIN(p0[12]); PIN(p0[13]); });
  QSTEP(3, { p0[14] = __builtin_amdgcn_exp2f(p0[14]); p0[15] = __builtin_amdgcn_exp2f(p0[15]); PIN(p0[14]); PIN(p0[15]); });
  QSTEP(4, { ps = ((p0[0] + p0[1]) + (p0[2] + p0[3])) + ((p0[4] + p0[5]) + (p0[6] + p0[7])); PIN(ps); });
  QSTEP(5, { ps += ((p0[8] + p0[9]) + (p0[10] + p0[11])) + ((p0[12] + p0[13]) + (p0[14] + p0[15]));
    { auto rr = __builtin_amdgcn_permlane32_swap(__float_as_uint(ps), __float_as_uint(ps), false, false); ps = __uint_as_float(rr[0]) + __uint_as_float(rr[1]); }
    l_reg = l_reg * alpha + ps; PIN(l_reg); });
  QSTEP(6, { c0 = cvtpk(p0[0], p0[1]); c1 = cvtpk(p0[2], p0[3]); c2 = cvtpk(p0[4], p0[5]); c3 = cvtpk(p0[6], p0[7]);
    auto r0 = __builtin_amdgcn_permlane32_swap(c0, c2, false, false); auto r1 = __builtin_amdgcn_permlane32_swap(c1, c3, false, false);
    u32x4 w = {r0[0], r1[0], r0[1], r1[1]}; PIN(w); pa0 = *reinterpret_cast<bf16x8*>(&w); });
  QSTEP(7, { e0 = cvtpk(p0[8], p0[9]); e1 = cvtpk(p0[10], p0[11]); e2 = cvtpk(p0[12], p0[13]); e3 = cvtpk(p0[14], p0[15]);
    auto r0 = __builtin_amdgcn_permlane32_swap(e0, e2, false, false); auto r1 = __builtin_amdgcn_permlane32_swap(e1, e3, false, false);
    u32x4 w = {r0[0], r1[0], r0[1], r1[1]}; PIN(w); pa1 = *reinterpret_cast<bf16x8*>(&w); });
#undef QSTEP
}
#undef PVR
#undef PVM
#undef PVW
#undef PIN
__device__ __forceinline__ void pv_all(f32x16* o, int vb, bf16x8 pa0, bf16x8 pa1) {
#if ATT_PVPIPE
  pv_all_pipe(o, vb, pa0, pa1);
#elif ATT_PV1
  pv_one<0>(o[0], vb, pa0, pa1); pv_one<1>(o[1], vb, pa0, pa1); pv_one<2>(o[2], vb, pa0, pa1); pv_one<3>(o[3], vb, pa0, pa1);
  pv_one<4>(o[4], vb, pa0, pa1); pv_one<5>(o[5], vb, pa0, pa1); pv_one<6>(o[6], vb, pa0, pa1); pv_one<7>(o[7], vb, pa0, pa1);
#else
  pv_two<0>(o[0], o[1], vb, pa0, pa1); pv_two<2>(o[2], o[3], vb, pa0, pa1); pv_two<4>(o[4], o[5], vb, pa0, pa1); pv_two<6>(o[6], o[7], vb, pa0, pa1);
#endif
}
__device__ __forceinline__ void attn_dense_body(const bf16_t* __restrict__ Qb, const bf16_t* __restrict__ Kh, const bf16_t* __restrict__ Vh,
                                                unsigned* __restrict__ Ob, int seq, char* lds, int wave_) {
  const int tid = hw_tid(wave_), wid = tid >> 6, lane = tid & 63, r32 = lane & 31, hi = lane >> 5;
#ifndef ATT_DMA3
#define ATT_DMA3 1
#endif
#if ATT_DMA3
  constexpr int NVB = 4, NKB = 3;
  static_assert(!ATT_QLDS, "the LDS-DMA body keeps Q in registers");
#else
  constexpr int NVB = 2, NKB = 2;
#endif
  bf16_t* V_lds = (bf16_t*)lds; bf16_t* K_lds = (bf16_t*)(lds + NVB * SHM_V);
  float* ws = (float*)(lds + NVB * SHM_V + NKB * SHM_K) + wid * 64; float* li_l = ws; float* al_l = ws + 32;
  float m_reg = -1e30f, l_reg = 0; f32x16 o[8] = {};
#if ATT_QLDS
  char* qr = lds + SHM_Q0 + wid * 8192 + lane * 16;
#else
  bf16x8 qr[8];
#endif
  const bf16_t* Qw = Qb + (long)(wid * QBLK + r32) * LDQ + hi * 8;
#pragma unroll
#if ATT_QLDS
  for (int d0 = 0; d0 < 8; ++d0) *reinterpret_cast<bf16x8*>(qr + d0 * 1024) = *reinterpret_cast<const bf16x8*>(Qw + d0 * 16);
#else
  for (int d0 = 0; d0 < 8; ++d0) qr[d0] = *reinterpret_cast<const bf16x8*>(Qw + d0 * 16);
#endif
  const int vb0 = (int)(uintptr_t)V_lds + v_rd_base(lane);
#define RESC(a) do { if (__any((a) < 1.f)) { if (hi == 0) al_l[r32] = (a); asm volatile("s_waitcnt lgkmcnt(0)" ::: "memory"); \
    for (int d = 0; d < 8; ++d) for (int r = 0; r < 16; ++r) o[d][r] *= al_l[crow(r, hi)]; } } while (0)
#if ATT_DMA3
  const int widu = __builtin_amdgcn_readfirstlane(wid);
  const unsigned kdl = (unsigned)(uintptr_t)(LAS unsigned char*)K_lds + ((unsigned)widu << 10), vdl = (unsigned)(uintptr_t)(LAS unsigned char*)V_lds + ((unsigned)widu << 10);
  const unsigned kofs = (unsigned)(((tid >> 4) * LDK + ((((tid & 15) ^ ((tid >> 4) & 7))) << 3)) * 2);
  unsigned vofs[2];
#pragma unroll
  for (int i = 0; i < 2; ++i) { const int sl = tid + 512 * i, sub = sl >> 5, w = sl & 31, kk = (sub >> 3) * 8 + (w >> 2), c = (sub & 7) * 32 + (w & 3) * 8, k = (kk & ~0xC) | ((kk & 4) << 1) | ((kk & 8) >> 1);
    vofs[i] = (unsigned)((k * LDK + c) * 2); }
  const int NT = seq / KVBLK;
#define DMA(t, kb, vbi) do { const int t_ = (t) < NT ? (t) : NT - 1; const char* kt_ = (const char*)(Kh + (long)t_ * (KVBLK * LDK)); const char* vt_ = (const char*)(Vh + (long)t_ * (KVBLK * LDK)); \
    __builtin_amdgcn_global_load_lds((const unsigned*)(kt_ + kofs), (LAS unsigned*)(kdl + (unsigned)(kb) * (unsigned)SHM_K), 16, 0, 0); \
    __builtin_amdgcn_global_load_lds((const unsigned*)(vt_ + vofs[0]), (LAS unsigned*)(vdl + (unsigned)(vbi) * (unsigned)SHM_V), 16, 0, 0); \
    __builtin_amdgcn_global_load_lds((const unsigned*)(vt_ + vofs[1]), (LAS unsigned*)(vdl + (unsigned)(vbi) * (unsigned)SHM_V + 8192u), 16, 0, 0); } while (0)
#define LAND() do { asm volatile("s_waitcnt vmcnt(3)" ::: "memory"); __builtin_amdgcn_s_barrier(); asm volatile("" ::: "memory"); } while (0)
#define KB(i) ((bf16_t*)((char*)K_lds + (i) * (int)SHM_K))
#ifndef ATT_QKV
#define ATT_QKV 6
#endif
#define QK_SCHED() do { _Pragma("unroll") for (int i_ = 0; i_ < 8; ++i_) { __builtin_amdgcn_sched_group_barrier(0x100, 1, 0); __builtin_amdgcn_sched_group_barrier(0x008, 1, 0); \
    __builtin_amdgcn_sched_group_barrier(0x002, ATT_QKV, 0); } } while (0)
  f32x16 pA, pB; float mnA, mnB, alA, alB; bf16x8 pa0, pa1;
  DMA(0, 0, 0); DMA(1, 1, 1); LAND();
  qkt(pA, KB(0), qr, r32, hi); partialSM(pA, m_reg, mnA, alA);
  DMA(2, 2, 2); LAND();
  int k1 = 1;
  for (int j = 1; j + 1 < NT; j += 2) {
    const int kA = k1, kB = (kA == 2 ? 0 : kA + 1), kC = (kB == 2 ? 0 : kB + 1);
    SBAR(); qkt_fsm(pB, KB(kA), qr, r32, hi, pA, alA, l_reg, pa0, pa1);
    DMA(j + 2, kC, (j + 2) & 3); SBAR();
    pv_all_sm(o[0], o[1], o[2], o[3], o[4], o[5], o[6], o[7], vb0 + ((j - 1) & 3) * (int)SHM_V, pa0, pa1, pB, m_reg, mnB, alB);
    LAND(); RESC(alB);
    SBAR(); qkt_fsm(pA, KB(kB), qr, r32, hi, pB, alB, l_reg, pa0, pa1);
    DMA(j + 3, kA, (j + 3) & 3); SBAR();
    pv_all_sm(o[0], o[1], o[2], o[3], o[4], o[5], o[6], o[7], vb0 + (j & 3) * (int)SHM_V, pa0, pa1, pA, m_reg, mnA, alA);
    LAND(); RESC(alA);
    k1 = kC;
  }
  SBAR(); qkt(pB, KB(k1), qr, r32, hi);
  finishSM(pA, alA, l_reg, pa0, pa1); SBAR();
  pv_all(o, vb0 + ((NT - 2) & 3) * (int)SHM_V, pa0, pa1); partialSM(pB, m_reg, mnB, alB);
  RESC(alB);
  finishSM(pB, alB, l_reg, pa0, pa1); SBAR();
  pv_all(o, vb0 + ((NT - 1) & 3) * (int)SHM_V, pa0, pa1);
  asm volatile("s_waitcnt vmcnt(0)" ::: "memory");
#undef DMA
#undef LAND
#undef KB
#undef QK_SCHED
#else
  const int sr = tid >> 4, sc = (tid & 15) * 8, vst0 = v_st(sr, sc), vst1 = v_st(sr, 128 + sc);
#ifndef ATT_KDMA
#define ATT_KDMA 1
#endif
#if ATT_KDMA
  struct { bf16x8 vs0, vs1; } sr_[SDEPTH];
  const int kdc = (((tid & 15) ^ (sr & 7)) << 3);
  const unsigned kdl = (unsigned)(uintptr_t)(LAS unsigned char*)K_lds + ((unsigned)__builtin_amdgcn_readfirstlane(wid) << 10);
#define KDMA(b, k0) __builtin_amdgcn_global_load_lds((const unsigned*)(Kh + (long)((k0) + sr) * LDK + kdc), (LAS unsigned*)(kdl + (b) * (unsigned)SHM_K), 16, 0, 0)
#define SLOAD(i, k0, b) do { sr_[i].vs0 = *reinterpret_cast<const bf16x8*>(&Vh[(long)((k0) + sr) * LDK + sc]); sr_[i].vs1 = *reinterpret_cast<const bf16x8*>(&Vh[(long)((k0) + sr) * LDK + 128 + sc]); KDMA(b, k0); } while (0)
#define SWRITE(b, i) do { *(bf16x8*)((char*)V_lds + (b) * SHM_V + vst0) = sr_[i].vs0;          \
    *(bf16x8*)((char*)V_lds + (b) * SHM_V + vst1) = sr_[i].vs1; } while (0)
#else
  struct { bf16x8 vs0, vs1, ks0; } sr_[SDEPTH];
#define SLOAD(i, k0, b) do { sr_[i].vs0 = *reinterpret_cast<const bf16x8*>(&Vh[(long)((k0) + sr) * LDK + sc]); sr_[i].vs1 = *reinterpret_cast<const bf16x8*>(&Vh[(long)((k0) + sr) * LDK + 128 + sc]); \
    sr_[i].ks0 = *reinterpret_cast<const bf16x8*>(&Kh[(long)((k0) + sr) * LDK + sc]); } while (0)
#define SWRITE(b, i) do { *(bf16x8*)((char*)V_lds + (b) * SHM_V + vst0) = sr_[i].vs0;          \
    *(bf16x8*)((char*)V_lds + (b) * SHM_V + vst1) = sr_[i].vs1;                                 \
    *(bf16x8*)((char*)K_lds + (b) * SHM_K + KSWZ(sr, sc * 2)) = sr_[i].ks0; } while (0)
#endif
#define SWAIT() do { if constexpr (SDEPTH == 2) asm volatile("s_waitcnt vmcnt(3)" ::: "memory"); else asm volatile("s_waitcnt vmcnt(0)" ::: "memory"); } while (0)
  f32x16 pA, pB; float mnA, mnB, alA, alB; bf16x8 pa0, pa1; const int NT = seq / KVBLK;
  constexpr int SE = 0, SO = SDEPTH - 1;
  SLOAD(SE, 0, 0); asm volatile("s_waitcnt vmcnt(0)" ::: "memory"); SWRITE(0, SE); __syncthreads();
  qkt(pA, K_lds, qr, r32, hi); partialSM(pA, m_reg, mnA, alA);
  SLOAD(SO, KVBLK, 1); if constexpr (SDEPTH == 2) { if (2 < NT) SLOAD(SE, 2 * KVBLK, 0); }
  SWAIT(); SWRITE(1, SO); __syncthreads();
  for (int j = 1; j + 1 < NT; j += 2) {
    SBAR(); qkt(pB, (bf16_t*)((char*)K_lds + SHM_K), qr, r32, hi);
    finishSM(pA, alA, l_reg, pa0, pa1); SBAR();
    SLOAD(SO, (j + SDEPTH) * KVBLK, 0); SBAR();
    pv_all(o, vb0, pa0, pa1); partialSM(pB, m_reg, mnB, alB);
    __syncthreads(); SWAIT(); SWRITE(0, SE);
    RESC(alB); __syncthreads();
    SBAR(); qkt(pA, K_lds, qr, r32, hi);
    finishSM(pB, alB, l_reg, pa0, pa1); SBAR();
    if (SDEPTH == 1 || j + 3 < NT) SLOAD(SE, (j + 1 + SDEPTH) * KVBLK, 1); SBAR();
    pv_all(o, vb0 + (int)SHM_V, pa0, pa1); partialSM(pA, m_reg, mnA, alA);
    __syncthreads(); SWAIT(); SWRITE(1, SO);
    RESC(alA); __syncthreads();
  }
  SBAR(); qkt(pB, (bf16_t*)((char*)K_lds + SHM_K), qr, r32, hi);
  finishSM(pA, alA, l_reg, pa0, pa1); SBAR();
  pv_all(o, vb0, pa0, pa1); partialSM(pB, m_reg, mnB, alB);
  __syncthreads(); RESC(alB);
  finishSM(pB, alB, l_reg, pa0, pa1); SBAR();
  pv_all(o, vb0 + (int)SHM_V, pa0, pa1);
#undef SLOAD
#undef SWRITE
#undef SWAIT
#ifdef KDMA
#undef KDMA
#endif
#endif
  if (hi == 0) li_l[r32] = l_reg; asm volatile("s_waitcnt lgkmcnt(0)" ::: "memory");
  float rli[16];
#pragma unroll
  for (int r = 0; r < 16; ++r) rli[r] = __builtin_amdgcn_rcpf(li_l[crow(r, hi)]);
  unsigned* Ow = Ob + (long)(wid * QBLK) * (LDO / 2);
#pragma unroll
  for (int r = 0; r < 16; ++r) { int orow = crow(r, hi);
    for (int k = 0; k < 4; ++k) Ow[(long)orow * (LDO / 2) + k * 32 + r32] = cvtpk(o[2 * k][r] * rli[r], o[2 * k + 1][r] * rli[r]); }
#undef RESC
}
#undef KSWZ
#undef SBAR
#undef QV
}

struct Args { const float* in[38]; float* out; unsigned char* ws; int ph_lo, ph_hi; };
enum { I_X = 0, I_C, I_CTX, I_CCTX, I_WADA, I_BADA, I_NORM1, I_NORM2, I_WIN, I_BGATE, I_QNORM, I_KNORM, I_LQ1, I_LK1, I_LQ2, I_LK2, I_SUBN, I_HCW, I_HCB,
       I_HW1, I_HB1, I_HW2, I_HB2, I_HW3, I_HB3, I_HW4, I_HFREQ, I_HBIAS, I_WBRA, I_WBRB, I_WOUT, I_FW1, I_FW3, I_FW2, I_ROUTER, I_MW1, I_MW3, I_MW2 };

struct Frame {
    LAS unsigned char* lds; char* ldsg;
    const float* const* in; float* out; unsigned char* ws;
    int tid, lane, wave, G, bid, gw, NGW;
};

__device__ __forceinline__ Frame enter(const Frame& F0) {
    Frame F = F0; __attribute__((address_space(1))) unsigned char* w = (__attribute__((address_space(1))) unsigned char*)F0.ws; asm volatile("" : "+s"(w)); F.ws = (unsigned char*)w;
    const int t = hw_tid(F0.wave); F.tid = t; F.lane = t & 63; return F;
}
__host__ __device__ __forceinline__ int qk_perm(int d) { const int axis = d >> 6, half = (d >> 5) & 1, f = d & 31; return 32 * (2 * axis + (f >> 4)) + 8 * ((f >> 2) & 3) + 4 * half + (f & 3); }
__device__ __forceinline__ void transpose_item(const float* W, int K, int N, bf16_t* WT, int kb, int nb, int dst_row0, LAS float* scr, int lane, bool qkperm = false) {
    const int k0 = 64 * kb, n0 = 32 * nb;
    { f32x4 v[8]; const float* wp = W + (size_t)(k0 + (lane >> 3)) * N + n0 + 4 * (lane & 7);
#pragma unroll
      for (int i = 0; i < 8; ++i) v[i] = __builtin_nontemporal_load((const f32x4*)(wp + (size_t)(8 * i) * N));
#pragma unroll
      for (int i = 0; i < 8; ++i) { LAS float* d = scr + (8 * i + (lane >> 3)) * 33 + 4 * (lane & 7); d[0] = v[i].x; d[1] = v[i].y; d[2] = v[i].z; d[3] = v[i].w; } }
    LDS_WAIT(); asm volatile("" ::: "memory");
    const int c = lane & 7;
#pragma unroll
    for (int j = 0; j < 4; ++j) { const int n = (lane >> 3) + 8 * j; const LAS float* s = scr + (8 * c) * 33 + n;
        u32x4 o; o.x = cvt_pk_bf16(s[0 * 33], s[1 * 33]); o.y = cvt_pk_bf16(s[2 * 33], s[3 * 33]); o.z = cvt_pk_bf16(s[4 * 33], s[5 * 33]); o.w = cvt_pk_bf16(s[6 * 33], s[7 * 33]);
        const int drow = qkperm ? ((n0 + n) & ~127) + qk_perm((n0 + n) & 127) : dst_row0 + n;
        __builtin_nontemporal_store(o, (u32x4*)(WT + (size_t)drow * K + k0 + 8 * c)); }
    LDS_WAIT(); asm volatile("" ::: "memory");
}
__device__ __forceinline__ float silu_f(float v) { return v / (1.f + __expf(-v)); }

namespace zt {
constexpr int L_WIN = 32 * 512, L_BR = 3 * 32 * 64, L_UP1 = 2 * 32 * 176, L_DN1 = 88 * 64;
constexpr int L_DENSE = L_WIN + L_BR + L_UP1 + L_DN1, L_MOE = L_WIN + L_BR + 8 * (L_UP1 + L_DN1);
constexpr int Z1 = L_DENSE, Z2 = Z1 + L_MOE, Z3 = Z2 + L_DENSE, ZEND = Z3 + L_MOE;
#ifndef ZT_NH
#define ZT_NH 16
#endif
#ifndef ZT_NI
#define ZT_NI 7
#endif
constexpr int BUSY = 32, WORKERS = (256 - BUSY) * NWAVES, CH = ZT_NH * WORKERS, CI = ZT_NI * WORKERS, CL = CH + CI;
constexpr int ZB0 = Z1, ZB1 = ZB0 + CL, ZB2 = Z2 + L_WIN + L_BR;
static_assert(ZB1 + CL <= Z2 && ZB2 + CL <= ZEND, "tail ranges");
__device__ __forceinline__ bool deferred(int G) { return G == 256 && CL > 0; }
}
__device__ __forceinline__ void transpose_z(const Frame& F, int z, LAS float* scr) {
    const int l = z < zt::Z1 ? 0 : (z < zt::Z2 ? 1 : (z < zt::Z3 ? 2 : 3)); int r = z - (l == 0 ? 0 : (l == 1 ? zt::Z1 : (l == 2 ? zt::Z2 : zt::Z3)));
    const float* src; bf16_t* dst; int K, N, kb, nb, dr; bool qp = false;
    if (r < zt::L_WIN) { kb = r / 512; nb = r % 512; const int n0 = 32 * nb; K = DM; N = NIN;
        dr = n0 < 6144 ? n0 : (n0 < 12288 ? NQKVG + (n0 - 6144) : 6144 + (n0 - 12288)); qp = n0 < 4096;
        src = F.in[I_WIN] + (size_t)l * DM * NIN; dst = (bf16_t*)(F.ws + WS_WIN) + (size_t)l * NIN * DM; }
    else if ((r -= zt::L_WIN) < zt::L_BR) { const int w = r / 2048, q = r % 2048; kb = q / 64; nb = q % 64; K = DM; N = DM; dr = 32 * nb;
        src = F.in[w == 0 ? I_WBRA : (w == 1 ? I_WBRB : I_WOUT)] + (size_t)l * DM * DM;
        dst = (bf16_t*)(F.ws + (w == 0 ? WS_WBRA : (w == 1 ? WS_WBRB : WS_WOUT))) + (size_t)l * DM * DM; }
    else { r -= zt::L_BR; const bool moe = (l & 1) != 0; const int ns = moe ? 8 : 1, slot0 = moe ? 2 + (l >> 1) * 8 : (l >> 1);
        if (r < ns * zt::L_UP1) { const int slot = slot0 + r / zt::L_UP1, q0 = r % zt::L_UP1, which = q0 / (32 * 176), q = q0 % (32 * 176); kb = q / 176; nb = q % 176; const int n0 = 32 * nb; K = DM; N = DFF;
            dr = (n0 / 128) * 256 + which * 128 + (n0 % 128);
            src = slot < 2 ? F.in[which ? I_FW3 : I_FW1] + (size_t)slot * DM * DFF : F.in[which ? I_MW3 : I_MW1] + (size_t)(slot - 2) * DM * DFF;
            dst = (bf16_t*)(F.ws + WS_WUP) + (size_t)slot * 2 * DFF * DM; }
        else { r -= ns * zt::L_UP1; const int slot = slot0 + r / zt::L_DN1, q = r % zt::L_DN1; kb = q / 64; nb = q % 64; K = DFF; N = DM; dr = 32 * nb;
            src = slot < 2 ? F.in[I_FW2] + (size_t)slot * DFF * DM : F.in[I_MW2] + (size_t)(slot - 2) * DFF * DM;
            dst = (bf16_t*)(F.ws + WS_WDN) + (size_t)slot * DM * DFF; } }
    transpose_item(src, K, N, dst, kb, nb, dr, scr, F.lane, qp);
}
__device__ __forceinline__ void phase_tail_transposes(const Frame& F0, int l, int which) {
    Frame F = enter(F0);
    if (!zt::deferred(F.G) || F.bid < zt::BUSY || l >= DEPTH - 1) return;
    LAS float* scr = (LAS float*)(F.lds + F.wave * 16384);
    const int zlo = (l == 0 ? zt::ZB0 : (l == 1 ? zt::ZB1 : zt::ZB2)) + (which ? zt::CH : 0), zhi = zlo + (which ? zt::CI : zt::CH);
    for (int z = zlo + (F.bid - zt::BUSY) * NWAVES + F.wave; z < zhi; z += zt::WORKERS) transpose_z(F, z, scr);
}
__device__ __forceinline__ void phase_prologue0(const Frame& F0) {
    Frame F = enter(F0);
    LAS float* scr = (LAS float*)(F.lds + F.wave * 16384);
    {
        const bool defer = zt::deferred(F.G);
        const int n0 = defer ? zt::ZB0 : zt::ZEND, n1 = defer ? zt::ZB2 - (zt::ZB1 + zt::CL) : 0, n2 = defer ? zt::ZEND - (zt::ZB2 + zt::CL) : 0, np = n0 + n1 + n2;
        for (int px = F.gw; px < np * ((PROBE == 4) ? 2 : 1); px += F.NGW) { const int p = px % np;
            const int z = p < n0 ? p : (p < n0 + n1 ? zt::ZB1 + zt::CL + (p - n0) : zt::ZB2 + zt::CL + (p - n0 - n1));
            transpose_z(F, z, scr); }
    }
    {
        LAS float* zb = (LAS float*)(F.lds + F.wave * 16384);
        const int l = F.gw & 3, j = F.lane;
        float w1c[33], w2c[64], w3c[64];
#pragma unroll
        for (int i = 0; i < 33; ++i) w1c[i] = F.in[I_HW1][((size_t)l * 33 + i) * 64 + j];
#pragma unroll
        for (int i = 0; i < 64; ++i) { w2c[i] = F.in[I_HW2][((size_t)l * 64 + i) * 64 + j]; w3c[i] = F.in[I_HW3][((size_t)l * 64 + i) * 64 + j]; }
        const float fr = F.in[I_HFREQ][l * 64 + j], b1 = F.in[I_HB1][l * 64 + j], b2 = F.in[I_HB2][l * 64 + j], b3 = F.in[I_HB3][l * 64 + j];
        const int nq = 4352 * ((PROBE == 12) ? 2 : 1);
        for (int qx = F.gw >> 2; qx < nq; qx += F.NGW >> 2) {
            const int q = qx % 4352; const int var = q >= 4096, t = var ? q - 4096 : q, L = var ? 256 : 4096;
            float z = 0.f;
            if (j == 0) z = (float)t / (float)(L - 1);
            else if (j < 33) { const int k = (j - 1) & 15; const float w = 6.283185307179586f * (float)t / (float)L; const float f = 1e-4f + (float)k * ((15.f - 1e-4f) / 15.f);
                z = (j < 17) ? cosf(w * f) : -sinf(w * f); }
            zb[j] = z; LDS_WAIT(); asm volatile("" ::: "memory");
            float a = b1;
#pragma unroll
            for (int i = 0; i < 33; ++i) a += zb[i] * w1c[i];
            float h = sinf(fr * a);
            zb[64 + j] = h; LDS_WAIT(); asm volatile("" ::: "memory");
            a = b2;
#pragma unroll
            for (int i = 0; i < 64; ++i) a += zb[64 + i] * w2c[i];
            h = sinf(fr * a);
            zb[j] = h; LDS_WAIT(); asm volatile("" ::: "memory");
            a = b3;
#pragma unroll
            for (int i = 0; i < 64; ++i) a += zb[i] * w3c[i];
            h = sinf(fr * a);
            float* dst = var ? (float*)(F.ws + WS_HIDC) + ((size_t)l * 256 + t) * 64 : (float*)(F.ws + WS_HID) + ((size_t)l * 4096 + t) * 64;
            dst[j] = h;
            LDS_WAIT(); asm volatile("" ::: "memory");
        }
    }
    if (F.bid == 0 && F.wave < 4) {
        const int l = F.wave; const int j = F.lane;
        float s1 = F.in[I_LQ1][l * 128 + j] * F.in[I_LK1][l * 128 + j] + F.in[I_LQ1][l * 128 + 64 + j] * F.in[I_LK1][l * 128 + 64 + j];
        float s2 = F.in[I_LQ2][l * 128 + j] * F.in[I_LK2][l * 128 + j] + F.in[I_LQ2][l * 128 + 64 + j] * F.in[I_LK2][l * 128 + 64 + j];
        s1 = wave_sum(s1, j); s2 = wave_sum(s2, j);
        const float lam_init = 0.8f - 0.6f * expf(-0.3f * (float)l);
        if (j == 0) ((float*)(F.ws + WS_LAM))[l] = expf(s1) - expf(s2) + lam_init;
    }
    if (F.bid == 1 % F.G) {
        for (int i = F.tid; i < 2048; i += NTHR) { const int pos = i >> 5, f = i & 31; const float inv = expf(-(float)f * (9.210340371976184f / 32.f)); const float ang = (float)pos * inv;
            ((float*)(F.ws + WS_ROPE))[i] = cosf(ang); ((float*)(F.ws + WS_ROPE))[2048 + i] = sinf(ang); }
    }
    __syncthreads();
    {
        LAS float* sv = (LAS float*)F.lds;
        LAS float* red = (LAS float*)(F.lds + 65536);
        bool have = false;
        const int half = F.lane >> 5, l4 = (F.lane & 31) * 4;
        for (int itx = F.bid; itx < 4 * 96 * ((PROBE == 13) ? 2 : 1); itx += F.G) { const int it = itx % (4 * 96);
            if (!have) { for (int i = F.tid; i < 5 * DM; i += NTHR) { const int v = i / DM, k = i % DM; const float cv = v < 4 ? F.in[I_C][v * DM + k] : F.in[I_CCTX][k]; sv[i] = silu_f(cv); } have = true; __syncthreads(); }
            const int l = it / 96, cc = it % 96;
            const float* W = F.in[I_WADA] + (size_t)l * DM * 12288 + cc * 128 + l4;
            f32x4 acc[5];
#pragma unroll
            for (int v = 0; v < 5; ++v) acc[v] = (f32x4){0.f, 0.f, 0.f, 0.f};
            const int k0 = F.wave * 256 + half;
#pragma unroll 8
            for (int kk = 0; kk < 128; ++kk) { const int k = k0 + 2 * kk; const f32x4 w = *(const f32x4*)(W + (size_t)k * 12288);
#pragma unroll
                for (int v = 0; v < 5; ++v) acc[v] += w * sv[v * DM + k]; }
#pragma unroll
            for (int v = 0; v < 5; ++v)
#pragma unroll
                for (int q = 0; q < 4; ++q) acc[v][q] += shx(acc[v][q], 32, F.lane);
            if (half == 0) {
#pragma unroll
                for (int v = 0; v < 5; ++v) *(LAS f32x4*)(red + (F.wave * 5 + v) * 128 + l4) = acc[v]; }
            __syncthreads();
            for (int i = F.tid; i < 5 * 128; i += NTHR) { const int v = i / 128, c = i % 128; float sm = 0.f;
#pragma unroll
                for (int w = 0; w < 8; ++w) sm += red[(w * 5 + v) * 128 + c];
                ((float*)(F.ws + WS_MOD))[((size_t)l * 5 + v) * 12288 + cc * 128 + c] = sm + F.in[I_BADA][l * 12288 + cc * 128 + c]; }
            __syncthreads();
        }
    }
}

__device__ __forceinline__ void split8(const float (&x)[8], bf16x8& hi, bf16x8& lo) {
    u32x4 h, l;
#pragma unroll
    for (int k = 0; k < 4; ++k) { const unsigned hw = cvt_pk_bf16(x[2 * k], x[2 * k + 1]); h[k] = hw; l[k] = cvt_pk_bf16(x[2 * k] - bf_lo(hw), x[2 * k + 1] - bf_hi(hw)); }
    hi = *reinterpret_cast<bf16x8*>(&h); lo = *reinterpret_cast<bf16x8*>(&l);
}
__device__ __forceinline__ void phase_prologue1(const Frame& F0) {
    Frame F = enter(F0);
    const int n = F.lane & 31, hi = F.lane >> 5;
    for (int it = F.gw; it < 4 * 256 * 2; it += F.NGW) {
        const int l = it >> 9, cb = (it >> 1) & 255, half = it & 1;
        const int col0 = cb * 32, f = col0 >> 12, dir = (col0 >> 11) & 1, c0 = col0 & 2047;
        const float* w4 = F.in[I_HW4] + (size_t)l * 64 * 8192 + col0 + n;
        bf16x8 Ah[4], Al[4];
#pragma unroll
        for (int ks = 0; ks < 4; ++ks) { float xv[8];
#pragma unroll
            for (int i = 0; i < 8; ++i) xv[i] = w4[(size_t)(16 * ks + 8 * hi + i) * 8192];
            split8(xv, Ah[ks], Al[ks]); }
        const float da = -3.0701134573253945f, db = -15.350567286626972f;
#pragma unroll
        for (int var = 0; var < 2; ++var) {
            if (var == 1 && half != 0) continue;
            const int L = var ? 256 : 4096, ntb = var ? 8 : 64, tb0 = var ? 0 : half * 64;
            const float invL = 1.f / (float)(L - 1);
            float base[16], step[16];
#pragma unroll
            for (int r = 0; r < 16; ++r) { const int ch = c0 + (r & 3) + 8 * (r >> 2) + 4 * hi; const float delta = fabsf(da + (float)ch * ((db - da) / 2047.f));
                base[r] = expf(-delta * (float)(tb0 * 32 + n) * invL); step[r] = expf(-delta * 32.f * invL); }
            const float* hsrc = (var ? (const float*)(F.ws + WS_HIDC) + (size_t)l * 256 * 64 : (const float*)(F.ws + WS_HID) + (size_t)l * 4096 * 64) + (size_t)(tb0 * 32 + n) * 64 + 8 * hi;
            bf16_t* Rl = var ? (bf16_t*)(F.ws + WS_RC) + (((size_t)l * 2 + f) * 2048 + c0 + 4 * hi) * 1024 + 512 : (bf16_t*)(F.ws + WS_R) + (((size_t)l * 2 + f) * 2048 + c0 + 4 * hi) * 8704 + 4352;
            const int rstride = var ? 1024 : 8704;
            f32x4 hn[8];
#pragma unroll
            for (int ks = 0; ks < 4; ++ks) { hn[2 * ks] = *(const f32x4*)(hsrc + 16 * ks); hn[2 * ks + 1] = *(const f32x4*)(hsrc + 16 * ks + 4); }
            for (int tb = 0; tb < ntb; ++tb) {
                f32x16 acc = f32x16{};
                f32x4 hc[8];
#pragma unroll
                for (int k = 0; k < 8; ++k) hc[k] = hn[k];
                { const int tn = tb + 1 < ntb ? tb + 1 : tb;
#pragma unroll
                  for (int ks = 0; ks < 4; ++ks) { hn[2 * ks] = *(const f32x4*)(hsrc + (size_t)tn * 2048 + 16 * ks); hn[2 * ks + 1] = *(const f32x4*)(hsrc + (size_t)tn * 2048 + 16 * ks + 4); } }
#pragma unroll
                for (int ks = 0; ks < 4; ++ks) { const f32x4 b0 = hc[2 * ks], b1 = hc[2 * ks + 1];
                    const float xv[8] = {b0.x, b0.y, b0.z, b0.w, b1.x, b1.y, b1.z, b1.w}; bf16x8 Bh, Bl; split8(xv, Bh, Bl);
                    acc = __builtin_amdgcn_mfma_f32_32x32x16_bf16(Ah[ks], Bh, acc, 0, 0, 0);
                    acc = __builtin_amdgcn_mfma_f32_32x32x16_bf16(Ah[ks], Bl, acc, 0, 0, 0);
                    acc = __builtin_amdgcn_mfma_f32_32x32x16_bf16(Al[ks], Bh, acc, 0, 0, 0); }
                const int t = (tb0 + tb) * 32 + n;
#pragma unroll
                for (int r = 0; r < 16; ++r) { const float val = acc[r] * base[r]; base[r] *= step[r];
                    bf16_t* Rr = Rl + (size_t)((r & 3) + 8 * (r >> 2)) * rstride;
                    const bf16_t bv = (bf16_t)(cvt_pk_bf16(val, 0.f) & 0xffffu);
                    if (dir == 0) Rr[-t] = bv; else if (t >= 1) Rr[t] = bv; }
            }
        }
    }
    for (int it = F.gw; it < 4 * 2 * 2048; it += F.NGW) {
        bf16_t* R = (bf16_t*)(F.ws + WS_R) + (size_t)it * 8704; bf16_t* Rc = (bf16_t*)(F.ws + WS_RC) + (size_t)it * 1024;
        for (int x = F.lane; x < 257; x += 64) { R[x] = 0; Rc[x] = 0; }
        for (int x = F.lane; x < 256; x += 64) { R[8448 + x] = 0; Rc[768 + x] = 0; }
    }
}

__device__ __forceinline__ void ffn_row_load(Frame& F, int lp, int row, f32x4 (&f)[8]) {
    const bf16_t* ys = (const bf16_t*)(F.ws + AR_YS);
    if ((lp & 1) == 0) {
        if (row < ML) { const u32x2* p = (const u32x2*)(ys + (size_t)row * DM) + F.lane;
#pragma unroll
            for (int j = 0; j < 8; ++j) { const u32x2 w = __builtin_nontemporal_load(p + 64 * j); f[j] = (f32x4){bf_lo(w.x), bf_hi(w.x), bf_lo(w.y), bf_hi(w.y)}; }
        } else { const f32x4* p = (const f32x4*)((const float*)(F.ws + AR_YSC) + (size_t)(row - ML) * DM) + F.lane;
#pragma unroll
            for (int j = 0; j < 8; ++j) f[j] = ((p[64 * j] + p[64 * j + MC * DM / 4]) + p[64 * j + 2 * (MC * DM / 4)]) + p[64 * j + 3 * (MC * DM / 4)]; }
    } else {
        const int* ti = (const int*)(F.ws + WS_TOK) + (size_t)row * 8;
        const int e1 = ti[0], p1 = ti[1], e2 = ti[2], p2 = ti[3]; const float w1 = __int_as_float(ti[4]), w2 = __int_as_float(ti[5]);
        const unsigned* cnt = (const unsigned*)(F.ws + WS_CTL) + CW_CNT + (lp >> 1) * 8 * 64;
        int s1 = 0, s2 = 0;
#pragma unroll
        for (int e = 0; e < 8; ++e) { const int tl = ((int)cnt[e * 64] + 255) >> 8; s1 += (e < e1) ? tl : 0; s2 += (e < e2) ? tl : 0; }
        const u32x2* pa = (const u32x2*)(ys + (size_t)(s1 * 256 + p1) * DM) + F.lane;
        const u32x2* pb = (const u32x2*)(ys + (size_t)(s2 * 256 + p2) * DM) + F.lane;
#pragma unroll
        for (int j = 0; j < 8; ++j) { const u32x2 a = __builtin_nontemporal_load(pa + 64 * j), b = __builtin_nontemporal_load(pb + 64 * j);
            f[j] = (f32x4){w1 * bf_lo(a.x) + w2 * bf_lo(b.x), w1 * bf_hi(a.x) + w2 * bf_hi(b.x), w1 * bf_lo(a.y) + w2 * bf_lo(b.y), w1 * bf_hi(a.y) + w2 * bf_hi(b.y)}; }
    }
}
__device__ __forceinline__ void phase_normmod1(const Frame& F0, int l, int npass = 1) {
    Frame F = enter(F0);
#pragma nounroll
    for (int pass = 0; pass < npass; ++pass) { const bool dry = pass + 1 < npass;
    float* X = (float*)(F.ws + WS_X); bf16_t* H = (bf16_t*)(F.ws + (dry ? AR_O : AR_H)); float* Xw = dry ? (float*)(F.ws + AR_O + 68 * MiB) : X;
    const float* mod = (const float*)(F.ws + WS_MOD);
    f32x4 xn[8];
    { const int row = F.gw; const f32x4* src = (const f32x4*)(l == 0 ? (row < ML ? F.in[I_X] + (size_t)row * DM : F.in[I_CTX] + (size_t)(row - ML) * DM) : X + (size_t)row * DM) + F.lane;
#pragma unroll
      for (int j = 0; j < 8; ++j) xn[j] = src[64 * j]; }
    for (int row = F.gw; row < MT; row += F.NGW) {
        const int v = row < ML ? row / SEQ : 4;
        f32x4 x[8];
#pragma unroll
        for (int j = 0; j < 8; ++j) x[j] = xn[j];
        { const int rn = row + F.NGW < MT ? row + F.NGW : row;
          const f32x4* src = (const f32x4*)(l == 0 ? (rn < ML ? F.in[I_X] + (size_t)rn * DM : F.in[I_CTX] + (size_t)(rn - ML) * DM) : X + (size_t)rn * DM) + F.lane;
#pragma unroll
          for (int j = 0; j < 8; ++j) xn[j] = __builtin_nontemporal_load(src + 64 * j); }
        if (l != 0) {
            const f32x4* g2 = (const f32x4*)(mod + ((size_t)(l - 1) * 5 + v) * 12288 + 5 * DM) + F.lane;
            f32x4 f[8]; ffn_row_load(F, l - 1, row, f);
#pragma unroll
            for (int j = 0; j < 8; ++j) x[j] = x[j] + g2[64 * j] * f[j];
        }
        { f32x4* dst = (f32x4*)(Xw + (size_t)row * DM) + F.lane;
#pragma unroll
            for (int j = 0; j < 8; ++j) __builtin_nontemporal_store(x[j], dst + 64 * j); }
        float ss = 0.f;
#pragma unroll
        for (int j = 0; j < 8; ++j) ss += (x[j].x * x[j].x + x[j].y * x[j].y) + (x[j].z * x[j].z + x[j].w * x[j].w);
        const float rstd = 1.f / sqrtf(wave_sum(ss, F.lane) * (1.f / DM) + EPS);
        const f32x4* gn = (const f32x4*)(F.in[I_NORM1] + (size_t)l * DM) + F.lane;
        const f32x4* sh = (const f32x4*)(mod + ((size_t)l * 5 + v) * 12288) + F.lane;
        const f32x4* sc = (const f32x4*)(mod + ((size_t)l * 5 + v) * 12288 + DM) + F.lane;
        u32x2* o = (u32x2*)(H + (size_t)row * DM) + F.lane;
#pragma unroll
        for (int j = 0; j < 8; ++j) { const f32x4 y = (x[j] * rstd) * gn[64 * j]; const f32x4 h = y * (sc[64 * j] + 1.f) + sh[64 * j];
            u32x2 w; w.x = cvt_pk_bf16(h.x, h.y); w.y = cvt_pk_bf16(h.z, h.w); o[64 * j] = w; }
    }
    }
}
__device__ __forceinline__ void phase_final(const Frame& F0) {
    Frame F = enter(F0);
    const float* X = (const float*)(F.ws + WS_X); const float* mod = (const float*)(F.ws + WS_MOD);
    for (int row = F.gw; row < ML; row += F.NGW) {
        const int v = row / SEQ;
        const f32x4* src = (const f32x4*)(X + (size_t)row * DM) + F.lane;
        const f32x4* g2 = (const f32x4*)(mod + ((size_t)3 * 5 + v) * 12288 + 5 * DM) + F.lane;
        f32x4 f[8]; ffn_row_load(F, 3, row, f);
        f32x4* dst = (f32x4*)(F.out + (size_t)row * DM) + F.lane;
#pragma unroll
        for (int j = 0; j < 8; ++j) __builtin_nontemporal_store(__builtin_nontemporal_load(src + 64 * j) + g2[64 * j] * f[j], dst + 64 * j);
    }
}
__device__ __forceinline__ void phase_normmod2(const Frame& F0, int l) {
    Frame F = enter(F0);
    const float* X = (const float*)(F.ws + WS_X); const float* mod = (const float*)(F.ws + WS_MOD);
    const bool moe = (l & 1) != 0; const int nrows = (l == DEPTH - 1) ? ML : MT;
    bf16_t* H = (bf16_t*)(F.ws + AR_H); bf16_t* H2S = (bf16_t*)(F.ws + AR_H2S);
    unsigned* cnt = (unsigned*)(F.ws + WS_CTL) + CW_CNT + (l >> 1) * 8 * 64;
    const float* router = F.in[I_ROUTER] + (size_t)(l >> 1) * DM * 8;
    f32x4 xn[8];
    { const f32x4* src = (const f32x4*)(X + (size_t)(F.gw < nrows ? F.gw : 0) * DM) + F.lane;
#pragma unroll
      for (int j = 0; j < 8; ++j) xn[j] = src[64 * j]; }
    for (int row = F.gw; row < nrows; row += F.NGW) {
        const int v = row < ML ? row / SEQ : 4;
        f32x4 x[8]; float ss = 0.f;
#pragma unroll
        for (int j = 0; j < 8; ++j) { x[j] = xn[j]; ss += (x[j].x * x[j].x + x[j].y * x[j].y) + (x[j].z * x[j].z + x[j].w * x[j].w); }
        { const int rn = row + F.NGW < nrows ? row + F.NGW : row; const f32x4* src = (const f32x4*)(X + (size_t)rn * DM) + F.lane;
#pragma unroll
          for (int j = 0; j < 8; ++j) xn[j] = __builtin_nontemporal_load(src + 64 * j); }
        const float rstd = 1.f / sqrtf(wave_sum(ss, F.lane) * (1.f / DM) + EPS);
        const f32x4* gn = (const f32x4*)(F.in[I_NORM2] + (size_t)l * DM) + F.lane;
        const f32x4* sh = (const f32x4*)(mod + ((size_t)l * 5 + v) * 12288 + 3 * DM) + F.lane;
        const f32x4* sc = (const f32x4*)(mod + ((size_t)l * 5 + v) * 12288 + 4 * DM) + F.lane;
        u32x2 hw[8];
#pragma unroll
        for (int j = 0; j < 8; ++j) { const f32x4 y = (x[j] * rstd) * gn[64 * j]; x[j] = y * (sc[64 * j] + 1.f) + sh[64 * j];
            hw[j].x = cvt_pk_bf16(x[j].x, x[j].y); hw[j].y = cvt_pk_bf16(x[j].z, x[j].w); }
        if (!moe) {
            u32x2* o = (u32x2*)(H + (size_t)row * DM) + F.lane;
#pragma unroll
            for (int j = 0; j < 8; ++j) o[64 * j] = hw[j];
        } else {
            float lg[8];
#pragma unroll
            for (int e = 0; e < 8; ++e) lg[e] = 0.f;
#pragma unroll
            for (int j = 0; j < 8; ++j) {
                const f32x4* rp = (const f32x4*)(router + (size_t)(4 * (F.lane + 64 * j)) * 8);
#pragma unroll
                for (int i = 0; i < 4; ++i) { const f32x4 r0 = rp[2 * i], r1 = rp[2 * i + 1]; const float xv = x[j][i];
                    lg[0] += xv * r0.x; lg[1] += xv * r0.y; lg[2] += xv * r0.z; lg[3] += xv * r0.w; lg[4] += xv * r1.x; lg[5] += xv * r1.y; lg[6] += xv * r1.z; lg[7] += xv * r1.w; }
            }
#pragma unroll
            for (int e = 0; e < 8; ++e) lg[e] = wave_sum(lg[e], F.lane);
            float v1 = lg[0]; int i1 = 0;
#pragma unroll
            for (int e = 1; e < 8; ++e) if (lg[e] > v1) { v1 = lg[e]; i1 = e; }
            float v2 = -3.0e38f; int i2 = -1;
#pragma unroll
            for (int e = 0; e < 8; ++e) if (e != i1 && lg[e] > v2) { v2 = lg[e]; i2 = e; }
            const float w2 = 1.f / (1.f + expf(v1 - v2)), w1 = 1.f - w2;
            int p1 = 0, p2 = 0;
            if (F.lane == 0) { p1 = (int)__hip_atomic_fetch_add(cnt + i1 * 64, 1u, __ATOMIC_RELAXED, __HIP_MEMORY_SCOPE_AGENT); p2 = (int)__hip_atomic_fetch_add(cnt + i2 * 64, 1u, __ATOMIC_RELAXED, __HIP_MEMORY_SCOPE_AGENT); }
            p1 = __builtin_amdgcn_readfirstlane(p1); p2 = __builtin_amdgcn_readfirstlane(p2);
            if (F.lane == 0) { int* ti = (int*)(F.ws + WS_TOK) + (size_t)row * 8; ti[0] = i1; ti[1] = p1; ti[2] = i2; ti[3] = p2; ti[4] = __float_as_int(w1); ti[5] = __float_as_int(w2); }
            u32x2* oa = (u32x2*)(H2S + ((size_t)i1 * CAP + p1) * DM) + F.lane;
            u32x2* ob = (u32x2*)(H2S + ((size_t)i2 * CAP + p2) * DM) + F.lane;
#pragma unroll
            for (int j = 0; j < 8; ++j) { oa[64 * j] = hw[j]; ob[64 * j] = hw[j]; }
        }
    }
}
__device__ __forceinline__ void phase_combine_transpose(const Frame& F0, int l) {
    Frame F = enter(F0);
    const bool last = (l == DEPTH - 1); const int nrows = last ? ML : MT;
    const unsigned* O = (const unsigned*)(F.ws + AR_O); bf16_t* YA = (bf16_t*)(F.ws + AR_YAN);
    const float lam = ((const float*)(F.ws + WS_LAM))[l];
    const float lam_init = 0.8f - 0.6f * expf(-0.3f * (float)l);
    const int c0 = 64 * (F.lane >> 4) + 2 * (F.lane & 15);
    const float* gs = F.in[I_SUBN] + l * 256;
    const float g00 = gs[c0], g01 = gs[c0 + 32], g10 = gs[c0 + 1], g11 = gs[c0 + 33];
    for (int it = F.gw; it < nrows * 8; it += F.NGW) {
        const int row = it >> 3, d = it & 7;
        const u32x2 a = __builtin_nontemporal_load((const u32x2*)(O + (size_t)row * 2048 + (2 * d) * 128) + F.lane), b = __builtin_nontemporal_load((const u32x2*)(O + (size_t)row * 2048 + (2 * d + 1) * 128) + F.lane);
        const float o00 = bf_lo(a.x) - lam * bf_lo(b.x), o01 = bf_hi(a.x) - lam * bf_hi(b.x), o10 = bf_lo(a.y) - lam * bf_lo(b.y), o11 = bf_hi(a.y) - lam * bf_hi(b.y);
        const float ss = wave_sum((o00 * o00 + o01 * o01) + (o10 * o10 + o11 * o11), F.lane);
        const float rstd = (1.f - lam_init) / sqrtf(ss * (1.f / 256.f) + EPS);
        bf16_t* yp = YA + (size_t)row * DM + d * 256 + c0;
        *(unsigned*)yp = cvt_pk_bf16(o00 * rstd * g00, o10 * rstd * g10);
        *(unsigned*)(yp + 32) = cvt_pk_bf16(o01 * rstd * g01, o11 * rstd * g11);
    }
    const bf16_t* YBT = (const bf16_t*)(F.ws + AR_YBT); bf16_t* YB = (bf16_t*)(F.ws + AR_YB);
    LAS bf16_t* scr = (LAS bf16_t*)(F.lds + F.wave * 16384);
    const int ntt = nrows / 64;
    for (int it = F.gw; it < 32 * ntt; it += F.NGW) {
        const int cb = it / ntt, tb = it % ntt;
#pragma unroll
        for (int i = 0; i < 8; ++i) { const int c = 8 * i + (F.lane >> 3), tq = F.lane & 7;
            const u32x4 w = *(const u32x4*)(YBT + (size_t)(cb * 64 + c) * MT + tb * 64 + tq * 8);
            LAS unsigned* d = (LAS unsigned*)(scr + c * 66 + tq * 8); d[0] = w.x; d[1] = w.y; d[2] = w.z; d[3] = w.w; }
        LDS_WAIT(); asm volatile("" ::: "memory");
#pragma unroll
        for (int i = 0; i < 8; ++i) { const int t = 8 * i + (F.lane >> 3), cq = F.lane & 7;
            unsigned short e[8];
#pragma unroll
            for (int k = 0; k < 8; ++k) e[k] = scr[(cq * 8 + k) * 66 + t];
            u32x4 o; o.x = e[0] | ((unsigned)e[1] << 16); o.y = e[2] | ((unsigned)e[3] << 16); o.z = e[4] | ((unsigned)e[5] << 16); o.w = e[6] | ((unsigned)e[7] << 16);
            *(u32x4*)(YB + (size_t)(tb * 64 + t) * DM + cb * 64 + cq * 8) = o; }
        LDS_WAIT(); asm volatile("" ::: "memory");
    }
}

namespace hy {
constexpr int UST = 4616, UBYTES = 4 * UST * 2, RLEN = 8704, RBYTES = RLEN * 2, CH_BYTES = UBYTES + RBYTES;
__device__ __forceinline__ int crow(int r, int hi) { return (r & 3) + 8 * (r >> 2) + 4 * hi; }

__device__ __forceinline__ void conv_pass(const LAS unsigned char* U, const LAS unsigned char* R, int j0, int lane, f32x16 (&acc)[4]) {
    const int n = lane & 31, hi = lane >> 5, b = n & 3, qp = n >> 2;
#pragma unroll
    for (int j = 0; j < 4; ++j) acc[j] = f32x16{};
    const int xl = 4352 - n + 8 * hi - 256 * j0 - 768;
    const unsigned sh = (unsigned)(xl & 1) << 4;
    const int ub = (b * UST + 256 + 32 * qp + 8 * hi) * 2;
#ifndef HY_PF
#define HY_PF 1
#endif
    for (int dp = 0; dp < 16; ++dp) {
        const LAS unsigned char* pG = U + ub - 32 * dp;
        const LAS unsigned* pA = (const LAS unsigned*)R + ((xl - 16 * dp) >> 1);
        bf16x8 Gw[6];
        unsigned ra[HY_PF + 1][5];
#pragma unroll
        for (int p = 0; p < HY_PF; ++p) {
            Gw[p] = *(const LAS bf16x8*)(pG + 512 * p);
#pragma unroll
            for (int k = 0; k < 5; ++k) ra[p][k] = pA[128 * p + k];
        }
#pragma unroll
        for (int e2 = 0; e2 < 20; ++e2) {
            if (e2 + HY_PF < 20) {
#pragma unroll
                for (int k = 0; k < 5; ++k) ra[(e2 + HY_PF) % (HY_PF + 1)][k] = pA[128 * (e2 + HY_PF) + k];
                if (e2 + HY_PF <= 16) Gw[(e2 + HY_PF) % 6] = *(const LAS bf16x8*)(pG + 512 * (e2 + HY_PF));
            }
            const unsigned (&rc)[5] = ra[e2 % (HY_PF + 1)];
            u32x4 w; w.x = __builtin_amdgcn_alignbit(rc[1], rc[0], sh); w.y = __builtin_amdgcn_alignbit(rc[2], rc[1], sh); w.z = __builtin_amdgcn_alignbit(rc[3], rc[2], sh); w.w = __builtin_amdgcn_alignbit(rc[4], rc[3], sh);
            const bf16x8 A = *reinterpret_cast<const bf16x8*>(&w);
#pragma unroll
            for (int j = 0; j < 4; ++j) { const int J = j + e2 - 3; if (J >= 0 && J <= 16) acc[j] = __builtin_amdgcn_mfma_f32_32x32x16_bf16(A, Gw[J % 6], acc[j], 0, 0, 0); }
            __builtin_amdgcn_sched_barrier(0);
        }
    }
}

__device__ __forceinline__ void conv4(const bf16_t* seq, int s0, int Ls, float w0, float w1, float w2, float bb, float (&y)[4]) {
    const u32x2 w = *(const u32x2*)(seq + s0);
    const float l = s0 > 0 ? bf2f(seq[s0 - 1]) : 0.f, r = (s0 + 4 < Ls) ? bf2f(seq[s0 + 4]) : 0.f;
    const float x0 = bf_lo(w.x), x1 = bf_hi(w.x), x2 = bf_lo(w.y), x3 = bf_hi(w.y);
    y[0] = l * w0 + x0 * w1 + x1 * w2 + bb; y[1] = x0 * w0 + x1 * w1 + x2 * w2 + bb; y[2] = x1 * w0 + x2 * w1 + x3 * w2 + bb; y[3] = x2 * w0 + x3 * w1 + r * w2 + bb;
}
__device__ __forceinline__ u32x4 conv8_pk(const bf16_t* seq, int s0, int Ls, float w0, float w1, float w2, float bb) {
    const u32x4 w = *(const u32x4*)(seq + s0);
    const float left = s0 > 0 ? bf2f(seq[s0 - 1]) : 0.f, right = (s0 + 8 < Ls) ? bf2f(seq[s0 + 8]) : 0.f;
    const float xv[10] = {left, bf_lo(w.x), bf_hi(w.x), bf_lo(w.y), bf_hi(w.y), bf_lo(w.z), bf_hi(w.z), bf_lo(w.w), bf_hi(w.w), right};
    float y[8];
#pragma unroll
    for (int k = 0; k < 8; ++k) y[k] = xv[k] * w0 + xv[k + 1] * w1 + xv[k + 2] * w2 + bb;
    u32x4 o; o.x = cvt_pk_bf16(y[0], y[1]); o.y = cvt_pk_bf16(y[2], y[3]); o.z = cvt_pk_bf16(y[4], y[5]); o.w = cvt_pk_bf16(y[6], y[7]); return o;
}
typedef unsigned u32x4_a4 __attribute__((ext_vector_type(4), aligned(4)));
__device__ __forceinline__ u32x4 conv4_load(const bf16_t* seq, int s0) { const u32x4_a4 w = *(const u32x4_a4*)(seq + s0 - 2); return (u32x4){w.x, w.y, w.z, w.w}; }
__device__ __forceinline__ void conv4_eval(const u32x4 w, int s0, int Ls, float w0, float w1, float w2, float bb, float (&y)[4]) {
    const float l = s0 > 0 ? bf_hi(w.x) : 0.f, r = (s0 + 4 < Ls) ? bf_lo(w.w) : 0.f;
    const float x0 = bf_lo(w.y), x1 = bf_hi(w.y), x2 = bf_lo(w.z), x3 = bf_hi(w.z);
    y[0] = l * w0 + x0 * w1 + x1 * w2 + bb; y[1] = x0 * w0 + x1 * w1 + x2 * w2 + bb; y[2] = x1 * w0 + x2 * w1 + x3 * w2 + bb; y[3] = x2 * w0 + x3 * w1 + r * w2 + bb;
}
struct Conv8Raw { u32x4 w; unsigned lw, rw; };
__device__ __forceinline__ Conv8Raw conv8_load(const bf16_t* seq, int s0) { Conv8Raw r; r.w = *(const u32x4*)(seq + s0); r.lw = *(const unsigned*)(seq + s0 - 2); r.rw = *(const unsigned*)(seq + s0 + 8); return r; }
__device__ __forceinline__ u32x4 conv8_eval(const Conv8Raw& q, int s0, int Ls, float w0, float w1, float w2, float bb) {
    const u32x4 w = q.w;
    const float left = s0 > 0 ? bf_hi(q.lw) : 0.f, right = (s0 + 8 < Ls) ? bf_lo(q.rw) : 0.f;
    const float xv[10] = {left, bf_lo(w.x), bf_hi(w.x), bf_lo(w.y), bf_hi(w.y), bf_lo(w.z), bf_hi(w.z), bf_lo(w.w), bf_hi(w.w), right};
    float y[8];
#pragma unroll
    for (int k = 0; k < 8; ++k) y[k] = xv[k] * w0 + xv[k + 1] * w1 + xv[k + 2] * w2 + bb;
    u32x4 o; o.x = cvt_pk_bf16(y[0], y[1]); o.y = cvt_pk_bf16(y[2], y[3]); o.z = cvt_pk_bf16(y[4], y[5]); o.w = cvt_pk_bf16(y[6], y[7]); return o;
}
struct ConvW { float w0, w1, w2, bb; };
__device__ __forceinline__ ConvW conv_w(const Frame& F, int l, int cc) {
    ConvW w; w.w0 = F.in[I_HCW][((size_t)l * 3 + 0) * HYW + cc]; w.w1 = F.in[I_HCW][((size_t)l * 3 + 1) * HYW + cc]; w.w2 = F.in[I_HCW][((size_t)l * 3 + 2) * HYW + cc]; w.bb = F.in[I_HCB][(size_t)l * HYW + cc]; return w;
}

__device__ __forceinline__ void pair_body(Frame& F, int l, int c0, bool first) {
    const int tidq = opaque(F.tid); const int ch = F.wave >> 2, j0 = 4 * (F.wave & 3), c = c0 + ch, ltid = tidq & 255, lane = tidq & 63;
    LAS unsigned char* U = F.lds + ch * CH_BYTES; LAS unsigned char* R = U + UBYTES;
    const bf16_t* uT = (const bf16_t*)(F.ws + AR_UT);
    const bf16_t* vrow = uT + (size_t)c * MT, *x1row = uT + (size_t)(2048 + c) * MT, *x2row = uT + (size_t)(4096 + c) * MT;
    const bf16_t* Rg = (const bf16_t*)(F.ws + WS_R) + (((size_t)l * 2 + 0) * 2048 + c) * RLEN;
    const bf16_t* Rg2 = (const bf16_t*)(F.ws + WS_R) + (((size_t)l * 2 + 1) * 2048 + c) * RLEN;
    const float bias0 = F.in[I_HBIAS][((size_t)l * 2 + 0) * 2048 + c], bias1 = F.in[I_HBIAS][((size_t)l * 2 + 1) * 2048 + c];
    if (first) {
        for (int i = ltid; i < 4 * 65; i += 256) { const int b = i / 65, k = i % 65; const int el = k < 32 ? k * 8 : 4352 + (k - 32) * 8;
            *(LAS u32x4*)(U + (b * UST + el) * 2) = (u32x4){0u, 0u, 0u, 0u}; }
    }
    { const ConvW cw = conv_w(F, l, c); Conv8Raw raw[8];
#pragma unroll
      for (int k = 0; k < 8; ++k) { const int q = ltid + 256 * k, tok = 8 * q, b = tok >> 12, s = tok & 4095; raw[k] = conv8_load(vrow + b * SEQ, s); }
#pragma unroll
      for (int k = 0; k < 8; ++k) { const int q = ltid + 256 * k, tok = 8 * q, b = tok >> 12, s = tok & 4095;
        *(LAS u32x4*)(U + (b * UST + 256 + s) * 2) = conv8_eval(raw[k], s, SEQ, cw.w0, cw.w1, cw.w2, cw.bb); } }
    { u32x4 rr[5];
#pragma unroll
      for (int k = 0; k < 5; ++k) { const int q = ltid + 256 * k; if (q < RBYTES / 16) rr[k] = *(const u32x4*)((const char*)Rg + q * 16); }
#pragma unroll
      for (int k = 0; k < 5; ++k) { const int q = ltid + 256 * k; if (q < RBYTES / 16) *(LAS u32x4*)(R + q * 16) = rr[k]; } }
    __syncthreads();
    f32x16 acc[4];
    conv_pass(U, R, j0, lane, acc);
    const int n = lane & 31, hi = lane >> 5, b = n & 3, qp = n >> 2;
    u32x2 zp[4][4];
    { const ConvW cw = conv_w(F, l, 2048 + c); u32x4 xr[4][4];
#pragma unroll
    for (int j = 0; j < 4; ++j)
#pragma unroll
        for (int g = 0; g < 4; ++g) xr[j][g] = conv4_load(x1row + b * SEQ, 32 * (8 * (j0 + j) + qp) + 8 * g + 4 * hi);
#pragma unroll
    for (int j = 0; j < 4; ++j)
#pragma unroll
        for (int g = 0; g < 4; ++g) {
            const int t0 = 32 * (8 * (j0 + j) + qp) + 8 * g + 4 * hi;
            const u32x2 vv = *(const LAS u32x2*)(U + (b * UST + 256 + t0) * 2);
            float xx[4]; conv4_eval(xr[j][g], t0, SEQ, cw.w0, cw.w1, cw.w2, cw.bb, xx);
            const float z0 = xx[0] * (acc[j][4 * g + 0] + bias0 * bf_lo(vv.x)), z1 = xx[1] * (acc[j][4 * g + 1] + bias0 * bf_hi(vv.x));
            const float z2 = xx[2] * (acc[j][4 * g + 2] + bias0 * bf_lo(vv.y)), z3 = xx[3] * (acc[j][4 * g + 3] + bias0 * bf_hi(vv.y));
            zp[j][g].x = cvt_pk_bf16(z0, z1); zp[j][g].y = cvt_pk_bf16(z2, z3);
        } }
    __syncthreads();
#pragma unroll
    for (int j = 0; j < 4; ++j)
#pragma unroll
        for (int g = 0; g < 4; ++g) { const int t0 = 32 * (8 * (j0 + j) + qp) + 8 * g + 4 * hi; *(LAS u32x2*)(U + (b * UST + 256 + t0) * 2) = zp[j][g]; }
    { u32x4 rr[5];
#pragma unroll
      for (int k = 0; k < 5; ++k) { const int q = ltid + 256 * k; if (q < RBYTES / 16) rr[k] = *(const u32x4*)((const char*)Rg2 + q * 16); }
#pragma unroll
      for (int k = 0; k < 5; ++k) { const int q = ltid + 256 * k; if (q < RBYTES / 16) *(LAS u32x4*)(R + q * 16) = rr[k]; } }
    __syncthreads();
    conv_pass(U, R, j0, lane, acc);
    bf16_t* yrow = (bf16_t*)(F.ws + AR_YBT) + (size_t)c * MT;
    { const ConvW cw = conv_w(F, l, 4096 + c); u32x4 xr[4][4];
#pragma unroll
    for (int j = 0; j < 4; ++j)
#pragma unroll
        for (int g = 0; g < 4; ++g) xr[j][g] = conv4_load(x2row + b * SEQ, 32 * (8 * (j0 + j) + qp) + 8 * g + 4 * hi);
#pragma unroll
    for (int j = 0; j < 4; ++j)
#pragma unroll
        for (int g = 0; g < 4; ++g) {
            const int t0 = 32 * (8 * (j0 + j) + qp) + 8 * g + 4 * hi;
            const u32x2 zz = *(const LAS u32x2*)(U + (b * UST + 256 + t0) * 2);
            float xx[4]; conv4_eval(xr[j][g], t0, SEQ, cw.w0, cw.w1, cw.w2, cw.bb, xx);
            const float y0 = xx[0] * (acc[j][4 * g + 0] + bias1 * bf_lo(zz.x)), y1 = xx[1] * (acc[j][4 * g + 1] + bias1 * bf_hi(zz.x));
            const float y2 = xx[2] * (acc[j][4 * g + 2] + bias1 * bf_lo(zz.y)), y3 = xx[3] * (acc[j][4 * g + 3] + bias1 * bf_hi(zz.y));
            u32x2 o; o.x = cvt_pk_bf16(y0, y1); o.y = cvt_pk_bf16(y2, y3);
            *(u32x2*)(yrow + b * SEQ + t0) = o;
        } }
    __syncthreads();
}
constexpr int UCST = 776, UCBYTES = 4 * UCST * 2;
__device__ __forceinline__ f32x16 ctx_conv_pass(const LAS unsigned char* U, const LAS unsigned char* R, int lane) {
    const int n = lane & 31, hi = lane >> 5, b = n & 3, qp = n >> 2;
    f32x16 acc = f32x16{};
    const int xl = 512 + 240 - n + 8 * hi;
    const unsigned sh = (unsigned)(xl & 1) << 4;
    const LAS unsigned* pA = (const LAS unsigned*)R + (xl >> 1);
    const LAS unsigned char* pG = U + (b * UCST + 256 + 240 + 32 * qp + 8 * hi) * 2;
#pragma unroll
    for (int e = 0; e < 31; ++e) {
        const LAS unsigned* p = pA - 8 * e;
        const unsigned d0 = p[0], d1 = p[1], d2 = p[2], d3 = p[3], d4 = p[4];
        u32x4 w; w.x = __builtin_amdgcn_alignbit(d1, d0, sh); w.y = __builtin_amdgcn_alignbit(d2, d1, sh); w.z = __builtin_amdgcn_alignbit(d3, d2, sh); w.w = __builtin_amdgcn_alignbit(d4, d3, sh);
        const bf16x8 G = *(const LAS bf16x8*)(pG - 32 * e);
        acc = __builtin_amdgcn_mfma_f32_32x32x16_bf16(*reinterpret_cast<const bf16x8*>(&w), G, acc, 0, 0, 0);
    }
    return acc;
}
__device__ __forceinline__ void ctx_body(Frame& F, int l, int c) {
    const int lane = opaque(F.tid) & 63;
    LAS unsigned char* U = F.lds + F.wave * 16384; LAS unsigned char* R = U + UCBYTES;
    const bf16_t* uT = (const bf16_t*)(F.ws + AR_UT);
    const bf16_t* vrow = uT + (size_t)c * MT + ML, *x1row = uT + (size_t)(2048 + c) * MT + ML, *x2row = uT + (size_t)(4096 + c) * MT + ML;
    const bf16_t* R1 = (const bf16_t*)(F.ws + WS_RC) + (((size_t)l * 2 + 0) * 2048 + c) * 1024, *R2 = (const bf16_t*)(F.ws + WS_RC) + (((size_t)l * 2 + 1) * 2048 + c) * 1024;
    const float bias0 = F.in[I_HBIAS][((size_t)l * 2 + 0) * 2048 + c], bias1 = F.in[I_HBIAS][((size_t)l * 2 + 1) * 2048 + c];
    for (int i = lane; i < 4 * 65; i += 64) { const int b = i / 65, k = i % 65; const int el = k < 32 ? k * 8 : 512 + (k - 32) * 8;
        *(LAS u32x4*)(U + (b * UCST + el) * 2) = (u32x4){0u, 0u, 0u, 0u}; }
    { const ConvW cw = conv_w(F, l, c);
#pragma unroll
      for (int k = 0; k < 2; ++k) { const int q = lane + 64 * k, b = q >> 5, s = (q & 31) * 8;
        *(LAS u32x4*)(U + (b * UCST + 256 + s) * 2) = conv8_pk(vrow + b * LC, s, LC, cw.w0, cw.w1, cw.w2, cw.bb); } }
#pragma unroll
    for (int k = 0; k < 2; ++k) *(LAS u32x4*)(R + (lane + 64 * k) * 16) = *(const u32x4*)((const char*)R1 + (lane + 64 * k) * 16);
    LDS_WAIT(); asm volatile("" ::: "memory");
    f32x16 acc = ctx_conv_pass(U, R, lane);
    const int n = lane & 31, hi = lane >> 5, b = n & 3, qp = n >> 2;
    u32x2 zp[4];
    { const ConvW cw = conv_w(F, l, 2048 + c);
#pragma unroll
      for (int g = 0; g < 4; ++g) { const int t0 = 32 * qp + 8 * g + 4 * hi;
        const u32x2 vv = *(const LAS u32x2*)(U + (b * UCST + 256 + t0) * 2);
        float xx[4]; conv4(x1row + b * LC, t0, LC, cw.w0, cw.w1, cw.w2, cw.bb, xx);
        zp[g].x = cvt_pk_bf16(xx[0] * (acc[4 * g + 0] + bias0 * bf_lo(vv.x)), xx[1] * (acc[4 * g + 1] + bias0 * bf_hi(vv.x)));
        zp[g].y = cvt_pk_bf16(xx[2] * (acc[4 * g + 2] + bias0 * bf_lo(vv.y)), xx[3] * (acc[4 * g + 3] + bias0 * bf_hi(vv.y))); } }
    LDS_WAIT(); asm volatile("" ::: "memory");
#pragma unroll
    for (int g = 0; g < 4; ++g) { const int t0 = 32 * qp + 8 * g + 4 * hi; *(LAS u32x2*)(U + (b * UCST + 256 + t0) * 2) = zp[g]; }
#pragma unroll
    for (int k = 0; k < 2; ++k) *(LAS u32x4*)(R + (lane + 64 * k) * 16) = *(const u32x4*)((const char*)R2 + (lane + 64 * k) * 16);
    LDS_WAIT(); asm volatile("" ::: "memory");
    acc = ctx_conv_pass(U, R, lane);
    bf16_t* yrow = (bf16_t*)(F.ws + AR_YBT) + (size_t)c * MT + ML;
    { const ConvW cw = conv_w(F, l, 4096 + c);
#pragma unroll
      for (int g = 0; g < 4; ++g) { const int t0 = 32 * qp + 8 * g + 4 * hi;
        const u32x2 zz = *(const LAS u32x2*)(U + (b * UCST + 256 + t0) * 2);
        float xx[4]; conv4(x2row + b * LC, t0, LC, cw.w0, cw.w1, cw.w2, cw.bb, xx);
        u32x2 o; o.x = cvt_pk_bf16(xx[0] * (acc[4 * g + 0] + bias1 * bf_lo(zz.x)), xx[1] * (acc[4 * g + 1] + bias1 * bf_hi(zz.x)));
        o.y = cvt_pk_bf16(xx[2] * (acc[4 * g + 2] + bias1 * bf_lo(zz.y)), xx[3] * (acc[4 * g + 3] + bias1 * bf_hi(zz.y)));
        *(u32x2*)(yrow + b * LC + t0) = o; } }
    LDS_WAIT(); asm volatile("" ::: "memory");
}
}

__device__ __forceinline__ void phase_mixers(const Frame& F0, int l) {
    Frame F = enter(F0);
    const bool last = (l == DEPTH - 1);
    const bf16_t* Q = (const bf16_t*)(F.ws + AR_Q); const bf16_t* Kc = (const bf16_t*)(F.ws + AR_KC); const bf16_t* Vc = (const bf16_t*)(F.ws + AR_VC); unsigned* O = (unsigned*)(F.ws + AR_O);
#ifndef NO_ATT
    const int nitems = NB * 16 * 16 + (last ? 0 : NB * 16);
    const int nrep_a = (PROBE == 1) ? 2 : 1;
    for (int itx = F.bid; itx < nitems * nrep_a; itx += F.G) { const int it = itx % nitems;
        int h, b, seq; size_t row0;
        if (it < 1024) {
            const int x = it & 7, rk = (it >> 3) & 31, qb = rk & 15; h = 2 * x + (rk >> 4); b = it >> 8; row0 = (size_t)b * SEQ + qb * 256; seq = SKV; }
        else { const int i2 = it - 1024; h = i2 & 15; b = i2 >> 4; row0 = (size_t)ML + b * LC; seq = LC; }
        att::attn_dense_body(Q + row0 * DM + h * 128, Kc + (size_t)b * SKV * DM + h * 128, Vc + (size_t)b * SKV * DM + (h >> 1) * 256, O + row0 * 2048 + h * 128, seq, F.ldsg, F.wave);
        __syncthreads();
    }
#endif
#ifndef NO_HY
    bool first = true;
    const int nrep_h = (PROBE == 2) ? 2 : 1;
    for (int itx = F.bid; itx < 1024 * nrep_h; itx += F.G) { const int it = itx & 1023; hy::pair_body(F, l, 2 * it, first); first = false; }
#ifndef NO_HYC
    if (!last) for (int cx = F.gw; cx < 2048 * ((PROBE == 9) ? 2 : 1); cx += F.NGW) { const int c = cx & 2047; hy::ctx_body(F, l, c); }
#endif
#endif
}

using pg8::Unit;
constexpr int HALF = 128;
struct EpiBf16Plain {
    static constexpr bool PERM = true, CARRY = false;
    bf16_t* O; int ldc;
    __device__ __forceinline__ void operator()(const f32x4 (&acc)[2][2][4][2], const Unit& u, int wr, int wc, int fr, int fq) const {
        const int row0 = u.pm * 256 + wr * 64 + fr, col0 = u.pn * 256 + wc * 32 + 8 * fq;
#pragma unroll
        for (int ai = 0; ai < 2; ++ai)
#pragma unroll
            for (int m = 0; m < 4; ++m) { bf16_t* rowp = O + (size_t)(row0 + ai * HALF + m * 16) * ldc + col0;
#pragma unroll
                for (int bj = 0; bj < 2; ++bj) { const f32x4 v0 = acc[ai][bj][m][0], v1 = acc[ai][bj][m][1];
                    u32x4 w; w.x = cvt_pk_bf16(v0[0], v0[1]); w.y = cvt_pk_bf16(v0[2], v0[3]); w.z = cvt_pk_bf16(v1[0], v1[1]); w.w = cvt_pk_bf16(v1[2], v1[3]);
                    __builtin_nontemporal_store(w, (u32x4*)(rowp + bj * HALF)); } }
    }
};
struct EpiInProj {
    static constexpr bool PERM = true, CARRY = false;
    bf16_t *Q, *K, *V, *G; const float* bgate; const float* qgain; const float* kgain; const LAS float* rope; LAS unsigned char* lds;
    __device__ __forceinline__ void operator()(const f32x4 (&acc)[2][2][4][2], const Unit& u, int wr, int wc, int fr, int fq) const {
        const int pn = u.pn;
        if (pn < 16) {
            const bool isk = pn >= 8; const bool lat = u.pm < 64;
            LAS float* P = (LAS float*)lds;
#pragma unroll
            for (int ai = 0; ai < 2; ++ai)
#pragma unroll
                for (int m = 0; m < 4; ++m)
#pragma unroll
                    for (int bj = 0; bj < 2; ++bj) { const f32x4 a = acc[ai][bj][m][0], b = acc[ai][bj][m][1];
                        float ss = (a[0] * a[0] + a[1] * a[1]) + (a[2] * a[2] + a[3] * a[3]) + (b[0] * b[0] + b[1] * b[1]) + (b[2] * b[2] + b[3] * b[3]);
                        ss += shx(ss, 16, fr + 16 * fq); ss += shx(ss, 32, fr + 16 * fq);
                        if (fq == 0) P[((wr * 2 + bj) * 128 + ai * 64 + m * 16 + fr) * 4 + wc] = ss; }
            asm volatile("s_waitcnt lgkmcnt(0)" ::: "memory"); __builtin_amdgcn_s_barrier(); asm volatile("" ::: "memory");
            const int axis = wc >> 1, f0 = 16 * (wc & 1) + 4 * fq, d0 = 64 * axis + f0;
            const float* gp = isk ? kgain : qgain;
            const f32x4 g0 = *(const f32x4*)(gp + d0), g1 = *(const f32x4*)(gp + d0 + 32);
            const int rowt = isk ? (lat ? (u.pm >> 4) * SKV + LC + (u.pm & 15) * 256 : (u.pm - 64) * SKV) : u.pm * 256;
            bf16_t* base = (isk ? K : Q) + (size_t)(rowt + wr * 64 + fr) * DM + (isk ? pn - 8 : pn) * 256 + wc * 32 + 8 * fq;
#pragma unroll
            for (int ai = 0; ai < 2; ++ai)
#pragma unroll
                for (int m = 0; m < 4; ++m) {
                    f32x4 cs = (f32x4){1.f, 1.f, 1.f, 1.f}, sn = (f32x4){0.f, 0.f, 0.f, 0.f};
                    if (lat) { const int pos = axis ? (16 * m + fr) : (4 * (u.pm & 15) + 2 * ai + wr); cs = *(const LAS f32x4*)(rope + pos * 32 + f0); sn = *(const LAS f32x4*)(rope + 2048 + pos * 32 + f0); }
#pragma unroll
                    for (int bj = 0; bj < 2; ++bj) {
                        const f32x4 pp = *(const LAS f32x4*)(P + ((wr * 2 + bj) * 128 + ai * 64 + m * 16 + fr) * 4);
                        const float rstd = __builtin_amdgcn_rsqf(((pp[0] + pp[1]) + (pp[2] + pp[3])) * (1.f / 128.f) + EPS);
                        const f32x4 a = (acc[ai][bj][m][0] * rstd) * g0, b = (acc[ai][bj][m][1] * rstd) * g1;
                        const f32x4 ra = a * cs - b * sn, rb = a * sn + b * cs;
                        u32x4 w; w.x = cvt_pk_bf16(ra[0], ra[1]); w.y = cvt_pk_bf16(ra[2], ra[3]); w.z = cvt_pk_bf16(rb[0], rb[1]); w.w = cvt_pk_bf16(rb[2], rb[3]);
                        *(u32x4*)(base + (size_t)(ai * HALF + m * 16) * DM + bj * HALF) = w; } }
            return;
        }
        bf16_t* basep; int ldc = DM, colt; int rowt = u.pm * 256; const bool gate = pn >= 24;
        if (pn < 24) { basep = V; colt = (pn - 16) * 256; rowt = u.pm < 64 ? (u.pm >> 4) * SKV + LC + (u.pm & 15) * 256 : (u.pm - 64) * SKV; }
        else { basep = G; colt = (pn - 24) * 256; ldc = 4096; }
        const int row0 = rowt + wr * 64 + fr, col0 = colt + wc * 32 + 8 * fq;
        f32x4 bv[2][2];
#pragma unroll
        for (int bj = 0; bj < 2; ++bj)
#pragma unroll
            for (int n = 0; n < 2; ++n) bv[bj][n] = gate ? *(const f32x4*)(bgate + col0 + bj * HALF + 4 * n) : (f32x4){0.f, 0.f, 0.f, 0.f};
#pragma unroll
        for (int ai = 0; ai < 2; ++ai)
#pragma unroll
            for (int m = 0; m < 4; ++m) { bf16_t* rowp = basep + (size_t)(row0 + ai * HALF + m * 16) * ldc + col0;
#pragma unroll
                for (int bj = 0; bj < 2; ++bj) { f32x4 v0 = acc[ai][bj][m][0] + bv[bj][0], v1 = acc[ai][bj][m][1] + bv[bj][1];
                    if (gate) {
#pragma unroll
                        for (int i = 0; i < 4; ++i) { v0[i] = __builtin_amdgcn_rcpf(1.f + __expf(-v0[i])); v1[i] = __builtin_amdgcn_rcpf(1.f + __expf(-v1[i])); } }
                    u32x4 w; w.x = cvt_pk_bf16(v0[0], v0[1]); w.y = cvt_pk_bf16(v0[2], v0[3]); w.z = cvt_pk_bf16(v1[0], v1[1]); w.w = cvt_pk_bf16(v1[2], v1[3]);
                    *(u32x4*)(rowp + bj * HALF) = w; } }
    }
};
struct EpiMergePair {
    static constexpr bool PERM = true, CARRY = true;
    const bf16_t* gates; bf16_t* Mo;
    __device__ __forceinline__ bool carry(f32x4 (&acc)[2][2][4][2], const Unit& u, int wr, int wc, int fr, int fq) const {
        const int row0 = u.pm * 256 + wr * 64 + fr, col0 = u.pn * 256 + wc * 32 + 8 * fq;
        const bf16_t* gbase = gates + (size_t)row0 * 4096 + col0;
#define MP_ROW(i) ((size_t)((((i) >> 3) * HALF) + (((i) >> 1) & 3) * 16))
#define MP_G(i, off) (*(const u32x4*)(gbase + MP_ROW(i) * 4096 + ((i) & 1) * HALF + (off)))
#define MP_UNPK(WV, FV) const float FV[8] = {bf_lo(WV.x), bf_hi(WV.x), bf_lo(WV.y), bf_hi(WV.y), bf_lo(WV.z), bf_hi(WV.z), bf_lo(WV.w), bf_hi(WV.w)}
        if (u.kind == 0) {
            u32x4 ga_[2][4], gb_[2][4];
#pragma unroll
            for (int k = 0; k < 4; ++k) { ga_[0][k] = MP_G(k, 0); gb_[0][k] = MP_G(k, DM); }
#pragma unroll
            for (int b = 0; b < 4; ++b) {
                if (b + 1 < 4) {
#pragma unroll
                    for (int k = 0; k < 4; ++k) { ga_[(b + 1) & 1][k] = MP_G(4 * (b + 1) + k, 0); gb_[(b + 1) & 1][k] = MP_G(4 * (b + 1) + k, DM); } }
#pragma unroll
                for (int k = 0; k < 4; ++k) { const int i = 4 * b + k, ai = i >> 3, m = (i >> 1) & 3, bj = i & 1;
                    MP_UNPK(ga_[b & 1][k], ga); MP_UNPK(gb_[b & 1][k], gb);
#pragma unroll
                    for (int e = 0; e < 4; ++e) { acc[ai][bj][m][0][e] *= ga[e] * __builtin_amdgcn_rcpf(gb[e]); acc[ai][bj][m][1][e] *= ga[4 + e] * __builtin_amdgcn_rcpf(gb[4 + e]); } }
            }
            return true;
        }
        u32x4 gb_[2][4];
#pragma unroll
        for (int k = 0; k < 4; ++k) gb_[0][k] = MP_G(k, DM);
        bf16_t* mbase = Mo + (size_t)row0 * DM + col0;
#pragma unroll
        for (int b = 0; b < 4; ++b) {
            if (b + 1 < 4) {
#pragma unroll
                for (int k = 0; k < 4; ++k) gb_[(b + 1) & 1][k] = MP_G(4 * (b + 1) + k, DM); }
#pragma unroll
            for (int k = 0; k < 4; ++k) { const int i = 4 * b + k, ai = i >> 3, m = (i >> 1) & 3, bj = i & 1;
                MP_UNPK(gb_[b & 1][k], gb); const f32x4 v0 = acc[ai][bj][m][0], v1 = acc[ai][bj][m][1];
                u32x4 w; w.x = cvt_pk_bf16(v0[0] * gb[0], v0[1] * gb[1]); w.y = cvt_pk_bf16(v0[2] * gb[2], v0[3] * gb[3]); w.z = cvt_pk_bf16(v1[0] * gb[4], v1[1] * gb[5]); w.w = cvt_pk_bf16(v1[2] * gb[6], v1[3] * gb[7]);
                *(u32x4*)(mbase + MP_ROW(i) * DM + bj * HALF) = w; }
        }
        return false;
#undef MP_ROW
#undef MP_G
#undef MP_UNPK
    }
};
struct EpiInProjDual {
    static constexpr bool PERM = true, CARRY = false;
    EpiInProj e1; EpiBf16Plain e2;
    __device__ __forceinline__ void operator()(const f32x4 (&acc)[2][2][4][2], const Unit& u, int wr, int wc, int fr, int fq) const { if (u.kind == 0) e1(acc, u, wr, wc, fr, fq); else e2(acc, u, wr, wc, fr, fq); }
};
struct EpiOut {
    static constexpr bool PERM = false, CARRY = false;
    float* X; const float* mod_l;
    __device__ __forceinline__ void operator()(const f32x4 (&acc)[2][2][4][2], const Unit& u, int wr, int wc, int fr, int fq) const {
        const int row0 = u.pm * 256 + wr * 64 + fr, col0 = u.pn * 256 + wc * 32 + 4 * fq;
        const int v = u.pm < 64 ? (u.pm >> 4) : 4; const float* g1 = mod_l + (size_t)v * 12288 + 2 * DM;
        f32x4 gv[2][2];
#pragma unroll
        for (int bj = 0; bj < 2; ++bj)
#pragma unroll
            for (int n = 0; n < 2; ++n) gv[bj][n] = *(const f32x4*)(g1 + col0 + bj * HALF + n * 16);
        float* base = X + (size_t)row0 * DM + col0;
        f32x4 xa[8], xb[8];
#define EO_P(b, c, bj, n) ((f32x4*)(base + (size_t)((((2 * (b) + (c)) >> 2) * HALF) + ((2 * (b) + (c)) & 3) * 16) * DM + (bj) * HALF + (n) * 16))
#define EO_LOAD(b, dst) do { _Pragma("unroll") for (int c = 0; c < 2; ++c) _Pragma("unroll") for (int bj = 0; bj < 2; ++bj) _Pragma("unroll") for (int n = 0; n < 2; ++n) dst[c * 4 + bj * 2 + n] = *EO_P(b, c, bj, n); } while (0)
#define EO_STORE(b, src) do { _Pragma("unroll") for (int c = 0; c < 2; ++c) _Pragma("unroll") for (int bj = 0; bj < 2; ++bj) _Pragma("unroll") for (int n = 0; n < 2; ++n) \
        *EO_P(b, c, bj, n) = src[c * 4 + bj * 2 + n] + gv[bj][n] * acc[(2 * (b) + c) >> 2][bj][(2 * (b) + c) & 3][n]; } while (0)
        EO_LOAD(0, xa);
        EO_LOAD(1, xb); EO_STORE(0, xa);
        EO_LOAD(2, xa); EO_STORE(1, xb);
        EO_LOAD(3, xb); EO_STORE(2, xa);
        EO_STORE(3, xb);
#undef EO_P
#undef EO_LOAD
#undef EO_STORE
    }
};
struct EpiDownSlab {
    static constexpr bool PERM = false, CARRY = false;
    float* YSC;
    __device__ __forceinline__ void operator()(const f32x4 (&acc)[2][2][4][2], const Unit& u, int wr, int wc, int fr, int fq) const {
        const int row0 = (u.pm - 64) * 256 + wr * 64 + fr, col0 = u.pn * 256 + wc * 32 + 4 * fq; float* base = YSC + (size_t)u.kind * MC * DM;
#pragma unroll
        for (int ai = 0; ai < 2; ++ai)
#pragma unroll
            for (int m = 0; m < 4; ++m)
#pragma unroll
                for (int bj = 0; bj < 2; ++bj)
#pragma unroll
                    for (int n = 0; n < 2; ++n) *(f32x4*)(base + (size_t)(row0 + ai * HALF + m * 16) * DM + col0 + bj * HALF + n * 16) = acc[ai][bj][m][n];
    }
};
struct EpiUp {
    static constexpr bool PERM = true, CARRY = false;
    bf16_t* act;
    __device__ __forceinline__ void operator()(const f32x4 (&acc)[2][2][4][2], const Unit& u, int wr, int wc, int fr, int fq) const {
        const int row0 = u.pm * 256 + wr * 64 + fr, col0 = u.pn * 128 + wc * 32 + 8 * fq;
#pragma unroll
        for (int ai = 0; ai < 2; ++ai)
#pragma unroll
            for (int m = 0; m < 4; ++m) { bf16_t* rowp = act + (size_t)(row0 + ai * HALF + m * 16) * DFF + col0;
                f32x4 r[2];
#pragma unroll
                for (int n = 0; n < 2; ++n)
#pragma unroll
                    for (int i = 0; i < 4; ++i) { const float a = acc[ai][0][m][n][i], b = acc[ai][1][m][n][i]; r[n][i] = a * b * __builtin_amdgcn_rcpf(1.f + __expf(-a)); }
                u32x4 w; w.x = cvt_pk_bf16(r[0][0], r[0][1]); w.y = cvt_pk_bf16(r[0][2], r[0][3]); w.z = cvt_pk_bf16(r[1][0], r[1][1]); w.w = cvt_pk_bf16(r[1][2], r[1][3]);
                __builtin_nontemporal_store(w, (u32x4*)rowp); }
    }
};

__device__ __forceinline__ void moe_tables(const Frame& F0, int l) {
    Frame F = enter(F0);
    LAS int* tab = (LAS int*)(F.lds + LDS_TAB);
    if (F.tid == 0) { const unsigned* cnt = (const unsigned*)(F.ws + WS_CTL) + CW_CNT + (l >> 1) * 8 * 64; int p = 0;
        for (int e = 0; e < 8; ++e) { const int t = ((int)__hip_atomic_load(cnt + e * 64, __ATOMIC_RELAXED, __HIP_MEMORY_SCOPE_AGENT) + 255) >> 8; tab[e] = t; tab[8 + e] = p; p += t; }
        tab[16] = p; }
    __syncthreads();
}

constexpr int PH_PER_LAYER = 9, N_PHASES = 2 + DEPTH * PH_PER_LAYER + 1;

__global__ void __launch_bounds__(NTHR, 2) mega(Args args) {
    extern __shared__ __attribute__((aligned(16))) unsigned char lds_raw[];
    Frame F0;
    F0.lds = (LAS unsigned char*)lds_raw; F0.ldsg = (char*)lds_raw;
    F0.in = args.in; F0.out = args.out; F0.ws = args.ws;
    F0.tid = threadIdx.x; F0.lane = F0.tid & 63; F0.wave = __builtin_amdgcn_readfirstlane(F0.tid >> 6);
    F0.G = gridDim.x; F0.bid = blockIdx.x; F0.gw = F0.bid * NWAVES + F0.wave; F0.NGW = F0.G * NWAVES;
    volatile LAS unsigned* MISC = (volatile LAS unsigned*)(F0.lds + LDS_TAB + 1024);
    if (F0.tid < 8) MISC[F0.tid] = 0u;
    __syncthreads();
#if MK_ONE_LAUNCH
    XcdBarrier bar = xcd_barrier_post((unsigned*)(F0.ws + WS_CTL) + CW_BAR, MISC, F0.wave);
#define GRID_BAR() xcd_barrier(bar)
#else
#define GRID_BAR() do {} while (0)
#endif
    const int lo = args.ph_lo, hi = args.ph_hi;
#ifndef AUDIT
#define AUDIT -1
#endif
#define INA(a, k) ((AUDIT < 0 || AUDIT == (a)) && lo <= (k) && (k) < hi)
#define IN(k) (lo <= (k) && (k) < hi)
#define INL(j) INA(2 + (j), pb + (j))
#define SEAM(k) do { if (IN((k) + 1)) { GRID_BAR(); if (PROBE == 15) GRID_BAR(); } } while (0)
    if (INA(0, 0)) { phase_prologue0(F0); SEAM(0); }
    if (INA(1, 1)) { phase_prologue1(F0); if (PROBE == 8) { GRID_BAR(); phase_prologue1(F0); } SEAM(1); }
    for (int l = 0; l < DEPTH; ++l) {
        const int pb = 2 + l * PH_PER_LAYER; const bool last = (l == DEPTH - 1);
        if (INL(0)) { phase_normmod1(F0, l, PROBE == 14 ? 2 : 1); SEAM(pb + 0); }
        if (INL(1)) { Frame F = enter(F0);
            const bf16_t* W = (const bf16_t*)(F.ws + WS_WIN) + (size_t)l * NIN * DM;
            { LAS f32x4* rl = (LAS f32x4*)(F.lds + LDS_ROPE); const f32x4* rg = (const f32x4*)(F.ws + WS_ROPE); for (int i = F.tid; i < 1024; i += NTHR) rl[i] = rg[i]; __syncthreads(); }
            pg8::DualOrder S; S.S1.init(F.ws + AR_H, W, MT, NQKVG, DM, F.G, F.bid, 1, WGM_INP); S.S2.init(W + (size_t)NQKVG * DM, F.ws + AR_H, HYW, MT, DM, F.G, F.bid, 1, WGM_INP);
            EpiInProjDual E{EpiInProj{(bf16_t*)(F.ws + AR_Q), (bf16_t*)(F.ws + AR_KC), (bf16_t*)(F.ws + AR_VC), (bf16_t*)(F.ws + AR_GATE), F.in[I_BGATE] + (size_t)l * 4096,
                          F.in[I_QNORM] + l * 128, F.in[I_KNORM] + l * 128, (const LAS float*)(F.lds + LDS_ROPE), F.lds + LDS_EPI}, EpiBf16Plain{(bf16_t*)(F.ws + AR_UT), MT}};
            pg8::gemm_phase(F.lds, F.wave, DM, S, E);
            SEAM(pb + 1);
        }
        if (INL(2)) { phase_mixers(F0, l); SEAM(pb + 2); }
        if (INL(3)) { phase_combine_transpose(F0, l); if (PROBE == 7) { GRID_BAR(); phase_combine_transpose(F0, l); } SEAM(pb + 3); }
        if (INL(4)) { Frame F = enter(F0);
            const int Mr = last ? ML : MT;
            pg8::PairOrder S; S.S0.init(F.ws + AR_YAN, (const bf16_t*)(F.ws + WS_WBRA) + (size_t)l * DM * DM, Mr, DM, DM, F.G, F.bid);
            S.A1 = (const char*)(F.ws + AR_YB); S.Bt1 = (const char*)((const bf16_t*)(F.ws + WS_WBRB) + (size_t)l * DM * DM);
            EpiMergePair E{(const bf16_t*)(F.ws + AR_GATE), (bf16_t*)(F.ws + AR_M)};
            pg8::gemm_phase(F.lds, F.wave, DM, S, E);
            phase_tail_transposes(F0, l, 0);
            SEAM(pb + 4);
        }
        if (INL(5)) { Frame F = enter(F0);
            const int Mr = last ? ML : MT;
            pg8::StaticOrder S; S.init(F.ws + AR_M, (const bf16_t*)(F.ws + WS_WOUT) + (size_t)l * DM * DM, Mr, DM, DM, F.G, F.bid);
            EpiOut E{(float*)(F.ws + WS_X), (const float*)(F.ws + WS_MOD) + (size_t)l * 5 * 12288};
            pg8::gemm_phase(F.lds, F.wave, DM, S, E);
            phase_tail_transposes(F0, l, 1);
            SEAM(pb + 5);
        }
        if (INL(6)) { phase_normmod2(F0, l); SEAM(pb + 6); }
        const int wslot = (l & 1) ? 2 + (l >> 1) * 8 : (l >> 1);
        if (INL(7)) { Frame F = enter(F0);
            const bf16_t* Wup = (const bf16_t*)(F.ws + WS_WUP) + (size_t)wslot * 2 * DFF * DM;
            EpiUp E{(bf16_t*)(F.ws + AR_ACT)};
            if (l & 1) { moe_tables(F, l);
                pg8::MoeOrder S; S.tab = (const LAS int*)(F.lds + LDS_TAB); S.nN = 44; S.G = F.G; S.c = F.bid; S.rep = (PROBE == 10) ? 2 : 1; S.wgm = WGM_MOE; S.A = (const char*)(F.ws + AR_H2S); S.W = (const char*)Wup;
                S.a_estride = (size_t)CAP * DM * 2; S.a_tstep = (size_t)256 * DM * 2; S.w_estride = (size_t)2 * DFF * DM * 2; S.w_tstep = (size_t)256 * DM * 2; S.a_by_slot = false;
                pg8::gemm_phase(F.lds, F.wave, DM, S, E);
            } else { pg8::StaticOrder S; S.init(F.ws + AR_H, Wup, last ? ML : MT, 2 * DFF, DM, F.G, F.bid, PROBE == 5 ? 2 : 1); pg8::gemm_phase(F.lds, F.wave, DM, S, E); }
            SEAM(pb + 7);
        }
        if (INL(8)) { Frame F = enter(F0);
            const bf16_t* Wdn = (const bf16_t*)(F.ws + WS_WDN) + (size_t)wslot * DM * DFF;
            EpiBf16Plain E{(bf16_t*)(F.ws + AR_YS), DM};
            if (l & 1) { moe_tables(F, l);
                pg8::MoeOrder S; S.tab = (const LAS int*)(F.lds + LDS_TAB); S.nN = 8; S.G = F.G; S.c = F.bid; S.rep = (PROBE == 11) ? 2 : 1; S.wgm = WGM_MOE; S.A = (const char*)(F.ws + AR_ACT); S.W = (const char*)Wdn;
                S.a_estride = 0; S.a_tstep = (size_t)256 * DFF * 2; S.w_estride = (size_t)DM * DFF * 2; S.w_tstep = (size_t)256 * DFF * 2; S.a_by_slot = true;
                pg8::gemm_phase(F.lds, F.wave, DFF, S, E);
            } else { { pg8::StaticOrder S; S.init(F.ws + AR_ACT, Wdn, ML, DM, DFF, F.G, F.bid, PROBE == 6 ? 2 : 1); pg8::gemm_phase(F.lds, F.wave, DFF, S, E); }
                pg8::SplitKOrder S; S.pm0 = 64; S.nN = 8; S.nT = 32; S.S = 4; S.G = F.G; S.c = F.bid; S.A = (const char*)(F.ws + AR_ACT); S.Bt = (const char*)Wdn; S.tstep = (size_t)256 * DFF * 2; S.kbytes = 1408 * 2;
                EpiDownSlab E2{(float*)(F.ws + AR_YSC)};
                pg8::gemm_phase(F.lds, F.wave, 1408, S, E2, DFF); }
            SEAM(pb + 8);
        }
    }
    if (INA(11, N_PHASES - 1)) phase_final(F0);
#undef IN
#undef INA
#undef INL
#undef SEAM
}

extern "C" void kernel_launch(void* const* d_in, const int* in_sizes, int n_in, void* d_out, int out_size, void* d_ws, size_t ws_size, hipStream_t stream) {
    static int grid = 0;
    if (grid == 0) {
        if (n_in != 38 || out_size != ML * DM || ws_size < WS_END) { fprintf(stderr, "kernel_launch: unexpected shapes: n_in %d out %d ws %zu (need %zu)\n", n_in, out_size, ws_size, (size_t)WS_END); grid = -1; return; }
        int dev = 0, cus = 0, per_cu = 0;
        if (hipGetDevice(&dev) != hipSuccess || hipDeviceGetAttribute(&cus, hipDeviceAttributeMultiprocessorCount, dev) != hipSuccess) { grid = -1; return; }
        if (hipFuncSetAttribute((const void*)mega, hipFuncAttributeMaxDynamicSharedMemorySize, LDS_BYTES) != hipSuccess) { fprintf(stderr, "kernel_launch: hipFuncSetAttribute failed\n"); grid = -1; return; }
        if (hipOccupancyMaxActiveBlocksPerMultiprocessor(&per_cu, (const void*)mega, NTHR, LDS_BYTES) != hipSuccess || per_cu < 1) fprintf(stderr, "kernel_launch: occupancy query reports %d\n", per_cu);
        (void)hipGetLastError();
        grid = cus;
    }
    if (grid < 0) return;
    static_assert((CW_CNT + 2 * 8 * 64) * 4 <= 128 * 1024 && (CW_BAR + XCD_BAR_WORDS) * 4 <= 128 * 1024, "control words inside the zeroed region");
    if (hipMemsetAsync((char*)d_ws + WS_CTL, 0, 128 * 1024, stream) != hipSuccess) return;
    Args a{};
    for (int i = 0; i < 38; ++i) a.in[i] = (const float*)d_in[i];
    a.out = (float*)d_out; a.ws = (unsigned char*)d_ws;
#if MK_ONE_LAUNCH
    a.ph_lo = 0; a.ph_hi = N_PHASES;
    hipLaunchKernelGGL(mega, dim3(grid), dim3(NTHR), LDS_BYTES, stream, a);
#else
    for (int p = 0; p < N_PHASES; ++p) { a.ph_lo = p; a.ph_hi = p + 1; hipLaunchKernelGGL(mega, dim3(grid), dim3(NTHR), LDS_BYTES, stream, a); }
#endif
}
```

```cpp
#include <hip/hip_runtime.h>
#include <cstdio>
#include <cstdint>

#ifndef PROBE
#define PROBE 0
#endif
#ifndef MK_ONE_LAUNCH
#define MK_ONE_LAUNCH 1
#endif

#define LAS __attribute__((address_space(3)))
typedef unsigned short bf16_t;
typedef short bf16x8 __attribute__((ext_vector_type(8)));
typedef short s16x4 __attribute__((ext_vector_type(4)));
typedef float f32x2 __attribute__((ext_vector_type(2)));
typedef float f32x4 __attribute__((ext_vector_type(4)));
typedef float f32x16 __attribute__((ext_vector_type(16)));
typedef unsigned u32x2 __attribute__((ext_vector_type(2)));
typedef unsigned u32x4 __attribute__((ext_vector_type(4)));

constexpr int DM = 2048, NB = 4, SEQ = 4096, LC = 256, ML = NB * SEQ, MC = NB * LC, MT = ML + MC;
constexpr int DEPTH = 4, NIN = 16384, DFF = 5632, NEXP = 8, CAP = MT, SKV = SEQ + LC;
constexpr int NQKVG = 10240;
constexpr int HYW = 6144;
constexpr int MAXSLOT = 36864;
constexpr float EPS = 1e-6f;
constexpr int NWAVES = 8, NTHR = 512;

constexpr size_t MiB = 1u << 20;
constexpr size_t WS_CTL = 0;
constexpr size_t WS_MOD = 1 * MiB;
constexpr size_t WS_LAM = 2 * MiB;
constexpr size_t WS_ROPE = 2 * MiB + 4096;
constexpr size_t WS_HID = 3 * MiB;
constexpr size_t WS_HIDC = WS_HID + 4 * MiB;
constexpr size_t WS_TOK = 8 * MiB;
constexpr size_t WS_RC = 9 * MiB;
constexpr size_t WS_R = 41 * MiB;
constexpr size_t WS_X = 313 * MiB;
constexpr size_t WS_WIN = 449 * MiB;
constexpr size_t WS_WBRA = WS_WIN + 256 * MiB;
constexpr size_t WS_WBRB = WS_WBRA + 32 * MiB;
constexpr size_t WS_WOUT = WS_WBRB + 32 * MiB;
constexpr size_t WS_WUP = WS_WOUT + 32 * MiB;
constexpr size_t WS_WDN = WS_WUP + 18 * 44 * MiB;
constexpr size_t WS_AR = WS_WDN + 18 * 22 * MiB;
constexpr size_t AR_H = WS_AR, AR_Q = WS_AR + 68 * MiB, AR_KRAW = WS_AR + 136 * MiB, AR_KC = WS_AR + 204 * MiB, AR_VC = WS_AR + 272 * MiB;
constexpr size_t AR_UT = WS_AR + 340 * MiB, AR_UT2 = WS_AR + 544 * MiB, AR_GATE = WS_AR + 748 * MiB, AR_O = WS_AR + 884 * MiB, AR_YBT = WS_AR + 1156 * MiB;
constexpr size_t AR_YAN = AR_KRAW, AR_YB = AR_KC, AR_M = AR_VC;
constexpr size_t AR_ACT = WS_AR + 68 * MiB, AR_YS = WS_AR + 464 * MiB, AR_H2S = WS_AR + 680 * MiB;
constexpr size_t AR_MSLAB = AR_UT;
constexpr size_t AR_YSC = WS_AR + 1224 * MiB;
constexpr size_t WS_END = WS_AR + 1256 * MiB;
static_assert(WS_AR == 1989 * MiB, "map");
constexpr int CW_BAR = 4096;
constexpr int CW_CNT = 16384;

constexpr int LDS_EPI = 131072;
constexpr int LDS_TAB = 143360;
constexpr int LDS_ROPE = 147456;
constexpr int LDS_BYTES = 163840;

__device__ __forceinline__ unsigned cvt_pk_bf16(float lo, float hi) { unsigned r; asm volatile("v_cvt_pk_bf16_f32 %0, %1, %2" : "=v"(r) : "v"(lo), "v"(hi)); return r; }
__device__ __forceinline__ float bf_lo(unsigned w) { return __uint_as_float(w << 16); }
__device__ __forceinline__ float bf_hi(unsigned w) { return __uint_as_float(w & 0xffff0000u); }
__device__ __forceinline__ float bf2f(bf16_t b) { return __uint_as_float(((unsigned)b) << 16); }
__device__ __forceinline__ float shx(float v, int k, int lane) { return __int_as_float(__builtin_amdgcn_ds_bpermute((lane ^ k) << 2, __float_as_int(v))); }
__device__ __forceinline__ float wave_sum(float v, int lane) {
#pragma unroll
    for (int o = 1; o < 64; o <<= 1) v += shx(v, o, lane);
    return v;
}
__device__ __forceinline__ int opaque(int v) { asm volatile("" : "+v"(v)); return v; }
__device__ __forceinline__ int lane_id() { int r; asm volatile("v_mbcnt_lo_u32_b32 %0, -1, 0\n\tv_mbcnt_hi_u32_b32 %0, -1, %0" : "=v"(r)); return r; }
__device__ __forceinline__ int hw_tid(int wave) { return opaque(wave * 64 + lane_id()); }
#define LDS_WAIT() asm volatile("s_waitcnt lgkmcnt(0)" ::: "memory")
#define VM_WAIT() asm volatile("s_waitcnt vmcnt(0)" ::: "memory")

#define XB_TMO      128
#define XB_XCNT(j)  (256  + 64 * (j))
#define XB_XSUB(j)  (1280 + 64 * (j))
#define XB_XGEN(j)  (2304 + 64 * (j))
#define XB_TOP      3328
#define XB_TOPGEN   3392
#define XCD_BAR_WORDS 3456
#define XB_SPIN_CAP (1u << 18)
__device__ __forceinline__ unsigned xb_ld(unsigned* p)              { return __hip_atomic_load(p, __ATOMIC_RELAXED, __HIP_MEMORY_SCOPE_AGENT); }
__device__ __forceinline__ unsigned xb_add(unsigned* p, unsigned v) { return __hip_atomic_fetch_add(p, v, __ATOMIC_RELAXED, __HIP_MEMORY_SCOPE_AGENT); }
__device__ __forceinline__ unsigned xb_xcc_id() { return (unsigned)__builtin_amdgcn_s_getreg((3 << 11) | 20) & 0xFu; }
#define XB_SPIN(cond, bar) do { unsigned _sp = 0; while (cond) { __builtin_amdgcn_s_sleep(1); \
    if ((++_sp & 255u) == 0u) { if (xb_ld(&(bar)[XB_TMO])) break; if (_sp > XB_SPIN_CAP) { atomicAdd(&(bar)[XB_TMO], 1u); break; } } } } while (0)
struct XcdBarrier { unsigned* bar; unsigned x; volatile LAS unsigned* st; int wave; };
__device__ __forceinline__ XcdBarrier xcd_barrier_post(unsigned* bar, volatile LAS unsigned* st, int wave) {
    XcdBarrier b; b.bar = bar; b.x = xb_xcc_id(); b.st = st; b.wave = wave;
    if (threadIdx.x == 0) (void)xb_add(&bar[XB_XCNT(b.x)], 1u);
    return b;
}
__device__ __forceinline__ void xcd_barrier_complete(unsigned* bar, unsigned x, unsigned& nloc, unsigned& nx) {
    const unsigned G = gridDim.x * gridDim.y * gridDim.z;
    unsigned sum, cnt, mine, sp = 0u;
    for (;;) {
        sum = 0u; cnt = 0u; mine = 0u;
#pragma unroll
        for (unsigned j = 0; j < 16; ++j) { const unsigned c = xb_ld(&bar[XB_XCNT(j)]); sum += c; cnt += (c > 0u) ? 1u : 0u; mine = (j == x) ? c : mine; }
        if (sum == G) break;
        __builtin_amdgcn_s_sleep(1);
        if ((++sp & 255u) == 0u) { if (xb_ld(&bar[XB_TMO])) break; if (sp > XB_SPIN_CAP) { atomicAdd(&bar[XB_TMO], 1u); break; } }
    }
    nloc = mine > 0u ? mine : 1u; nx = cnt > 0u ? cnt : 1u;
}
__device__ __forceinline__ void xcd_barrier(const XcdBarrier& b) {
    asm volatile("s_waitcnt vmcnt(0)" ::: "memory");
    __syncthreads();
    if (b.wave == 0 && lane_id() == 0) {
        unsigned* bar = b.bar;
        __builtin_amdgcn_s_waitcnt(0);
        unsigned nloc = b.st[0], nx = b.st[1];
        if (nloc == 0u) { xcd_barrier_complete(bar, b.x, nloc, nx); b.st[0] = nloc; b.st[1] = nx; }
        const unsigned old = xb_add(&bar[XB_XSUB(b.x)], 1u);
        const unsigned gen = old / nloc;
        if (old + 1u == (gen + 1u) * nloc) {
            __builtin_amdgcn_fence(__ATOMIC_RELEASE, "agent");
            asm volatile("s_waitcnt vmcnt(0)" ::: "memory");
            const unsigned og = xb_add(&bar[XB_TOP], 1u);
            const unsigned tg = og / nx;
            if (og + 1u == (tg + 1u) * nx) xb_add(&bar[XB_TOPGEN], 1u);
            else XB_SPIN(xb_ld(&bar[XB_TOPGEN]) == tg, bar);
            __builtin_amdgcn_fence(__ATOMIC_ACQUIRE, "agent");
            xb_add(&bar[XB_XGEN(b.x)], 1u);
            asm volatile("s_waitcnt vmcnt(0)" ::: "memory");
        } else {
            XB_SPIN(xb_ld(&bar[XB_XGEN(b.x)]) == gen, bar);
            __builtin_amdgcn_fence(__ATOMIC_ACQUIRE, "agent");
            asm volatile("s_waitcnt vmcnt(0)" ::: "memory");
        }
    }
    __syncthreads();
}

namespace pg8 {
constexpr int BM = 256, BK = 64, HALF = 128, HTB = HALF * BK * 2, STAGE_BYTES = 8 * HTB;
__host__ __device__ __forceinline__ int lds_byte(int r, int c) { const int st = (r >> 4) * 2 + (c >> 5), rr = r & 15, cc = c & 31, ob = rr * 64 + cc * 2; return st * 1024 + (ob ^ (((ob >> 9) & 1) << 5)); }
__host__ __device__ __forceinline__ void stage_rc(int b, int& R, int& C) { const int st = b / 1024, sb = b % 1024, swz = sb ^ (((sb >> 9) & 1) << 5); R = (st >> 1) * 16 + swz / 64; C = (st & 1) * 32 + (swz % 64) / 2; }
__host__ __device__ __forceinline__ int perm32(int rho) { const int n = rho >> 4, i = rho & 15; return 8 * (i >> 2) + 4 * n + (i & 3); }
struct Unit { int pm, pn; const char* a; const char* b; int kind; };

template <class Epi, class Sched>
__device__ __forceinline__ void gemm_phase(LAS unsigned char* lds, const int wave_, const int K, const Sched& S, const Epi& E, const int ld_ = 0) {
    const int tid = hw_tid(wave_), wid = __builtin_amdgcn_readfirstlane(tid >> 6), lane = tid & 63, wr = wid >> 2, wc = wid & 3, fr = lane & 15, fq = lane >> 4;
    const int nt = K / BK, ld = ld_ ? ld_ : K;
    unsigned voffA[2], voffB[2];
#pragma unroll
    for (int i = 0; i < 2; ++i) { int R, C; stage_rc(tid * 16 + i * 8192, R, C); const int Rb = Epi::PERM ? ((R & ~31) + perm32(R & 31)) : R;
        voffA[i] = (unsigned)(R * ld + C) * 2u; voffB[i] = (unsigned)(Rb * ld + C) * 2u; }
    const size_t kstep = (size_t)(BK * 2);
    const size_t hstep = (size_t)HALF * ld * 2;
    const unsigned ldsw = (unsigned)wid * 1024u;
    const int aoff = lds_byte(wr * 64 + fr, fq * 8), boff = lds_byte(wc * 32 + fr, fq * 8);
#define PG8_SA(b, h) (((b) * 2 + (h)) * HTB)
#define PG8_SB(b, h) ((4 + (b) * 2 + (h)) * HTB)
#define PG8_STAGE(bufoff, gbase, voff) do { _Pragma("unroll") for (int _i = 0; _i < 2; ++_i) \
        __builtin_amdgcn_global_load_lds((const unsigned*)((const char*)(gbase) + (voff)[_i]), (LAS unsigned*)(lds + (bufoff) + ldsw + _i * 8192), 16, 0, 0); } while (0)
#define PG8_LDA(dst, b, h) do { _Pragma("unroll") for (int m = 0; m < 4; ++m) _Pragma("unroll") for (int k = 0; k < 2; ++k) dst[m][k] = *(const LAS bf16x8*)(lds + PG8_SA(b, h) + aoff + m * 2048 + k * 1024); } while (0)
#define PG8_LDB(dst, b, h) do { _Pragma("unroll") for (int n = 0; n < 2; ++n) _Pragma("unroll") for (int k = 0; k < 2; ++k) dst[n][k] = *(const LAS bf16x8*)(lds + PG8_SB(b, h) + boff + n * 2048 + k * 1024); } while (0)
#define PG8_MMA(ai, bj, At, Bt) do { __builtin_amdgcn_s_setprio(1); _Pragma("unroll") for (int m = 0; m < 4; ++m) _Pragma("unroll") for (int n = 0; n < 2; ++n) _Pragma("unroll") for (int k = 0; k < 2; ++k) \
        acc[ai][bj][m][n] = __builtin_amdgcn_mfma_f32_16x16x32_bf16(Bt[n][k], At[m][k], acc[ai][bj][m][n], 0, 0, 0); __builtin_amdgcn_s_setprio(0); } while (0)
#define PG8_WAIT_V(n) asm volatile("s_waitcnt vmcnt(" #n ")" ::: "memory")
#define PG8_WAIT_L(n) asm volatile("s_waitcnt lgkmcnt(" #n ")" ::: "memory")
#define PG8_BAR __builtin_amdgcn_s_barrier()
#define PG8_SCHED __builtin_amdgcn_sched_barrier(0)
    Unit cur, nxt; int ui = 0;
    if (!S.next(0, cur)) return;
    f32x4 acc[2][2][4][2];
#pragma unroll
    for (int a = 0; a < 2; ++a)
#pragma unroll
        for (int b = 0; b < 2; ++b)
#pragma unroll
            for (int m = 0; m < 4; ++m)
#pragma unroll
                for (int n = 0; n < 2; ++n) acc[a][b][m][n] = (f32x4){0.f, 0.f, 0.f, 0.f};
    bf16x8 At[4][2], B0[2][2], B1[2][2];
    const char* cA = cur.a; const char* cB = cur.b;
    PG8_STAGE(PG8_SB(0, 0), cB, voffB); PG8_STAGE(PG8_SA(0, 0), cA, voffA); PG8_STAGE(PG8_SB(0, 1), cB + hstep, voffB); PG8_STAGE(PG8_SA(0, 1), cA + hstep, voffA);
    if (wr == 1) PG8_BAR;
    PG8_WAIT_V(4); PG8_BAR;
    PG8_STAGE(PG8_SB(1, 0), cB + kstep, voffB); PG8_STAGE(PG8_SA(1, 0), cA + kstep, voffA); PG8_STAGE(PG8_SB(1, 1), cB + hstep + kstep, voffB);
    PG8_WAIT_V(6); PG8_BAR;
    for (;;) {
        const bool has_next = S.next(ui + 1, nxt);
        const char* nA = has_next ? nxt.a : cA; const char* nB = has_next ? nxt.b : cB;
        for (int t = 0; t < nt; t += 2) {
            const bool last = (t == nt - 2);
            const char* a1 = cA + (size_t)(t + 1) * kstep;
            const char* a2 = last ? nA : cA + (size_t)(t + 2) * kstep; const char* b2 = last ? nB : cB + (size_t)(t + 2) * kstep;
            const char* a3 = a2 + kstep; const char* b3 = b2 + kstep;
            PG8_LDB(B0, 0, 0); PG8_SCHED; PG8_LDA(At, 0, 0); PG8_STAGE(PG8_SA(1, 1), a1 + hstep, voffA);
            PG8_WAIT_L(8); PG8_BAR; PG8_WAIT_L(0); PG8_MMA(0, 0, At, B0); PG8_BAR; PG8_SCHED;
            PG8_LDB(B1, 0, 1); PG8_STAGE(PG8_SB(0, 0), b2, voffB);
            PG8_BAR; PG8_WAIT_L(0); PG8_MMA(0, 1, At, B1); PG8_BAR;
            PG8_LDA(At, 0, 1); PG8_STAGE(PG8_SA(0, 0), a2, voffA);
            PG8_BAR; PG8_WAIT_L(0); PG8_MMA(1, 0, At, B0); PG8_BAR; PG8_SCHED;
            PG8_STAGE(PG8_SB(0, 1), b2 + hstep, voffB);
            PG8_WAIT_V(6); PG8_BAR; PG8_MMA(1, 1, At, B1); PG8_BAR;
            PG8_LDB(B0, 1, 0); PG8_SCHED; PG8_LDA(At, 1, 0); PG8_STAGE(PG8_SA(0, 1), a2 + hstep, voffA);
            PG8_WAIT_L(8); PG8_BAR; PG8_WAIT_L(0); PG8_MMA(0, 0, At, B0); PG8_BAR; PG8_SCHED;
            PG8_LDB(B1, 1, 1); PG8_STAGE(PG8_SB(1, 0), b3, voffB);
            PG8_BAR; PG8_WAIT_L(0); PG8_MMA(0, 1, At, B1); PG8_BAR;
            PG8_LDA(At, 1, 1); PG8_STAGE(PG8_SA(1, 0), a3, voffA);
            PG8_BAR; PG8_WAIT_L(0); PG8_MMA(1, 0, At, B0); PG8_BAR; PG8_SCHED;
            PG8_STAGE(PG8_SB(1, 1), b3 + hstep, voffB);
            PG8_WAIT_V(6); PG8_BAR; PG8_MMA(1, 1, At, B1); PG8_BAR;
        }
        bool keep = false;
        if constexpr (Epi::CARRY) keep = E.carry(acc, cur, wr, wc, fr, fq); else E(acc, cur, wr, wc, fr, fq);
        if (!has_next) break;
        if (!keep) {
#pragma unroll
        for (int a = 0; a < 2; ++a)
#pragma unroll
            for (int b = 0; b < 2; ++b)
#pragma unroll
                for (int m = 0; m < 4; ++m)
#pragma unroll
                    for (int n = 0; n < 2; ++n) acc[a][b][m][n] = (f32x4){0.f, 0.f, 0.f, 0.f}; }
        cur = nxt; cA = nA; cB = nB; ++ui;
    }
    PG8_WAIT_V(0);
    if (wr == 0) PG8_BAR;
    PG8_BAR;
#undef PG8_SA
#undef PG8_SB
#undef PG8_STAGE
#undef PG8_LDA
#undef PG8_LDB
#undef PG8_MMA
#undef PG8_WAIT_V
#undef PG8_WAIT_L
#undef PG8_BAR
#undef PG8_SCHED
}

#ifndef WGM_MOE
#define WGM_MOE 4
#endif
#ifndef WGM_INP
#define WGM_INP 4
#endif
constexpr int NXCD = 8, WGM = 4;
struct StaticOrder {
    int nM, nN, nwg, G, c, rep, wgm; const char* A; const char* Bt; size_t tstep;
    __device__ void init(const void* A_, const void* Bt_, int M, int N, int K, int G_, int c_, int rep_ = 1, int wgm_ = WGM) { nM = M / BM; nN = N / BM; nwg = nM * nN; G = G_; c = c_; rep = rep_; wgm = wgm_; A = (const char*)A_; Bt = (const char*)Bt_; tstep = (size_t)BM * K * 2; }
    __device__ bool next(int i, Unit& u) const {
        const long L = (long)i * G + c; if (L >= (long)nwg * rep) return false;
        map((int)(L % nwg), u); u.kind = 0; return true;
    }
    __device__ void map(int wgid, Unit& u) const {
        { const int q = nwg / NXCD, r = nwg % NXCD, xcd = wgid % NXCD, off = wgid / NXCD; wgid = (xcd < r ? xcd * (q + 1) : r * (q + 1) + (xcd - r) * q) + off; }
        const int nig = wgm * nN, gid = wgid / nig, fm = gid * wgm, gsz = (nM - fm) < wgm ? (nM - fm) : wgm;
        u.pm = fm + ((wgid % nig) % gsz); u.pn = (wgid % nig) / gsz; u.a = A + (size_t)u.pm * tstep; u.b = Bt + (size_t)u.pn * tstep;
    }
};
struct DualOrder {
    StaticOrder S1, S2;
    __device__ bool next(int i, Unit& u) const {
        const int L = i * S1.G + S1.c; if (L < S1.nwg) { S1.map(L, u); u.kind = 0; return true; }
        if (L - S1.nwg < S2.nwg) { S2.map(L - S1.nwg, u); u.kind = 1; return true; }
        return false;
    }
};
struct PairOrder {
    StaticOrder S0; const char* A1; const char* Bt1;
    __device__ bool next(int i, Unit& u) const {
        const int w = (i >> 1) * S0.G + S0.c; if (w >= S0.nwg) return false;
        S0.map(w, u); u.kind = i & 1;
        if (i & 1) { u.a = A1 + (size_t)u.pm * S0.tstep; u.b = Bt1 + (size_t)u.pn * S0.tstep; }
        return true;
    }
};
struct SplitKOrder {
    int pm0, nN, nT, S, G, c; const char* A; const char* Bt; size_t tstep, kbytes;
    __device__ bool next(int i, Unit& u) const {
        const int L = i * G + c; if (L >= nT * S) return false;
        const int un = L / S, ks = L - un * S; u.pm = pm0 + un / nN; u.pn = un % nN; u.kind = ks;
        u.a = A + (size_t)u.pm * tstep + (size_t)ks * kbytes; u.b = Bt + (size_t)u.pn * tstep + (size_t)ks * kbytes; return true;
    }
};
struct CtxPairSplitOrder {
    int G, c; const char* A0; const char* A1; const char* B0; const char* B1; size_t tstep, kbytes;
    __device__ bool next(int i, Unit& u) const {
        const int L = i * G + c; if (L >= 256) return false;
        const int un = L >> 3, rem = L & 7, g = rem >> 2, ks = rem & 3; u.pm = 64 + (un >> 3); u.pn = un & 7; u.kind = rem;
        u.a = (g ? A1 : A0) + (size_t)u.pm * tstep + (size_t)ks * kbytes; u.b = (g ? B1 : B0) + (size_t)u.pn * tstep + (size_t)ks * kbytes; return true;
    }
};
struct MoeOrder {
    const LAS int* tab; int nN, G, c, rep, wgm; const char* A; const char* W; size_t a_estride, a_tstep, w_estride, w_tstep; bool a_by_slot;
    __device__ bool next(int i, Unit& u) const {
        int L = i * G + c; const int total = tab[16] * nN; if (L >= total * rep) return false; if (L >= total) L -= total;
        int e = 0;
#pragma unroll
        for (int k = 1; k < 8; ++k) e += (L >= tab[8 + k] * nN) ? 1 : 0;
        const int te = tab[e], ts = tab[8 + e]; const int ne = te * nN; int idx = L - ts * nN;
        { const int q = ne / NXCD, r = ne % NXCD, xcd = idx % NXCD, off = idx / NXCD; idx = (xcd < r ? xcd * (q + 1) : r * (q + 1) + (xcd - r) * q) + off; }
        const int nig = wgm * nN, gid = idx / nig, fm = gid * wgm, gsz = (te - fm) < wgm ? (te - fm) : wgm;
        const int r = fm + ((idx % nig) % gsz), pn = (idx % nig) / gsz;
        const int ee = __builtin_amdgcn_readfirstlane(e), pnn = __builtin_amdgcn_readfirstlane(pn), rr = __builtin_amdgcn_readfirstlane(r), tss = __builtin_amdgcn_readfirstlane(ts);
        u.pm = tss + rr; u.pn = pnn; u.kind = 0;
        u.a = a_by_slot ? A + (size_t)u.pm * a_tstep : A + (size_t)ee * a_estride + (size_t)rr * a_tstep;
        u.b = W + (size_t)ee * w_estride + (size_t)pnn * w_tstep; return true;
    }
};
}

namespace att {
constexpr int D = 128, DV = 256, NW = 8, QBLK = 32, KVBLK = 32;
constexpr float SCALE = 0.088388347648318440f;
constexpr float THR = 8.f;
#ifndef ATT_SDEPTH
#define ATT_SDEPTH 1
#endif
constexpr int SDEPTH = ATT_SDEPTH;
constexpr int LDQ = DM, LDK = DM, LDO = 4096;
constexpr size_t SHM_V = KVBLK * DV * 2, SHM_K = KVBLK * D * 2, SHM_Q0 = 2 * SHM_V + 2 * SHM_K + NW * 64 * 4, SHM_ATTN = SHM_Q0 + NW * 8192;
#define KSWZ(row, colB) ((row) * 256 + ((colB) ^ (((row) & 7) << 4)))
#define SBAR() __builtin_amdgcn_sched_barrier(0)
__device__ __forceinline__ int crow(int r, int hi) { return (r & 3) + 8 * (r >> 2) + 4 * hi; }
__device__ __forceinline__ unsigned cvtpk(float lo, float hi) { unsigned r; asm volatile("v_cvt_pk_bf16_f32 %0, %1, %2" : "=v"(r) : "v"(lo), "v"(hi)); return r; }
__device__ __forceinline__ void partialSM(f32x16& p0, float& m_reg, float& mn, float& alpha) {
  constexpr float C = SCALE * 1.4426950408889634f;
  float pmax = p0[0]; for (int r = 1; r < 16; ++r) pmax = fmaxf(pmax, p0[r]);
  { auto rr = __builtin_amdgcn_permlane32_swap(__float_as_uint(pmax), __float_as_uint(pmax), false, false);
    pmax = fmaxf(__uint_as_float(rr[0]), __uint_as_float(rr[1])); }
  if (__builtin_expect(__all(pmax - m_reg <= THR / SCALE), 1)) { mn = m_reg; alpha = 1.f; }
  else { mn = fmaxf(m_reg, pmax); alpha = __builtin_amdgcn_exp2f((m_reg - mn) * C); m_reg = mn; }
  float mnC = -mn * C;
  for (int r = 0; r < 16; ++r) p0[r] = fmaf(p0[r], C, mnC);
  for (int r = 0; r < 8; ++r) p0[r] = __builtin_amdgcn_exp2f(p0[r]);
}
__device__ __forceinline__ void finishSM(f32x16& p0, float alpha, float& l_reg, bf16x8& pa0, bf16x8& pa1) {
  for (int r = 8; r < 16; ++r) p0[r] = __builtin_amdgcn_exp2f(p0[r]);
  float ps = 0; for (int r = 0; r < 16; ++r) ps += p0[r];
  { auto rr = __builtin_amdgcn_permlane32_swap(__float_as_uint(ps), __float_as_uint(ps), false, false);
    ps = __uint_as_float(rr[0]) + __uint_as_float(rr[1]); }
  l_reg = l_reg * alpha + ps;
#define PK4(P, BASE, OUT) do { unsigned a0 = cvtpk(P[BASE + 0], P[BASE + 1]), a1 = cvtpk(P[BASE + 2], P[BASE + 3]);   \
    unsigned b0 = cvtpk(P[BASE + 4], P[BASE + 5]), b1 = cvtpk(P[BASE + 6], P[BASE + 7]);                              \
    auto r0 = __builtin_amdgcn_permlane32_swap(a0, b0, false, false); auto r1 = __builtin_amdgcn_permlane32_swap(a1, b1, false, false); \
    u32x4 w = {r0[0], r1[0], r0[1], r1[1]}; OUT = *reinterpret_cast<bf16x8*>(&w); } while (0)
  PK4(p0, 0, pa0); PK4(p0, 8, pa1);
#undef PK4
}
#ifndef ATT_QLDS
#define ATT_QLDS 0
#endif
#if ATT_QLDS
typedef const char* qfrag_t;
#define QV(d0) (*reinterpret_cast<const bf16x8*>(qp + (d0) * 1024))
#else
typedef const bf16x8* qfrag_t;
#define QV(d0) (qp[d0])
#endif
__device__ __forceinline__ void qkt(f32x16& p0, const bf16_t* Ks, qfrag_t qp, int r32, int hi) {
  p0 = f32x16{};
  for (int d0 = 0; d0 < 8; ++d0) { int cb = (d0 * 16 + hi * 8) * 2; const bf16x8 qv = QV(d0);
    bf16x8 b0 = *reinterpret_cast<const bf16x8*>((const char*)Ks + KSWZ(r32, cb));
    p0 = __builtin_amdgcn_mfma_f32_32x32x16_bf16(b0, qv, p0, 0, 0, 0); }
}
__device__ __forceinline__ int v_st(int k, int c) { const int kk = (k & ~0xC) | ((k & 4) << 1) | ((k & 8) >> 1); return ((kk >> 3) * 8 + (c >> 5)) * 512 + ((kk & 7) * 32 + (c & 31)) * 2; }
__device__ __forceinline__ int v_rd_base(int lane) { return ((lane & 3) << 3) | (((lane >> 2) & 3) << 6) | (((lane >> 4) & 1) << 5) | (((lane >> 5) & 1) << 8); }
constexpr int v_rd_off(int d0, int ks, int half) { return d0 * 512 + ks * 8192 + half * 4096; }
template <int OFF> __device__ __forceinline__ s16x4 tr_read(int vb) {
  s16x4 r; asm volatile("ds_read_b64_tr_b16 %0, %1 offset:%2" : "=&v"(r) : "v"(vb), "i"(OFF) : "memory"); return r;
}
template <int D0> __device__ __forceinline__ void pv_two(f32x16& oa, f32x16& ob, int vb, bf16x8 pa0, bf16x8 pa1) {
  const s16x4 l0 = tr_read<v_rd_off(D0, 0, 0)>(vb), h0 = tr_read<v_rd_off(D0, 0, 1)>(vb), l1 = tr_read<v_rd_off(D0, 1, 0)>(vb), h1 = tr_read<v_rd_off(D0, 1, 1)>(vb);
  const s16x4 l2 = tr_read<v_rd_off(D0 + 1, 0, 0)>(vb), h2 = tr_read<v_rd_off(D0 + 1, 0, 1)>(vb), l3 = tr_read<v_rd_off(D0 + 1, 1, 0)>(vb), h3 = tr_read<v_rd_off(D0 + 1, 1, 1)>(vb);
  asm volatile("s_waitcnt lgkmcnt(0)" ::: "memory"); SBAR();
#define PK(L, H) (bf16x8){L[0], L[1], L[2], L[3], H[0], H[1], H[2], H[3]}
  oa = __builtin_amdgcn_mfma_f32_32x32x16_bf16(pa0, PK(l0, h0), oa, 0, 0, 0);
  oa = __builtin_amdgcn_mfma_f32_32x32x16_bf16(pa1, PK(l1, h1), oa, 0, 0, 0);
  ob = __builtin_amdgcn_mfma_f32_32x32x16_bf16(pa0, PK(l2, h2), ob, 0, 0, 0);
  ob = __builtin_amdgcn_mfma_f32_32x32x16_bf16(pa1, PK(l3, h3), ob, 0, 0, 0);
#undef PK
}
#ifndef ATT_PV1
#define ATT_PV1 1
#endif
template <int D0> __device__ __forceinline__ void pv_one(f32x16& oa, int vb, bf16x8 pa0, bf16x8 pa1) {
  const s16x4 l0 = tr_read<v_rd_off(D0, 0, 0)>(vb), h0 = tr_read<v_rd_off(D0, 0, 1)>(vb), l1 = tr_read<v_rd_off(D0, 1, 0)>(vb), h1 = tr_read<v_rd_off(D0, 1, 1)>(vb);
  asm volatile("s_waitcnt lgkmcnt(0)" ::: "memory"); SBAR();
#define PK(L, H) (bf16x8){L[0], L[1], L[2], L[3], H[0], H[1], H[2], H[3]}
  oa = __builtin_amdgcn_mfma_f32_32x32x16_bf16(pa0, PK(l0, h0), oa, 0, 0, 0);
  oa = __builtin_amdgcn_mfma_f32_32x32x16_bf16(pa1, PK(l1, h1), oa, 0, 0, 0);
#undef PK
}
#ifndef ATT_PVPIPE
#define ATT_PVPIPE 1
#endif
#define PVR(D0, l0, h0, l1, h1) do { l0 = tr_read<v_rd_off(D0, 0, 0)>(vb); h0 = tr_read<v_rd_off(D0, 0, 1)>(vb); l1 = tr_read<v_rd_off(D0, 1, 0)>(vb); h1 = tr_read<v_rd_off(D0, 1, 1)>(vb); } while (0)
#define PVM(OA, l0, h0, l1, h1) do { OA = __builtin_amdgcn_mfma_f32_32x32x16_bf16(pa0, ((bf16x8){l0[0], l0[1], l0[2], l0[3], h0[0], h0[1], h0[2], h0[3]}), OA, 0, 0, 0); \
    OA = __builtin_amdgcn_mfma_f32_32x32x16_bf16(pa1, ((bf16x8){l1[0], l1[1], l1[2], l1[3], h1[0], h1[1], h1[2], h1[3]}), OA, 0, 0, 0); } while (0)
#define PIN(x) asm volatile("" : "+v"(x))
#define PVW(n) do { asm volatile("s_waitcnt lgkmcnt(" #n ")" ::: "memory"); SBAR(); } while (0)
__device__ __forceinline__ void pv_all_pipe(f32x16* o, int vb, bf16x8 pa0, bf16x8 pa1) {
  s16x4 a0, a1, a2, a3, b0, b1, b2, b3;
  PVR(0, a0, a1, a2, a3);
  PVR(1, b0, b1, b2, b3); PVW(4); PVM(o[0], a0, a1, a2, a3);
  PVR(2, a0, a1, a2, a3); PVW(4); PVM(o[1], b0, b1, b2, b3);
  PVR(3, b0, b1, b2, b3); PVW(4); PVM(o[2], a0, a1, a2, a3);
  PVR(4, a0, a1, a2, a3); PVW(4); PVM(o[3], b0, b1, b2, b3);
  PVR(5, b0, b1, b2, b3); PVW(4); PVM(o[4], a0, a1, a2, a3);
  PVR(6, a0, a1, a2, a3); PVW(4); PVM(o[5], b0, b1, b2, b3);
  PVR(7, b0, b1, b2, b3); PVW(4); PVM(o[6], a0, a1, a2, a3);
  PVW(0); PVM(o[7], b0, b1, b2, b3);
}
__device__ __forceinline__ void pv_all_sm(f32x16& o0, f32x16& o1, f32x16& o2, f32x16& o3, f32x16& o4, f32x16& o5, f32x16& o6, f32x16& o7, int vb, bf16x8 pa0, bf16x8 pa1,
                                          f32x16& p0, float& m_reg, float& mn, float& alpha) {
  constexpr float C = SCALE * 1.4426950408889634f;
  s16x4 a0, a1, a2, a3, b0, b1, b2, b3;
  float t0, t1, mnC;
  PVR(0, a0, a1, a2, a3);
  PVR(1, b0, b1, b2, b3);
  t0 = fmaxf(fmaxf(fmaxf(p0[0], p0[1]), fmaxf(p0[2], p0[3])), fmaxf(fmaxf(p0[4], p0[5]), fmaxf(p0[6], p0[7]))); PIN(t0);
  PVW(4); PVM(o0, a0, a1, a2, a3);
  PVR(2, a0, a1, a2, a3);
  t1 = fmaxf(fmaxf(fmaxf(p0[8], p0[9]), fmaxf(p0[10], p0[11])), fmaxf(fmaxf(p0[12], p0[13]), fmaxf(p0[14], p0[15])));
  t0 = fmaxf(t0, t1);
  { auto rr = __builtin_amdgcn_permlane32_swap(__float_as_uint(t0), __float_as_uint(t0), false, false); t0 = fmaxf(__uint_as_float(rr[0]), __uint_as_float(rr[1])); } PIN(t0);
  PVW(4); PVM(o1, b0, b1, b2, b3);
  PVR(3, b0, b1, b2, b3);
  { const bool keep = __all(t0 - m_reg <= THR / SCALE);
    mn = keep ? m_reg : fmaxf(m_reg, t0); alpha = keep ? 1.f : __builtin_amdgcn_exp2f((m_reg - mn) * C); m_reg = mn; mnC = -mn * C; PIN(alpha); PIN(mnC); }
  PVW(4); PVM(o2, a0, a1, a2, a3);
  PVR(4, a0, a1, a2, a3);
#pragma unroll
  for (int r = 0; r < 8; ++r) { p0[r] = fmaf(p0[r], C, mnC); PIN(p0[r]); }
  PVW(4); PVM(o3, b0, b1, b2, b3);
  PVR(5, b0, b1, b2, b3);
#pragma unroll
  for (int r = 8; r < 16; ++r) { p0[r] = fmaf(p0[r], C, mnC); PIN(p0[r]); }
  PVW(4); PVM(o4, a0, a1, a2, a3);
  PVR(6, a0, a1, a2, a3);
#pragma unroll
  for (int r = 0; r < 3; ++r) { p0[r] = __builtin_amdgcn_exp2f(p0[r]); PIN(p0[r]); }
  PVW(4); PVM(o5, b0, b1, b2, b3);
  PVR(7, b0, b1, b2, b3);
#pragma unroll
  for (int r = 3; r < 6; ++r) { p0[r] = __builtin_amdgcn_exp2f(p0[r]); PIN(p0[r]); }
  PVW(4); PVM(o6, a0, a1, a2, a3);
#pragma unroll
  for (int r = 6; r < 8; ++r) { p0[r] = __builtin_amdgcn_exp2f(p0[r]); PIN(p0[r]); }
  PVW(0); PVM(o7, b0, b1, b2, b3);
}
__device__ __forceinline__ void qkt_fsm(f32x16& pn, const bf16_t* Ks, const bf16x8 (&q)[8], int r32, int hi, f32x16& p0, float alpha, float& l_reg, bf16x8& pa0, bf16x8& pa1) {
  pn = f32x16{};
  const char* kbp = (const char*)Ks;
  bf16x8 kf[2];
  kf[0] = *reinterpret_cast<const bf16x8*>(kbp + KSWZ(r32, (hi * 8) * 2));
  float ps = 0.f; unsigned c0 = 0, c1 = 0, c2 = 0, c3 = 0, e0 = 0, e1 = 0, e2 = 0, e3 = 0;
#define QSTEP(d0, ...) do { if ((d0) < 7) kf[((d0) + 1) & 1] = *reinterpret_cast<const bf16x8*>(kbp + KSWZ(r32, (((d0) + 1) * 16 + hi * 8) * 2)); \
    pn = __builtin_amdgcn_mfma_f32_32x32x16_bf16(kf[(d0) & 1], q[d0], pn, 0, 0, 0); __VA_ARGS__; SBAR(); } while (0)
  QSTEP(0, { p0[8] = __builtin_amdgcn_exp2f(p0[8]); p0[9] = __builtin_amdgcn_exp2f(p0[9]); PIN(p0[8]); PIN(p0[9]); });
  QSTEP(1, { p0[10] = __builtin_amdgcn_exp2f(p0[10]); p0[11] = __builtin_amdgcn_exp2f(p0[11]); PIN(p0[10]); PIN(p0[11]); });
  QSTEP(2, { p0[12] = __builtin_amdgcn_exp2f(p0[12]); p0[13] = __builtin_amdgcn_exp2f(p0[13]); PIN(p0[12]); PIN(p0[13]); });
  QSTEP(3, { p0[14] = __builtin_amdgcn_exp2f(p0[14]); p0[15] = __builtin_amdgcn_exp2f(p0[15]); PIN(p0[14]); PIN(p0[15]); });
  QSTEP(4, { ps = ((p0[0] + p0[1]) + (p0[2] + p0[3])) + ((p0[4] + p0[5]) + (p0[6] + p0[7])); PIN(ps); });
  QSTEP(5, { ps += ((p0[8] + p0[9]) + (p0[10] + p0[11])) + ((p0[12] + p0[13]) + (p0[14] + p0[15]));
    { auto rr = __builtin_amdgcn_permlane32_swap(__float_as_uint(ps), __float_as_uint(ps), false, false); ps = __uint_as_float(rr[0]) + __uint_as_float(rr[1]); }
    l_reg = l_reg * alpha + ps; PIN(l_reg); });
  QSTEP(6, { c0 = cvtpk(p0[0], p0[1]); c1 = cvtpk(p0[2], p0[3]); c2 = cvtpk(p0[4], p0[5]); c3 = cvtpk(p0[6], p0[7]);
    auto r0 = __builtin_amdgcn_permlane32_swap(c0, c2, false, false); auto r1 = __builtin_amdgcn_permlane32_swap(c1, c3, false, false);
    u32x4 w = {r0[0], r1[0], r0[1], r1[1]}; PIN(w); pa0 = *reinterpret_cast<bf16x8*>(&w); });
  QSTEP(7, { e0 = cvtpk(p0[8], p0[9]); e1 = cvtpk(p0[10], p0[11]); e2 = cvtpk(p0[12], p0[13]); e3 = cvtpk(p0[14], p0[15]);
    auto r0 = __builtin_amdgcn_permlane32_swap(e0, e2, false, false); auto r1 = __builtin_amdgcn_permlane32_swap(e1, e3, false, false);
    u32x4 w = {r0[0], r1[0], r0[1], r1[1]}; PIN(w); pa1 = *reinterpret_cast<bf16x8*>(&w); });
#undef QSTEP
}
#undef PVR
#undef PVM
#undef PVW
#undef PIN
__device__ __forceinline__ void pv_all(f32x16* o, int vb, bf16x8 pa0, bf16x8 pa1) {
#if ATT_PVPIPE
  pv_all_pipe(o, vb, pa0, pa1);
#elif ATT_PV1
  pv_one<0>(o[0], vb, pa0, pa1); pv_one<1>(o[1], vb, pa0, pa1); pv_one<2>(o[2], vb, pa0, pa1); pv_one<3>(o[3], vb, pa0, pa1);
  pv_one<4>(o[4], vb, pa0, pa1); pv_one<5>(o[5], vb, pa0, pa1); pv_one<6>(o[6], vb, pa0, pa1); pv_one<7>(o[7], vb, pa0, pa1);
#else
  pv_two<0>(o[0], o[1], vb, pa0, pa1); pv_two<2>(o[2], o[3], vb, pa0, pa1); pv_two<4>(o[4], o[5], vb, pa0, pa1); pv_two<6>(o[6], o[7], vb, pa0, pa1);
#endif
}
__device__ __forceinline__ void attn_dense_body(const bf16_t* __restrict__ Qb, const bf16_t* __restrict__ Kh, const bf16_t* __restrict__ Vh,
                                                unsigned* __restrict__ Ob, int seq, char* lds, int wave_) {
  const int tid = hw_tid(wave_), wid = tid >> 6, lane = tid & 63, r32 = lane & 31, hi = lane >> 5;
#ifndef ATT_DMA3
#define ATT_DMA3 1
#endif
#if ATT_DMA3
  constexpr int NVB = 4, NKB = 3;
  static_assert(!ATT_QLDS, "the LDS-DMA body keeps Q in registers");
#else
  constexpr int NVB = 2, NKB = 2;
#endif
  bf16_t* V_lds = (bf16_t*)lds; bf16_t* K_lds = (bf16_t*)(lds + NVB * SHM_V);
  float* ws = (float*)(lds + NVB * SHM_V + NKB * SHM_K) + wid * 64; float* li_l = ws; float* al_l = ws + 32;
  float m_reg = -1e30f, l_reg = 0; f32x16 o[8] = {};
#if ATT_QLDS
  char* qr = lds + SHM_Q0 + wid * 8192 + lane * 16;
#else
  bf16x8 qr[8];
#endif
  const bf16_t* Qw = Qb + (long)(wid * QBLK + r32) * LDQ + hi * 8;
#pragma unroll
#if ATT_QLDS
  for (int d0 = 0; d0 < 8; ++d0) *reinterpret_cast<bf16x8*>(qr + d0 * 1024) = *reinterpret_cast<const bf16x8*>(Qw + d0 * 16);
#else
  for (int d0 = 0; d0 < 8; ++d0) qr[d0] = *reinterpret_cast<const bf16x8*>(Qw + d0 * 16);
#endif
  const int vb0 = (int)(uintptr_t)V_lds + v_rd_base(lane);
#define RESC(a) do { if (__any((a) < 1.f)) { if (hi == 0) al_l[r32] = (a); asm volatile("s_waitcnt lgkmcnt(0)" ::: "memory"); \
    for (int d = 0; d < 8; ++d) for (int r = 0; r < 16; ++r) o[d][r] *= al_l[crow(r, hi)]; } } while (0)
#if ATT_DMA3
  const int widu = __builtin_amdgcn_readfirstlane(wid);
  const unsigned kdl = (unsigned)(uintptr_t)(LAS unsigned char*)K_lds + ((unsigned)widu << 10), vdl = (unsigned)(uintptr_t)(LAS unsigned char*)V_lds + ((unsigned)widu << 10);
  const unsigned kofs = (unsigned)(((tid >> 4) * LDK + ((((tid & 15) ^ ((tid >> 4) & 7))) << 3)) * 2);
  unsigned vofs[2];
#pragma unroll
  for (int i = 0; i < 2; ++i) { const int sl = tid + 512 * i, sub = sl >> 5, w = sl & 31, kk = (sub >> 3) * 8 + (w >> 2), c = (sub & 7) * 32 + (w & 3) * 8, k = (kk & ~0xC) | ((kk & 4) << 1) | ((kk & 8) >> 1);
    vofs[i] = (unsigned)((k * LDK + c) * 2); }
  const int NT = seq / KVBLK;
#define DMA(t, kb, vbi) do { const int t_ = (t) < NT ? (t) : NT - 1; const char* kt_ = (const char*)(Kh + (long)t_ * (KVBLK * LDK)); const char* vt_ = (const char*)(Vh + (long)t_ * (KVBLK * LDK)); \
    __builtin_amdgcn_global_load_lds((const unsigned*)(kt_ + kofs), (LAS unsigned*)(kdl + (unsigned)(kb) * (unsigned)SHM_K), 16, 0, 0); \
    __builtin_amdgcn_global_load_lds((const unsigned*)(vt_ + vofs[0]), (LAS unsigned*)(vdl + (unsigned)(vbi) * (unsigned)SHM_V), 16, 0, 0); \
    __builtin_amdgcn_global_load_lds((const unsigned*)(vt_ + vofs[1]), (LAS unsigned*)(vdl + (unsigned)(vbi) * (unsigned)SHM_V + 8192u), 16, 0, 0); } while (0)
#define LAND() do { asm volatile("s_waitcnt vmcnt(3)" ::: "memory"); __builtin_amdgcn_s_barrier(); asm volatile("" ::: "memory"); } while (0)
#define KB(i) ((bf16_t*)((char*)K_lds + (i) * (int)SHM_K))
#ifndef ATT_QKV
#define ATT_QKV 6
#endif
#define QK_SCHED() do { _Pragma("unroll") for (int i_ = 0; i_ < 8; ++i_) { __builtin_amdgcn_sched_group_barrier(0x100, 1, 0); __builtin_amdgcn_sched_group_barrier(0x008, 1, 0); \
    __builtin_amdgcn_sched_group_barrier(0x002, ATT_QKV, 0); } } while (0)
  f32x16 pA, pB; float mnA, mnB, alA, alB; bf16x8 pa0, pa1;
  DMA(0, 0, 0); DMA(1, 1, 1); LAND();
  qkt(pA, KB(0), qr, r32, hi); partialSM(pA, m_reg, mnA, alA);
  DMA(2, 2, 2); LAND();
  int k1 = 1;
  for (int j = 1; j + 1 < NT; j += 2) {
    const int kA = k1, kB = (kA == 2 ? 0 : kA + 1), kC = (kB == 2 ? 0 : kB + 1);
    SBAR(); qkt_fsm(pB, KB(kA), qr, r32, hi, pA, alA, l_reg, pa0, pa1);
    DMA(j + 2, kC, (j + 2) & 3); SBAR();
    pv_all_sm(o[0], o[1], o[2], o[3], o[4], o[5], o[6], o[7], vb0 + ((j - 1) & 3) * (int)SHM_V, pa0, pa1, pB, m_reg, mnB, alB);
    LAND(); RESC(alB);
    SBAR(); qkt_fsm(pA, KB(kB), qr, r32, hi, pB, alB, l_reg, pa0, pa1);
    DMA(j + 3, kA, (j + 3) & 3); SBAR();
    pv_all_sm(o[0], o[1], o[2], o[3], o[4], o[5], o[6], o[7], vb0 + (j & 3) * (int)SHM_V, pa0, pa1, pA, m_reg, mnA, alA);
    LAND(); RESC(alA);
    k1 = kC;
  }
  SBAR(); qkt(pB, KB(k1), qr, r32, hi);
  finishSM(pA, alA, l_reg, pa0, pa1); SBAR();
  pv_all(o, vb0 + ((NT - 2) & 3) * (int)SHM_V, pa0, pa1); partialSM(pB, m_reg, mnB, alB);
  RESC(alB);
  finishSM(pB, alB, l_reg, pa0, pa1); SBAR();
  pv_all(o, vb0 + ((NT - 1) & 3) * (int)SHM_V, pa0, pa1);
  asm volatile("s_waitcnt vmcnt(0)" ::: "memory");
#undef DMA
#undef LAND
#undef KB
#undef QK_SCHED
#else
  const int sr = tid >> 4, sc = (tid & 15) * 8, vst0 = v_st(sr, sc), vst1 = v_st(sr, 128 + sc);
#ifndef ATT_KDMA
#define ATT_KDMA 1
#endif
#if ATT_KDMA
  struct { bf16x8 vs0, vs1; } sr_[SDEPTH];
  const int kdc = (((tid & 15) ^ (sr & 7)) << 3);
  const unsigned kdl = (unsigned)(uintptr_t)(LAS unsigned char*)K_lds + ((unsigned)__builtin_amdgcn_readfirstlane(wid) << 10);
#define KDMA(b, k0) __builtin_amdgcn_global_load_lds((const unsigned*)(Kh + (long)((k0) + sr) * LDK + kdc), (LAS unsigned*)(kdl + (b) * (unsigned)SHM_K), 16, 0, 0)
#define SLOAD(i, k0, b) do { sr_[i].vs0 = *reinterpret_cast<const bf16x8*>(&Vh[(long)((k0) + sr) * LDK + sc]); sr_[i].vs1 = *reinterpret_cast<const bf16x8*>(&Vh[(long)((k0) + sr) * LDK + 128 + sc]); KDMA(b, k0); } while (0)
#define SWRITE(b, i) do { *(bf16x8*)((char*)V_lds + (b) * SHM_V + vst0) = sr_[i].vs0;          \
    *(bf16x8*)((char*)V_lds + (b) * SHM_V + vst1) = sr_[i].vs1; } while (0)
#else
  struct { bf16x8 vs0, vs1, ks0; } sr_[SDEPTH];
#define SLOAD(i, k0, b) do { sr_[i].vs0 = *reinterpret_cast<const bf16x8*>(&Vh[(long)((k0) + sr) * LDK + sc]); sr_[i].vs1 = *reinterpret_cast<const bf16x8*>(&Vh[(long)((k0) + sr) * LDK + 128 + sc]); \
    sr_[i].ks0 = *reinterpret_cast<const bf16x8*>(&Kh[(long)((k0) + sr) * LDK + sc]); } while (0)
#define SWRITE(b, i) do { *(bf16x8*)((char*)V_lds + (b) * SHM_V + vst0) = sr_[i].vs0;          \
    *(bf16x8*)((char*)V_lds + (b) * SHM_V + vst1) = sr_[i].vs1;                                 \
    *(bf16x8*)((char*)K_lds + (b) * SHM_K + KSWZ(sr, sc * 2)) = sr_[i].ks0; } while (0)
#endif
#define SWAIT() do { if constexpr (SDEPTH == 2) asm volatile("s_waitcnt vmcnt(3)" ::: "memory"); else asm volatile("s_waitcnt vmcnt(0)" ::: "memory"); } while (0)
  f32x16 pA, pB; float mnA, mnB, alA, alB; bf16x8 pa0, pa1; const int NT = seq / KVBLK;
  constexpr int SE = 0, SO = SDEPTH - 1;
  SLOAD(SE, 0, 0); asm volatile("s_waitcnt vmcnt(0)" ::: "memory"); SWRITE(0, SE); __syncthreads();
  qkt(pA, K_lds, qr, r32, hi); partialSM(pA, m_reg, mnA, alA);
  SLOAD(SO, KVBLK, 1); if constexpr (SDEPTH == 2) { if (2 < NT) SLOAD(SE, 2 * KVBLK, 0); }
  SWAIT(); SWRITE(1, SO); __syncthreads();
  for (int j = 1; j + 1 < NT; j += 2) {
    SBAR(); qkt(pB, (bf16_t*)((char*)K_lds + SHM_K), qr, r32, hi);
    finishSM(pA, alA, l_reg, pa0, pa1); SBAR();
    SLOAD(SO, (j + SDEPTH) * KVBLK, 0); SBAR();
    pv_all(o, vb0, pa0, pa1); partialSM(pB, m_reg, mnB, alB);
    __syncthreads(); SWAIT(); SWRITE(0, SE);
    RESC(alB); __syncthreads();
    SBAR(); qkt(pA, K_lds, qr, r32, hi);
    finishSM(pB, alB, l_reg, pa0, pa1); SBAR();
    if (SDEPTH == 1 || j + 3 < NT) SLOAD(SE, (j + 1 + SDEPTH) * KVBLK, 1); SBAR();
    pv_all(o, vb0 + (int)SHM_V, pa0, pa1); partialSM(pA, m_reg, mnA, alA);
    __syncthreads(); SWAIT(); SWRITE(1, SO);
    RESC(alA); __syncthreads();
  }
  SBAR(); qkt(pB, (bf16_t*)((char*)K_lds + SHM_K), qr, r32, hi);
  finishSM(pA, alA, l_reg, pa0, pa1); SBAR();
  pv_all(o, vb0, pa0, pa1); partialSM(pB, m_reg, mnB, alB);
  __syncthreads(); RESC(alB);
  finishSM(pB, alB, l_reg, pa0, pa1); SBAR();
  pv_all(o, vb0 + (int)SHM_V, pa0, pa1);
#undef SLOAD
#undef SWRITE
#undef SWAIT
#ifdef KDMA
#undef KDMA
#endif
#endif
  if (hi == 0) li_l[r32] = l_reg; asm volatile("s_waitcnt lgkmcnt(0)" ::: "memory");
  float rli[16];
#pragma unroll
  for (int r = 0; r < 16; ++r) rli[r] = __builtin_amdgcn_rcpf(li_l[crow(r, hi)]);
  unsigned* Ow = Ob + (long)(wid * QBLK) * (LDO / 2);
#pragma unroll
  for (int r = 0; r < 16; ++r) { int orow = crow(r, hi);
    for (int k = 0; k < 4; ++k) Ow[(long)orow * (LDO / 2) + k * 32 + r32] = cvtpk(o[2 * k][r] * rli[r], o[2 * k + 1][r] * rli[r]); }
#undef RESC
}
#undef KSWZ
#undef SBAR
#undef QV
}

struct Args { const float* in[38]; float* out; unsigned char* ws; int ph_lo, ph_hi; };
enum { I_X = 0, I_C, I_CTX, I_CCTX, I_WADA, I_BADA, I_NORM1, I_NORM2, I_WIN, I_BGATE, I_QNORM, I_KNORM, I_LQ1, I_LK1, I_LQ2, I_LK2, I_SUBN, I_HCW, I_HCB,
       I_HW1, I_HB1, I_HW2, I_HB2, I_HW3, I_HB3, I_HW4, I_HFREQ, I_HBIAS, I_WBRA, I_WBRB, I_WOUT, I_FW1, I_FW3, I_FW2, I_ROUTER, I_MW1, I_MW3, I_MW2 };

struct Frame {
    LAS unsigned char* lds; char* ldsg;
    const float* const* in; float* out; unsigned char* ws;
    int tid, lane, wave, G, bid, gw, NGW;
};

__device__ __forceinline__ Frame enter(const Frame& F0) {
    Frame F = F0; __attribute__((address_space(1))) unsigned char* w = (__attribute__((address_space(1))) unsigned char*)F0.ws; asm volatile("" : "+s"(w)); F.ws = (unsigned char*)w;
    const int t = hw_tid(F0.wave); F.tid = t; F.lane = t & 63; return F;
}
__host__ __device__ __forceinline__ int qk_perm(int d) { const int axis = d >> 6, half = (d >> 5) & 1, f = d & 31; return 32 * (2 * axis + (f >> 4)) + 8 * ((f >> 2) & 3) + 4 * half + (f & 3); }
__device__ __forceinline__ void transpose_item(const float* W, int K, int N, bf16_t* WT, int kb, int nb, int dst_row0, LAS float* scr, int lane, bool qkperm = false) {
    const int k0 = 64 * kb, n0 = 32 * nb;
    { f32x4 v[8]; const float* wp = W + (size_t)(k0 + (lane >> 3)) * N + n0 + 4 * (lane & 7);
#pragma unroll
      for (int i = 0; i < 8; ++i) v[i] = __builtin_nontemporal_load((const f32x4*)(wp + (size_t)(8 * i) * N));
#pragma unroll
      for (int i = 0; i < 8; ++i) { LAS float* d = scr + (8 * i + (lane >> 3)) * 33 + 4 * (lane & 7); d[0] = v[i].x; d[1] = v[i].y; d[2] = v[i].z; d[3] = v[i].w; } }
    LDS_WAIT(); asm volatile("" ::: "memory");
    const int c = lane & 7;
#pragma unroll
    for (int j = 0; j < 4; ++j) { const int n = (lane >> 3) + 8 * j; const LAS float* s = scr + (8 * c) * 33 + n;
        u32x4 o; o.x = cvt_pk_bf16(s[0 * 33], s[1 * 33]); o.y = cvt_pk_bf16(s[2 * 33], s[3 * 33]); o.z = cvt_pk_bf16(s[4 * 33], s[5 * 33]); o.w = cvt_pk_bf16(s[6 * 33], s[7 * 33]);
        const int drow = qkperm ? ((n0 + n) & ~127) + qk_perm((n0 + n) & 127) : dst_row0 + n;
        __builtin_nontemporal_store(o, (u32x4*)(WT + (size_t)drow * K + k0 + 8 * c)); }
    LDS_WAIT(); asm volatile("" ::: "memory");
}
__device__ __forceinline__ float silu_f(float v) { return v / (1.f + __expf(-v)); }

namespace zt {
constexpr int L_WIN = 32 * 512, L_BR = 3 * 32 * 64, L_UP1 = 2 * 32 * 176, L_DN1 = 88 * 64;
constexpr int L_DENSE = L_WIN + L_BR + L_UP1 + L_DN1, L_MOE = L_WIN + L_BR + 8 * (L_UP1 + L_DN1);
constexpr int Z1 = L_DENSE, Z2 = Z1 + L_MOE, Z3 = Z2 + L_DENSE, ZEND = Z3 + L_MOE;
#ifndef ZT_NH
#define ZT_NH 0
#endif
#ifndef ZT_NI
#define ZT_NI 7
#endif
constexpr int BUSY = 32, WORKERS = (256 - BUSY) * NWAVES, CH = ZT_NH * WORKERS, CI = ZT_NI * WORKERS, CL = CH + CI;
constexpr int ZB0 = Z1, ZB1 = (ZB0 + CL > Z1 + L_WIN + L_BR) ? ZB0 + CL : Z1 + L_WIN + L_BR, ZB2 = Z2 + L_WIN + L_BR;
static_assert(ZB1 + CL <= Z2 && ZB2 + CL <= ZEND, "tail ranges");
__device__ __forceinline__ bool deferred(int G) { return G == 256 && CL > 0; }
}
__device__ __forceinline__ void transpose_z(const Frame& F, int z, LAS float* scr) {
    const int l = z < zt::Z1 ? 0 : (z < zt::Z2 ? 1 : (z < zt::Z3 ? 2 : 3)); int r = z - (l == 0 ? 0 : (l == 1 ? zt::Z1 : (l == 2 ? zt::Z2 : zt::Z3)));
    const float* src; bf16_t* dst; int K, N, kb, nb, dr; bool qp = false;
    if (r < zt::L_WIN) { kb = r / 512; nb = r % 512; const int n0 = 32 * nb; K = DM; N = NIN;
        dr = n0 < 6144 ? n0 : (n0 < 12288 ? NQKVG + (n0 - 6144) : 6144 + (n0 - 12288)); qp = n0 < 4096;
        src = F.in[I_WIN] + (size_t)l * DM * NIN; dst = (bf16_t*)(F.ws + WS_WIN) + (size_t)l * NIN * DM; }
    else if ((r -= zt::L_WIN) < zt::L_BR) { const int w = r / 2048, q = r % 2048; kb = q / 64; nb = q % 64; K = DM; N = DM; dr = 32 * nb;
        src = F.in[w == 0 ? I_WBRA : (w == 1 ? I_WBRB : I_WOUT)] + (size_t)l * DM * DM;
        dst = (bf16_t*)(F.ws + (w == 0 ? WS_WBRA : (w == 1 ? WS_WBRB : WS_WOUT))) + (size_t)l * DM * DM; }
    else { r -= zt::L_BR; const bool moe = (l & 1) != 0; const int ns = moe ? 8 : 1, slot0 = moe ? 2 + (l >> 1) * 8 : (l >> 1);
        if (r < ns * zt::L_UP1) { const int slot = slot0 + r / zt::L_UP1, q0 = r % zt::L_UP1, which = q0 / (32 * 176), q = q0 % (32 * 176); kb = q / 176; nb = q % 176; const int n0 = 32 * nb; K = DM; N = DFF;
            dr = (n0 / 128) * 256 + which * 128 + (n0 % 128);
            src = slot < 2 ? F.in[which ? I_FW3 : I_FW1] + (size_t)slot * DM * DFF : F.in[which ? I_MW3 : I_MW1] + (size_t)(slot - 2) * DM * DFF;
            dst = (bf16_t*)(F.ws + WS_WUP) + (size_t)slot * 2 * DFF * DM; }
        else { r -= ns * zt::L_UP1; const int slot = slot0 + r / zt::L_DN1, q = r % zt::L_DN1; kb = q / 64; nb = q % 64; K = DFF; N = DM; dr = 32 * nb;
            src = slot < 2 ? F.in[I_FW2] + (size_t)slot * DFF * DM : F.in[I_MW2] + (size_t)(slot - 2) * DFF * DM;
            dst = (bf16_t*)(F.ws + WS_WDN) + (size_t)slot * DM * DFF; } }
    transpose_item(src, K, N, dst, kb, nb, dr, scr, F.lane, qp);
}
__device__ __forceinline__ void phase_tail_transposes(const Frame& F0, int l, int which) {
    Frame F = enter(F0);
    if (!zt::deferred(F.G) || F.bid < zt::BUSY || l >= DEPTH - 1) return;
    LAS float* scr = (LAS float*)(F.lds + F.wave * 16384);
    const int zlo = (l == 0 ? zt::ZB0 : (l == 1 ? zt::ZB1 : zt::ZB2)) + (which ? zt::CH : 0), zhi = zlo + (which ? zt::CI : zt::CH);
    for (int z = zlo + (F.bid - zt::BUSY) * NWAVES + F.wave; z < zhi; z += zt::WORKERS) transpose_z(F, z, scr);
}
__device__ __forceinline__ void phase_prologue0(const Frame& F0) {
    Frame F = enter(F0);
    LAS float* scr = (LAS float*)(F.lds + F.wave * 16384);
    {
        const bool defer = zt::deferred(F.G);
        const int n0 = defer ? zt::ZB0 : zt::ZEND, ng = defer ? zt::ZB1 - (zt::ZB0 + zt::CL) : 0, n1 = defer ? zt::ZB2 - (zt::ZB1 + zt::CL) : 0, n2 = defer ? zt::ZEND - (zt::ZB2 + zt::CL) : 0, np = n0 + ng + n1 + n2;
        for (int px = F.gw; px < np * ((PROBE == 4) ? 2 : 1); px += F.NGW) { const int p = px % np;
            const int z = p < n0 ? p : (p < n0 + ng ? zt::ZB0 + zt::CL + (p - n0) : (p < n0 + ng + n1 ? zt::ZB1 + zt::CL + (p - n0 - ng) : zt::ZB2 + zt::CL + (p - n0 - ng - n1)));
            transpose_z(F, z, scr); }
    }
    {
        LAS float* zb = (LAS float*)(F.lds + F.wave * 16384);
        const int l = F.gw & 3, j = F.lane;
        float w1c[33], w2c[64], w3c[64];
#pragma unroll
        for (int i = 0; i < 33; ++i) w1c[i] = F.in[I_HW1][((size_t)l * 33 + i) * 64 + j];
#pragma unroll
        for (int i = 0; i < 64; ++i) { w2c[i] = F.in[I_HW2][((size_t)l * 64 + i) * 64 + j]; w3c[i] = F.in[I_HW3][((size_t)l * 64 + i) * 64 + j]; }
        const float fr = F.in[I_HFREQ][l * 64 + j], b1 = F.in[I_HB1][l * 64 + j], b2 = F.in[I_HB2][l * 64 + j], b3 = F.in[I_HB3][l * 64 + j];
        const int nq = 4352 * ((PROBE == 12) ? 2 : 1);
        for (int qx = F.gw >> 2; qx < nq; qx += F.NGW >> 2) {
            const int q = qx % 4352; const int var = q >= 4096, t = var ? q - 4096 : q, L = var ? 256 : 4096;
            float z = 0.f;
            if (j == 0) z = (float)t / (float)(L - 1);
            else if (j < 33) { const int k = (j - 1) & 15; const float w = 6.283185307179586f * (float)t / (float)L; const float f = 1e-4f + (float)k * ((15.f - 1e-4f) / 15.f);
                z = (j < 17) ? cosf(w * f) : -sinf(w * f); }
            zb[j] = z; LDS_WAIT(); asm volatile("" ::: "memory");
            float a = b1;
#pragma unroll
            for (int i = 0; i < 33; ++i) a += zb[i] * w1c[i];
            float h = sinf(fr * a);
            zb[64 + j] = h; LDS_WAIT(); asm volatile("" ::: "memory");
            a = b2;
#pragma unroll
            for (int i = 0; i < 64; ++i) a += zb[64 + i] * w2c[i];
            h = sinf(fr * a);
            zb[j] = h; LDS_WAIT(); asm volatile("" ::: "memory");
            a = b3;
#pragma unroll
            for (int i = 0; i < 64; ++i) a += zb[i] * w3c[i];
            h = sinf(fr * a);
            float* dst = var ? (float*)(F.ws + WS_HIDC) + ((size_t)l * 256 + t) * 64 : (float*)(F.ws + WS_HID) + ((size_t)l * 4096 + t) * 64;
            dst[j] = h;
            LDS_WAIT(); asm volatile("" ::: "memory");
        }
    }
    if (F.bid == 0 && F.wave < 4) {
        const int l = F.wave; const int j = F.lane;
        float s1 = F.in[I_LQ1][l * 128 + j] * F.in[I_LK1][l * 128 + j] + F.in[I_LQ1][l * 128 + 64 + j] * F.in[I_LK1][l * 128 + 64 + j];
        float s2 = F.in[I_LQ2][l * 128 + j] * F.in[I_LK2][l * 128 + j] + F.in[I_LQ2][l * 128 + 64 + j] * F.in[I_LK2][l * 128 + 64 + j];
        s1 = wave_sum(s1, j); s2 = wave_sum(s2, j);
        const float lam_init = 0.8f - 0.6f * expf(-0.3f * (float)l);
        if (j == 0) ((float*)(F.ws + WS_LAM))[l] = expf(s1) - expf(s2) + lam_init;
    }
    if (F.bid == 1 % F.G) {
        for (int i = F.tid; i < 2048; i += NTHR) { const int pos = i >> 5, f = i & 31; const float inv = expf(-(float)f * (9.210340371976184f / 32.f)); const float ang = (float)pos * inv;
            ((float*)(F.ws + WS_ROPE))[i] = cosf(ang); ((float*)(F.ws + WS_ROPE))[2048 + i] = sinf(ang); }
    }
    __syncthreads();
    {
        LAS float* sv = (LAS float*)F.lds;
        LAS float* red = (LAS float*)(F.lds + 65536);
        bool have = false;
        const int half = F.lane >> 5, l4 = (F.lane & 31) * 4;
        for (int itx = F.bid; itx < 4 * 96 * ((PROBE == 13) ? 2 : 1); itx += F.G) { const int it = itx % (4 * 96);
            if (!have) { for (int i = F.tid; i < 5 * DM; i += NTHR) { const int v = i / DM, k = i % DM; const float cv = v < 4 ? F.in[I_C][v * DM + k] : F.in[I_CCTX][k]; sv[i] = silu_f(cv); } have = true; __syncthreads(); }
            const int l = it / 96, cc = it % 96;
            const float* W = F.in[I_WADA] + (size_t)l * DM * 12288 + cc * 128 + l4;
            f32x4 acc[5];
#pragma unroll
            for (int v = 0; v < 5; ++v) acc[v] = (f32x4){0.f, 0.f, 0.f, 0.f};
            const int k0 = F.wave * 256 + half;
#pragma unroll 8
            for (int kk = 0; kk < 128; ++kk) { const int k = k0 + 2 * kk; const f32x4 w = *(const f32x4*)(W + (size_t)k * 12288);
#pragma unroll
                for (int v = 0; v < 5; ++v) acc[v] += w * sv[v * DM + k]; }
#pragma unroll
            for (int v = 0; v < 5; ++v)
#pragma unroll
                for (int q = 0; q < 4; ++q) acc[v][q] += shx(acc[v][q], 32, F.lane);
            if (half == 0) {
#pragma unroll
                for (int v = 0; v < 5; ++v) *(LAS f32x4*)(red + (F.wave * 5 + v) * 128 + l4) = acc[v]; }
            __syncthreads();
            for (int i = F.tid; i < 5 * 128; i += NTHR) { const int v = i / 128, c = i % 128; float sm = 0.f;
#pragma unroll
                for (int w = 0; w < 8; ++w) sm += red[(w * 5 + v) * 128 + c];
                ((float*)(F.ws + WS_MOD))[((size_t)l * 5 + v) * 12288 + cc * 128 + c] = sm + F.in[I_BADA][l * 12288 + cc * 128 + c]; }
            __syncthreads();
        }
    }
}

__device__ __forceinline__ void split8(const float (&x)[8], bf16x8& hi, bf16x8& lo) {
    u32x4 h, l;
#pragma unroll
    for (int k = 0; k < 4; ++k) { const unsigned hw = cvt_pk_bf16(x[2 * k], x[2 * k + 1]); h[k] = hw; l[k] = cvt_pk_bf16(x[2 * k] - bf_lo(hw), x[2 * k + 1] - bf_hi(hw)); }
    hi = *reinterpret_cast<bf16x8*>(&h); lo = *reinterpret_cast<bf16x8*>(&l);
}
__device__ __forceinline__ void phase_prologue1(const Frame& F0) {
    Frame F = enter(F0);
    const int n = F.lane & 31, hi = F.lane >> 5;
    for (int it = F.gw; it < 4 * 256 * 2; it += F.NGW) {
        const int l = it >> 9, cb = (it >> 1) & 255, half = it & 1;
        const int col0 = cb * 32, f = col0 >> 12, dir = (col0 >> 11) & 1, c0 = col0 & 2047;
        const float* w4 = F.in[I_HW4] + (size_t)l * 64 * 8192 + col0 + n;
        bf16x8 Ah[4], Al[4];
#pragma unroll
        for (int ks = 0; ks < 4; ++ks) { float xv[8];
#pragma unroll
            for (int i = 0; i < 8; ++i) xv[i] = w4[(size_t)(16 * ks + 8 * hi + i) * 8192];
            split8(xv, Ah[ks], Al[ks]); }
        const float da = -3.0701134573253945f, db = -15.350567286626972f;
#pragma unroll
        for (int var = 0; var < 2; ++var) {
            if (var == 1 && half != 0) continue;
            const int L = var ? 256 : 4096, ntb = var ? 8 : 64, tb0 = var ? 0 : half * 64;
            const float invL = 1.f / (float)(L - 1);
            float base[16], step[16];
#pragma unroll
            for (int r = 0; r < 16; ++r) { const int ch = c0 + (r & 3) + 8 * (r >> 2) + 4 * hi; const float delta = fabsf(da + (float)ch * ((db - da) / 2047.f));
                base[r] = expf(-delta * (float)(tb0 * 32 + n) * invL); step[r] = expf(-delta * 32.f * invL); }
            const float* hsrc = (var ? (const float*)(F.ws + WS_HIDC) + (size_t)l * 256 * 64 : (const float*)(F.ws + WS_HID) + (size_t)l * 4096 * 64) + (size_t)(tb0 * 32 + n) * 64 + 8 * hi;
            bf16_t* Rl = var ? (bf16_t*)(F.ws + WS_RC) + (((size_t)l * 2 + f) * 2048 + c0 + 4 * hi) * 1024 + 512 : (bf16_t*)(F.ws + WS_R) + (((size_t)l * 2 + f) * 2048 + c0 + 4 * hi) * 8704 + 4352;
            const int rstride = var ? 1024 : 8704;
            f32x4 hn[8];
#pragma unroll
            for (int ks = 0; ks < 4; ++ks) { hn[2 * ks] = *(const f32x4*)(hsrc + 16 * ks); hn[2 * ks + 1] = *(const f32x4*)(hsrc + 16 * ks + 4); }
            for (int tb = 0; tb < ntb; ++tb) {
                f32x16 acc = f32x16{};
                f32x4 hc[8];
#pragma unroll
                for (int k = 0; k < 8; ++k) hc[k] = hn[k];
                { const int tn = tb + 1 < ntb ? tb + 1 : tb;
#pragma unroll
                  for (int ks = 0; ks < 4; ++ks) { hn[2 * ks] = *(const f32x4*)(hsrc + (size_t)tn * 2048 + 16 * ks); hn[2 * ks + 1] = *(const f32x4*)(hsrc + (size_t)tn * 2048 + 16 * ks + 4); } }
#pragma unroll
                for (int ks = 0; ks < 4; ++ks) { const f32x4 b0 = hc[2 * ks], b1 = hc[2 * ks + 1];
                    const float xv[8] = {b0.x, b0.y, b0.z, b0.w, b1.x, b1.y, b1.z, b1.w}; bf16x8 Bh, Bl; split8(xv, Bh, Bl);
                    acc = __builtin_amdgcn_mfma_f32_32x32x16_bf16(Ah[ks], Bh, acc, 0, 0, 0);
                    acc = __builtin_amdgcn_mfma_f32_32x32x16_bf16(Ah[ks], Bl, acc, 0, 0, 0);
                    acc = __builtin_amdgcn_mfma_f32_32x32x16_bf16(Al[ks], Bh, acc, 0, 0, 0); }
                const int t = (tb0 + tb) * 32 + n;
#pragma unroll
                for (int r = 0; r < 16; ++r) { const float val = acc[r] * base[r]; base[r] *= step[r];
                    bf16_t* Rr = Rl + (size_t)((r & 3) + 8 * (r >> 2)) * rstride;
                    const bf16_t bv = (bf16_t)(cvt_pk_bf16(val, 0.f) & 0xffffu);
                    if (dir == 0) Rr[-t] = bv; else if (t >= 1) Rr[t] = bv; }
            }
        }
    }
    for (int it = F.gw; it < 4 * 2 * 2048; it += F.NGW) {
        bf16_t* R = (bf16_t*)(F.ws + WS_R) + (size_t)it * 8704; bf16_t* Rc = (bf16_t*)(F.ws + WS_RC) + (size_t)it * 1024;
        for (int x = F.lane; x < 257; x += 64) { R[x] = 0; Rc[x] = 0; }
        for (int x = F.lane; x < 256; x += 64) { R[8448 + x] = 0; Rc[768 + x] = 0; }
    }
}

__device__ __forceinline__ void ffn_row_load(Frame& F, int lp, int row, f32x4 (&f)[8]) {
    const bf16_t* ys = (const bf16_t*)(F.ws + AR_YS);
    if ((lp & 1) == 0) {
        if (row < ML) { const u32x2* p = (const u32x2*)(ys + (size_t)row * DM) + F.lane;
#pragma unroll
            for (int j = 0; j < 8; ++j) { const u32x2 w = __builtin_nontemporal_load(p + 64 * j); f[j] = (f32x4){bf_lo(w.x), bf_hi(w.x), bf_lo(w.y), bf_hi(w.y)}; }
        } else { const f32x4* p = (const f32x4*)((const float*)(F.ws + AR_YSC) + (size_t)(row - ML) * DM) + F.lane;
#pragma unroll
            for (int j = 0; j < 8; ++j) f[j] = ((p[64 * j] + p[64 * j + MC * DM / 4]) + p[64 * j + 2 * (MC * DM / 4)]) + p[64 * j + 3 * (MC * DM / 4)]; }
    } else {
        const int* ti = (const int*)(F.ws + WS_TOK) + (size_t)row * 8;
        const int e1 = ti[0], p1 = ti[1], e2 = ti[2], p2 = ti[3]; const float w1 = __int_as_float(ti[4]), w2 = __int_as_float(ti[5]);
        const unsigned* cnt = (const unsigned*)(F.ws + WS_CTL) + CW_CNT + (lp >> 1) * 8 * 64;
        int s1 = 0, s2 = 0;
#pragma unroll
        for (int e = 0; e < 8; ++e) { const int tl = ((int)cnt[e * 64] + 255) >> 8; s1 += (e < e1) ? tl : 0; s2 += (e < e2) ? tl : 0; }
        const u32x2* pa = (const u32x2*)(ys + (size_t)(s1 * 256 + p1) * DM) + F.lane;
        const u32x2* pb = (const u32x2*)(ys + (size_t)(s2 * 256 + p2) * DM) + F.lane;
#pragma unroll
        for (int j = 0; j < 8; ++j) { const u32x2 a = __builtin_nontemporal_load(pa + 64 * j), b = __builtin_nontemporal_load(pb + 64 * j);
            f[j] = (f32x4){w1 * bf_lo(a.x) + w2 * bf_lo(b.x), w1 * bf_hi(a.x) + w2 * bf_hi(b.x), w1 * bf_lo(a.y) + w2 * bf_lo(b.y), w1 * bf_hi(a.y) + w2 * bf_hi(b.y)}; }
    }
}
__device__ __forceinline__ void phase_normmod1(const Frame& F0, int l, int npass = 1) {
    Frame F = enter(F0);
#pragma nounroll
    for (int pass = 0; pass < npass; ++pass) { const bool dry = pass + 1 < npass;
    float* X = (float*)(F.ws + WS_X); bf16_t* H = (bf16_t*)(F.ws + (dry ? AR_O : AR_H)); float* Xw = dry ? (float*)(F.ws + AR_O + 68 * MiB) : X;
    const float* mod = (const float*)(F.ws + WS_MOD);
    f32x4 xn[8];
    { const int row = F.gw; const f32x4* src = (const f32x4*)(l == 0 ? (row < ML ? F.in[I_X] + (size_t)row * DM : F.in[I_CTX] + (size_t)(row - ML) * DM) : X + (size_t)row * DM) + F.lane;
#pragma unroll
      for (int j = 0; j < 8; ++j) xn[j] = src[64 * j]; }
    for (int row = F.gw; row < MT; row += F.NGW) {
        const int v = row < ML ? row / SEQ : 4;
        f32x4 x[8];
#pragma unroll
        for (int j = 0; j < 8; ++j) x[j] = xn[j];
        { const int rn = row + F.NGW < MT ? row + F.NGW : row;
          const f32x4* src = (const f32x4*)(l == 0 ? (rn < ML ? F.in[I_X] + (size_t)rn * DM : F.in[I_CTX] + (size_t)(rn - ML) * DM) : X + (size_t)rn * DM) + F.lane;
#pragma unroll
          for (int j = 0; j < 8; ++j) xn[j] = __builtin_nontemporal_load(src + 64 * j); }
        if (l != 0) {
            const f32x4* g2 = (const f32x4*)(mod + ((size_t)(l - 1) * 5 + v) * 12288 + 5 * DM) + F.lane;
            f32x4 f[8]; ffn_row_load(F, l - 1, row, f);
#pragma unroll
            for (int j = 0; j < 8; ++j) x[j] = x[j] + g2[64 * j] * f[j];
        }
        { f32x4* dst = (f32x4*)(Xw + (size_t)row * DM) + F.lane;
#pragma unroll
            for (int j = 0; j < 8; ++j) __builtin_nontemporal_store(x[j], dst + 64 * j); }
        float ss = 0.f;
#pragma unroll
        for (int j = 0; j < 8; ++j) ss += (x[j].x * x[j].x + x[j].y * x[j].y) + (x[j].z * x[j].z + x[j].w * x[j].w);
        const float rstd = 1.f / sqrtf(wave_sum(ss, F.lane) * (1.f / DM) + EPS);
        const f32x4* gn = (const f32x4*)(F.in[I_NORM1] + (size_t)l * DM) + F.lane;
        const f32x4* sh = (const f32x4*)(mod + ((size_t)l * 5 + v) * 12288) + F.lane;
        const f32x4* sc = (const f32x4*)(mod + ((size_t)l * 5 + v) * 12288 + DM) + F.lane;
        u32x2* o = (u32x2*)(H + (size_t)row * DM) + F.lane;
#pragma unroll
        for (int j = 0; j < 8; ++j) { const f32x4 y = (x[j] * rstd) * gn[64 * j]; const f32x4 h = y * (sc[64 * j] + 1.f) + sh[64 * j];
            u32x2 w; w.x = cvt_pk_bf16(h.x, h.y); w.y = cvt_pk_bf16(h.z, h.w); o[64 * j] = w; }
    }
    }
}
__device__ __forceinline__ void phase_final(const Frame& F0) {
    Frame F = enter(F0);
    const float* X = (const float*)(F.ws + WS_X); const float* mod = (const float*)(F.ws + WS_MOD);
    for (int row = F.gw; row < ML; row += F.NGW) {
        const int v = row / SEQ;
        const f32x4* src = (const f32x4*)(X + (size_t)row * DM) + F.lane;
        const f32x4* g2 = (const f32x4*)(mod + ((size_t)3 * 5 + v) * 12288 + 5 * DM) + F.lane;
        f32x4 f[8]; ffn_row_load(F, 3, row, f);
        f32x4* dst = (f32x4*)(F.out + (size_t)row * DM) + F.lane;
#pragma unroll
        for (int j = 0; j < 8; ++j) __builtin_nontemporal_store(__builtin_nontemporal_load(src + 64 * j) + g2[64 * j] * f[j], dst + 64 * j);
    }
}
__device__ __forceinline__ void phase_normmod2(const Frame& F0, int l) {
    Frame F = enter(F0);
    const float* X = (const float*)(F.ws + WS_X); const float* mod = (const float*)(F.ws + WS_MOD);
    const bool moe = (l & 1) != 0; const int nrows = (l == DEPTH - 1) ? ML : MT;
    bf16_t* H = (bf16_t*)(F.ws + AR_H); bf16_t* H2S = (bf16_t*)(F.ws + AR_H2S);
    unsigned* cnt = (unsigned*)(F.ws + WS_CTL) + CW_CNT + (l >> 1) * 8 * 64;
    const float* router = F.in[I_ROUTER] + (size_t)(l >> 1) * DM * 8;
    f32x4 xn[8];
    { const f32x4* src = (const f32x4*)(X + (size_t)(F.gw < nrows ? F.gw : 0) * DM) + F.lane;
#pragma unroll
      for (int j = 0; j < 8; ++j) xn[j] = src[64 * j]; }
    for (int row = F.gw; row < nrows; row += F.NGW) {
        const int v = row < ML ? row / SEQ : 4;
        f32x4 x[8]; float ss = 0.f;
#pragma unroll
        for (int j = 0; j < 8; ++j) { x[j] = xn[j]; ss += (x[j].x * x[j].x + x[j].y * x[j].y) + (x[j].z * x[j].z + x[j].w * x[j].w); }
        { const int rn = row + F.NGW < nrows ? row + F.NGW : row; const f32x4* src = (const f32x4*)(X + (size_t)rn * DM) + F.lane;
#pragma unroll
          for (int j = 0; j < 8; ++j) xn[j] = __builtin_nontemporal_load(src + 64 * j); }
        const float rstd = 1.f / sqrtf(wave_sum(ss, F.lane) * (1.f / DM) + EPS);
        const f32x4* gn = (const f32x4*)(F.in[I_NORM2] + (size_t)l * DM) + F.lane;
        const f32x4* sh = (const f32x4*)(mod + ((size_t)l * 5 + v) * 12288 + 3 * DM) + F.lane;
        const f32x4* sc = (const f32x4*)(mod + ((size_t)l * 5 + v) * 12288 + 4 * DM) + F.lane;
        u32x2 hw[8];
#pragma unroll
        for (int j = 0; j < 8; ++j) { const f32x4 y = (x[j] * rstd) * gn[64 * j]; x[j] = y * (sc[64 * j] + 1.f) + sh[64 * j];
            hw[j].x = cvt_pk_bf16(x[j].x, x[j].y); hw[j].y = cvt_pk_bf16(x[j].z, x[j].w); }
        if (!moe) {
            u32x2* o = (u32x2*)(H + (size_t)row * DM) + F.lane;
#pragma unroll
            for (int j = 0; j < 8; ++j) o[64 * j] = hw[j];
        } else {
            float lg[8];
#pragma unroll
            for (int e = 0; e < 8; ++e) lg[e] = 0.f;
#pragma unroll
            for (int j = 0; j < 8; ++j) {
                const f32x4* rp = (const f32x4*)(router + (size_t)(4 * (F.lane + 64 * j)) * 8);
#pragma unroll
                for (int i = 0; i < 4; ++i) { const f32x4 r0 = rp[2 * i], r1 = rp[2 * i + 1]; const float xv = x[j][i];
                    lg[0] += xv * r0.x; lg[1] += xv * r0.y; lg[2] += xv * r0.z; lg[3] += xv * r0.w; lg[4] += xv * r1.x; lg[5] += xv * r1.y; lg[6] += xv * r1.z; lg[7] += xv * r1.w; }
            }
#pragma unroll
            for (int e = 0; e < 8; ++e) lg[e] = wave_sum(lg[e], F.lane);
            float v1 = lg[0]; int i1 = 0;
#pragma unroll
            for (int e = 1; e < 8; ++e) if (lg[e] > v1) { v1 = lg[e]; i1 = e; }
            float v2 = -3.0e38f; int i2 = -1;
#pragma unroll
            for (int e = 0; e < 8; ++e) if (e != i1 && lg[e] > v2) { v2 = lg[e]; i2 = e; }
            const float w2 = 1.f / (1.f + expf(v1 - v2)), w1 = 1.f - w2;
            int p1 = 0, p2 = 0;
            if (F.lane == 0) { p1 = (int)__hip_atomic_fetch_add(cnt + i1 * 64, 1u, __ATOMIC_RELAXED, __HIP_MEMORY_SCOPE_AGENT); p2 = (int)__hip_atomic_fetch_add(cnt + i2 * 64, 1u, __ATOMIC_RELAXED, __HIP_MEMORY_SCOPE_AGENT); }
            p1 = __builtin_amdgcn_readfirstlane(p1); p2 = __builtin_amdgcn_readfirstlane(p2);
            if (F.lane == 0) { int* ti = (int*)(F.ws + WS_TOK) + (size_t)row * 8; ti[0] = i1; ti[1] = p1; ti[2] = i2; ti[3] = p2; ti[4] = __float_as_int(w1); ti[5] = __float_as_int(w2); }
            u32x2* oa = (u32x2*)(H2S + ((size_t)i1 * CAP + p1) * DM) + F.lane;
            u32x2* ob = (u32x2*)(H2S + ((size_t)i2 * CAP + p2) * DM) + F.lane;
#pragma unroll
            for (int j = 0; j < 8; ++j) { oa[64 * j] = hw[j]; ob[64 * j] = hw[j]; }
        }
    }
}
__device__ __forceinline__ void phase_combine_transpose(const Frame& F0, int l) {
    Frame F = enter(F0);
    const bool last = (l == DEPTH - 1); const int nrows = last ? ML : MT;
    const unsigned* O = (const unsigned*)(F.ws + AR_O); bf16_t* YA = (bf16_t*)(F.ws + AR_YAN);
    const float lam = ((const float*)(F.ws + WS_LAM))[l];
    const float lam_init = 0.8f - 0.6f * expf(-0.3f * (float)l);
    const int c0 = 64 * (F.lane >> 4) + 2 * (F.lane & 15);
    const float* gs = F.in[I_SUBN] + l * 256;
    const float g00 = gs[c0], g01 = gs[c0 + 32], g10 = gs[c0 + 1], g11 = gs[c0 + 33];
    for (int it = F.gw; it < nrows * 8; it += F.NGW) {
        const int row = it >> 3, d = it & 7;
        const u32x2 a = __builtin_nontemporal_load((const u32x2*)(O + (size_t)row * 2048 + (2 * d) * 128) + F.lane), b = __builtin_nontemporal_load((const u32x2*)(O + (size_t)row * 2048 + (2 * d + 1) * 128) + F.lane);
        const float o00 = bf_lo(a.x) - lam * bf_lo(b.x), o01 = bf_hi(a.x) - lam * bf_hi(b.x), o10 = bf_lo(a.y) - lam * bf_lo(b.y), o11 = bf_hi(a.y) - lam * bf_hi(b.y);
        const float ss = wave_sum((o00 * o00 + o01 * o01) + (o10 * o10 + o11 * o11), F.lane);
        const float rstd = (1.f - lam_init) / sqrtf(ss * (1.f / 256.f) + EPS);
        bf16_t* yp = YA + (size_t)row * DM + d * 256 + c0;
        *(unsigned*)yp = cvt_pk_bf16(o00 * rstd * g00, o10 * rstd * g10);
        *(unsigned*)(yp + 32) = cvt_pk_bf16(o01 * rstd * g01, o11 * rstd * g11);
    }
    const bf16_t* YBT = (const bf16_t*)(F.ws + AR_YBT); bf16_t* YB = (bf16_t*)(F.ws + AR_YB);
    LAS bf16_t* scr = (LAS bf16_t*)(F.lds + F.wave * 16384);
    const int ntt = nrows / 64;
    for (int it = F.gw; it < 32 * ntt; it += F.NGW) {
        const int cb = it / ntt, tb = it % ntt;
#pragma unroll
        for (int i = 0; i < 8; ++i) { const int c = 8 * i + (F.lane >> 3), tq = F.lane & 7;
            const u32x4 w = *(const u32x4*)(YBT + (size_t)(cb * 64 + c) * MT + tb * 64 + tq * 8);
            LAS unsigned* d = (LAS unsigned*)(scr + c * 66 + tq * 8); d[0] = w.x; d[1] = w.y; d[2] = w.z; d[3] = w.w; }
        LDS_WAIT(); asm volatile("" ::: "memory");
#pragma unroll
        for (int i = 0; i < 8; ++i) { const int t = 8 * i + (F.lane >> 3), cq = F.lane & 7;
            unsigned short e[8];
#pragma unroll
            for (int k = 0; k < 8; ++k) e[k] = scr[(cq * 8 + k) * 66 + t];
            u32x4 o; o.x = e[0] | ((unsigned)e[1] << 16); o.y = e[2] | ((unsigned)e[3] << 16); o.z = e[4] | ((unsigned)e[5] << 16); o.w = e[6] | ((unsigned)e[7] << 16);
            *(u32x4*)(YB + (size_t)(tb * 64 + t) * DM + cb * 64 + cq * 8) = o; }
        LDS_WAIT(); asm volatile("" ::: "memory");
    }
}

namespace hy {
constexpr int UST = 4616, UBYTES = 4 * UST * 2, RLEN = 8704, RBYTES = RLEN * 2, CH_BYTES = UBYTES + RBYTES;
__device__ __forceinline__ int crow(int r, int hi) { return (r & 3) + 8 * (r >> 2) + 4 * hi; }

__device__ __forceinline__ void conv_pass(const LAS unsigned char* U, const LAS unsigned char* R, int j0, int lane, f32x16 (&acc)[4]) {
    const int n = lane & 31, hi = lane >> 5, b = n & 3, qp = n >> 2;
#pragma unroll
    for (int j = 0; j < 4; ++j) acc[j] = f32x16{};
    const int xl = 4352 - n + 8 * hi - 256 * j0 - 768;
    const unsigned sh = (unsigned)(xl & 1) << 4;
    const int ub = (b * UST + 256 + 32 * qp + 8 * hi) * 2;
#ifndef HY_PF
#define HY_PF 1
#endif
    for (int dp = 0; dp < 16; ++dp) {
        const LAS unsigned char* pG = U + ub - 32 * dp;
        const LAS unsigned* pA = (const LAS unsigned*)R + ((xl - 16 * dp) >> 1);
        bf16x8 Gw[6];
        unsigned ra[HY_PF + 1][5];
#pragma unroll
        for (int p = 0; p < HY_PF; ++p) {
            Gw[p] = *(const LAS bf16x8*)(pG + 512 * p);
#pragma unroll
            for (int k = 0; k < 5; ++k) ra[p][k] = pA[128 * p + k];
        }
#pragma unroll
        for (int e2 = 0; e2 < 20; ++e2) {
            if (e2 + HY_PF < 20) {
#pragma unroll
                for (int k = 0; k < 5; ++k) ra[(e2 + HY_PF) % (HY_PF + 1)][k] = pA[128 * (e2 + HY_PF) + k];
                if (e2 + HY_PF <= 16) Gw[(e2 + HY_PF) % 6] = *(const LAS bf16x8*)(pG + 512 * (e2 + HY_PF));
            }
            const unsigned (&rc)[5] = ra[e2 % (HY_PF + 1)];
            u32x4 w; w.x = __builtin_amdgcn_alignbit(rc[1], rc[0], sh); w.y = __builtin_amdgcn_alignbit(rc[2], rc[1], sh); w.z = __builtin_amdgcn_alignbit(rc[3], rc[2], sh); w.w = __builtin_amdgcn_alignbit(rc[4], rc[3], sh);
            const bf16x8 A = *reinterpret_cast<const bf16x8*>(&w);
#pragma unroll
            for (int j = 0; j < 4; ++j) { const int J = j + e2 - 3; if (J >= 0 && J <= 16) acc[j] = __builtin_amdgcn_mfma_f32_32x32x16_bf16(A, Gw[J % 6], acc[j], 0, 0, 0); }
            __builtin_amdgcn_sched_barrier(0);
        }
    }
}

__device__ __forceinline__ void conv4(const bf16_t* seq, int s0, int Ls, float w0, float w1, float w2, float bb, float (&y)[4]) {
    const u32x2 w = *(const u32x2*)(seq + s0);
    const float l = s0 > 0 ? bf2f(seq[s0 - 1]) : 0.f, r = (s0 + 4 < Ls) ? bf2f(seq[s0 + 4]) : 0.f;
    const float x0 = bf_lo(w.x), x1 = bf_hi(w.x), x2 = bf_lo(w.y), x3 = bf_hi(w.y);
    y[0] = l * w0 + x0 * w1 + x1 * w2 + bb; y[1] = x0 * w0 + x1 * w1 + x2 * w2 + bb; y[2] = x1 * w0 + x2 * w1 + x3 * w2 + bb; y[3] = x2 * w0 + x3 * w1 + r * w2 + bb;
}
__device__ __forceinline__ u32x4 conv8_pk(const bf16_t* seq, int s0, int Ls, float w0, float w1, float w2, float bb) {
    const u32x4 w = *(const u32x4*)(seq + s0);
    const float left = s0 > 0 ? bf2f(seq[s0 - 1]) : 0.f, right = (s0 + 8 < Ls) ? bf2f(seq[s0 + 8]) : 0.f;
    const float xv[10] = {left, bf_lo(w.x), bf_hi(w.x), bf_lo(w.y), bf_hi(w.y), bf_lo(w.z), bf_hi(w.z), bf_lo(w.w), bf_hi(w.w), right};
    float y[8];
#pragma unroll
    for (int k = 0; k < 8; ++k) y[k] = xv[k] * w0 + xv[k + 1] * w1 + xv[k + 2] * w2 + bb;
    u32x4 o; o.x = cvt_pk_bf16(y[0], y[1]); o.y = cvt_pk_bf16(y[2], y[3]); o.z = cvt_pk_bf16(y[4], y[5]); o.w = cvt_pk_bf16(y[6], y[7]); return o;
}
typedef unsigned u32x4_a4 __attribute__((ext_vector_type(4), aligned(4)));
__device__ __forceinline__ u32x4 conv4_load(const bf16_t* seq, int s0) { const u32x4_a4 w = *(const u32x4_a4*)(seq + s0 - 2); return (u32x4){w.x, w.y, w.z, w.w}; }
__device__ __forceinline__ void conv4_eval(const u32x4 w, int s0, int Ls, float w0, float w1, float w2, float bb, float (&y)[4]) {
    const float l = s0 > 0 ? bf_hi(w.x) : 0.f, r = (s0 + 4 < Ls) ? bf_lo(w.w) : 0.f;
    const float x0 = bf_lo(w.y), x1 = bf_hi(w.y), x2 = bf_lo(w.z), x3 = bf_hi(w.z);
    y[0] = l * w0 + x0 * w1 + x1 * w2 + bb; y[1] = x0 * w0 + x1 * w1 + x2 * w2 + bb; y[2] = x1 * w0 + x2 * w1 + x3 * w2 + bb; y[3] = x2 * w0 + x3 * w1 + r * w2 + bb;
}
struct Conv8Raw { u32x4 w; unsigned lw, rw; };
__device__ __forceinline__ Conv8Raw conv8_load(const bf16_t* seq, int s0) { Conv8Raw r; r.w = *(const u32x4*)(seq + s0); r.lw = *(const unsigned*)(seq + s0 - 2); r.rw = *(const unsigned*)(seq + s0 + 8); return r; }
__device__ __forceinline__ u32x4 conv8_eval(const Conv8Raw& q, int s0, int Ls, float w0, float w1, float w2, float bb) {
    const u32x4 w = q.w;
    const float left = s0 > 0 ? bf_hi(q.lw) : 0.f, right = (s0 + 8 < Ls) ? bf_lo(q.rw) : 0.f;
    const float xv[10] = {left, bf_lo(w.x), bf_hi(w.x), bf_lo(w.y), bf_hi(w.y), bf_lo(w.z), bf_hi(w.z), bf_lo(w.w), bf_hi(w.w), right};
    float y[8];
#pragma unroll
    for (int k = 0; k < 8; ++k) y[k] = xv[k] * w0 + xv[k + 1] * w1 + xv[k + 2] * w2 + bb;
    u32x4 o; o.x = cvt_pk_bf16(y[0], y[1]); o.y = cvt_pk_bf16(y[2], y[3]); o.z = cvt_pk_bf16(y[4], y[5]); o.w = cvt_pk_bf16(y[6], y[7]); return o;
}
struct ConvW { float w0, w1, w2, bb; };
__device__ __forceinline__ ConvW conv_w(const Frame& F, int l, int cc) {
    ConvW w; w.w0 = F.in[I_HCW][((size_t)l * 3 + 0) * HYW + cc]; w.w1 = F.in[I_HCW][((size_t)l * 3 + 1) * HYW + cc]; w.w2 = F.in[I_HCW][((size_t)l * 3 + 2) * HYW + cc]; w.bb = F.in[I_HCB][(size_t)l * HYW + cc]; return w;
}

__device__ __forceinline__ void pair_body(Frame& F, int l, int c0, bool first) {
    const int tidq = opaque(F.tid); const int ch = F.wave >> 2, j0 = 4 * (F.wave & 3), c = c0 + ch, ltid = tidq & 255, lane = tidq & 63;
    LAS unsigned char* U = F.lds + ch * CH_BYTES; LAS unsigned char* R = U + UBYTES;
    const bf16_t* uT = (const bf16_t*)(F.ws + AR_UT);
    const bf16_t* vrow = uT + (size_t)c * MT, *x1row = uT + (size_t)(2048 + c) * MT, *x2row = uT + (size_t)(4096 + c) * MT;
    const bf16_t* Rg = (const bf16_t*)(F.ws + WS_R) + (((size_t)l * 2 + 0) * 2048 + c) * RLEN;
    const bf16_t* Rg2 = (const bf16_t*)(F.ws + WS_R) + (((size_t)l * 2 + 1) * 2048 + c) * RLEN;
    const float bias0 = F.in[I_HBIAS][((size_t)l * 2 + 0) * 2048 + c], bias1 = F.in[I_HBIAS][((size_t)l * 2 + 1) * 2048 + c];
    if (first) {
        for (int i = ltid; i < 4 * 65; i += 256) { const int b = i / 65, k = i % 65; const int el = k < 32 ? k * 8 : 4352 + (k - 32) * 8;
            *(LAS u32x4*)(U + (b * UST + el) * 2) = (u32x4){0u, 0u, 0u, 0u}; }
    }
    { const ConvW cw = conv_w(F, l, c); Conv8Raw raw[8];
#pragma unroll
      for (int k = 0; k < 8; ++k) { const int q = ltid + 256 * k, tok = 8 * q, b = tok >> 12, s = tok & 4095; raw[k] = conv8_load(vrow + b * SEQ, s); }
#pragma unroll
      for (int k = 0; k < 8; ++k) { const int q = ltid + 256 * k, tok = 8 * q, b = tok >> 12, s = tok & 4095;
        *(LAS u32x4*)(U + (b * UST + 256 + s) * 2) = conv8_eval(raw[k], s, SEQ, cw.w0, cw.w1, cw.w2, cw.bb); } }
    { u32x4 rr[5];
#pragma unroll
      for (int k = 0; k < 5; ++k) { const int q = ltid + 256 * k; if (q < RBYTES / 16) rr[k] = *(const u32x4*)((const char*)Rg + q * 16); }
#pragma unroll
      for (int k = 0; k < 5; ++k) { const int q = ltid + 256 * k; if (q < RBYTES / 16) *(LAS u32x4*)(R + q * 16) = rr[k]; } }
    __syncthreads();
    f32x16 acc[4];
    conv_pass(U, R, j0, lane, acc);
    const int n = lane & 31, hi = lane >> 5, b = n & 3, qp = n >> 2;
    u32x2 zp[4][4];
    { const ConvW cw = conv_w(F, l, 2048 + c); u32x4 xr[4][4];
#pragma unroll
    for (int j = 0; j < 4; ++j)
#pragma unroll
        for (int g = 0; g < 4; ++g) xr[j][g] = conv4_load(x1row + b * SEQ, 32 * (8 * (j0 + j) + qp) + 8 * g + 4 * hi);
#pragma unroll
    for (int j = 0; j < 4; ++j)
#pragma unroll
        for (int g = 0; g < 4; ++g) {
            const int t0 = 32 * (8 * (j0 + j) + qp) + 8 * g + 4 * hi;
            const u32x2 vv = *(const LAS u32x2*)(U + (b * UST + 256 + t0) * 2);
            float xx[4]; conv4_eval(xr[j][g], t0, SEQ, cw.w0, cw.w1, cw.w2, cw.bb, xx);
            const float z0 = xx[0] * (acc[j][4 * g + 0] + bias0 * bf_lo(vv.x)), z1 = xx[1] * (acc[j][4 * g + 1] + bias0 * bf_hi(vv.x));
            const float z2 = xx[2] * (acc[j][4 * g + 2] + bias0 * bf_lo(vv.y)), z3 = xx[3] * (acc[j][4 * g + 3] + bias0 * bf_hi(vv.y));
            zp[j][g].x = cvt_pk_bf16(z0, z1); zp[j][g].y = cvt_pk_bf16(z2, z3);
        } }
    __syncthreads();
#pragma unroll
    for (int j = 0; j < 4; ++j)
#pragma unroll
        for (int g = 0; g < 4; ++g) { const int t0 = 32 * (8 * (j0 + j) + qp) + 8 * g + 4 * hi; *(LAS u32x2*)(U + (b * UST + 256 + t0) * 2) = zp[j][g]; }
    { u32x4 rr[5];
#pragma unroll
      for (int k = 0; k < 5; ++k) { const int q = ltid + 256 * k; if (q < RBYTES / 16) rr[k] = *(const u32x4*)((const char*)Rg2 + q * 16); }
#pragma unroll
      for (int k = 0; k < 5; ++k) { const int q = ltid + 256 * k; if (q < RBYTES / 16) *(LAS u32x4*)(R + q * 16) = rr[k]; } }
    __syncthreads();
    conv_pass(U, R, j0, lane, acc);
    bf16_t* yrow = (bf16_t*)(F.ws + AR_YBT) + (size_t)c * MT;
    { const ConvW cw = conv_w(F, l, 4096 + c); u32x4 xr[4][4];
#pragma unroll
    for (int j = 0; j < 4; ++j)
#pragma unroll
        for (int g = 0; g < 4; ++g) xr[j][g] = conv4_load(x2row + b * SEQ, 32 * (8 * (j0 + j) + qp) + 8 * g + 4 * hi);
#pragma unroll
    for (int j = 0; j < 4; ++j)
#pragma unroll
        for (int g = 0; g < 4; ++g) {
            const int t0 = 32 * (8 * (j0 + j) + qp) + 8 * g + 4 * hi;
            const u32x2 zz = *(const LAS u32x2*)(U + (b * UST + 256 + t0) * 2);
            float xx[4]; conv4_eval(xr[j][g], t0, SEQ, cw.w0, cw.w1, cw.w2, cw.bb, xx);
            const float y0 = xx[0] * (acc[j][4 * g + 0] + bias1 * bf_lo(zz.x)), y1 = xx[1] * (acc[j][4 * g + 1] + bias1 * bf_hi(zz.x));
            const float y2 = xx[2] * (acc[j][4 * g + 2] + bias1 * bf_lo(zz.y)), y3 = xx[3] * (acc[j][4 * g + 3] + bias1 * bf_hi(zz.y));
            u32x2 o; o.x = cvt_pk_bf16(y0, y1); o.y = cvt_pk_bf16(y2, y3);
            *(u32x2*)(yrow + b * SEQ + t0) = o;
        } }
    __syncthreads();
}
constexpr int UCST = 776, UCBYTES = 4 * UCST * 2;
__device__ __forceinline__ f32x16 ctx_conv_pass(const LAS unsigned char* U, const LAS unsigned char* R, int lane) {
    const int n = lane & 31, hi = lane >> 5, b = n & 3, qp = n >> 2;
    f32x16 acc = f32x16{};
    const int xl = 512 + 240 - n + 8 * hi;
    const unsigned sh = (unsigned)(xl & 1) << 4;
    const LAS unsigned* pA = (const LAS unsigned*)R + (xl >> 1);
    const LAS unsigned char* pG = U + (b * UCST + 256 + 240 + 32 * qp + 8 * hi) * 2;
#pragma unroll
    for (int e = 0; e < 31; ++e) {
        const LAS unsigned* p = pA - 8 * e;
        const unsigned d0 = p[0], d1 = p[1], d2 = p[2], d3 = p[3], d4 = p[4];
        u32x4 w; w.x = __builtin_amdgcn_alignbit(d1, d0, sh); w.y = __builtin_amdgcn_alignbit(d2, d1, sh); w.z = __builtin_amdgcn_alignbit(d3, d2, sh); w.w = __builtin_amdgcn_alignbit(d4, d3, sh);
        const bf16x8 G = *(const LAS bf16x8*)(pG - 32 * e);
        acc = __builtin_amdgcn_mfma_f32_32x32x16_bf16(*reinterpret_cast<const bf16x8*>(&w), G, acc, 0, 0, 0);
    }
    return acc;
}
__device__ __forceinline__ void ctx_body(Frame& F, int l, int c) {
    const int lane = opaque(F.tid) & 63;
    LAS unsigned char* U = F.lds + F.wave * 16384; LAS unsigned char* R = U + UCBYTES;
    const bf16_t* uT = (const bf16_t*)(F.ws + AR_UT);
    const bf16_t* vrow = uT + (size_t)c * MT + ML, *x1row = uT + (size_t)(2048 + c) * MT + ML, *x2row = uT + (size_t)(4096 + c) * MT + ML;
    const bf16_t* R1 = (const bf16_t*)(F.ws + WS_RC) + (((size_t)l * 2 + 0) * 2048 + c) * 1024, *R2 = (const bf16_t*)(F.ws + WS_RC) + (((size_t)l * 2 + 1) * 2048 + c) * 1024;
    const float bias0 = F.in[I_HBIAS][((size_t)l * 2 + 0) * 2048 + c], bias1 = F.in[I_HBIAS][((size_t)l * 2 + 1) * 2048 + c];
    for (int i = lane; i < 4 * 65; i += 64) { const int b = i / 65, k = i % 65; const int el = k < 32 ? k * 8 : 512 + (k - 32) * 8;
        *(LAS u32x4*)(U + (b * UCST + el) * 2) = (u32x4){0u, 0u, 0u, 0u}; }
    { const ConvW cw = conv_w(F, l, c);
#pragma unroll
      for (int k = 0; k < 2; ++k) { const int q = lane + 64 * k, b = q >> 5, s = (q & 31) * 8;
        *(LAS u32x4*)(U + (b * UCST + 256 + s) * 2) = conv8_pk(vrow + b * LC, s, LC, cw.w0, cw.w1, cw.w2, cw.bb); } }
#pragma unroll
    for (int k = 0; k < 2; ++k) *(LAS u32x4*)(R + (lane + 64 * k) * 16) = *(const u32x4*)((const char*)R1 + (lane + 64 * k) * 16);
    LDS_WAIT(); asm volatile("" ::: "memory");
    f32x16 acc = ctx_conv_pass(U, R, lane);
    const int n = lane & 31, hi = lane >> 5, b = n & 3, qp = n >> 2;
    u32x2 zp[4];
    { const ConvW cw = conv_w(F, l, 2048 + c);
#pragma unroll
      for (int g = 0; g < 4; ++g) { const int t0 = 32 * qp + 8 * g + 4 * hi;
        const u32x2 vv = *(const LAS u32x2*)(U + (b * UCST + 256 + t0) * 2);
        float xx[4]; conv4(x1row + b * LC, t0, LC, cw.w0, cw.w1, cw.w2, cw.bb, xx);
        zp[g].x = cvt_pk_bf16(xx[0] * (acc[4 * g + 0] + bias0 * bf_lo(vv.x)), xx[1] * (acc[4 * g + 1] + bias0 * bf_hi(vv.x)));
        zp[g].y = cvt_pk_bf16(xx[2] * (acc[4 * g + 2] + bias0 * bf_lo(vv.y)), xx[3] * (acc[4 * g + 3] + bias0 * bf_hi(vv.y))); } }
    LDS_WAIT(); asm volatile("" ::: "memory");
#pragma unroll
    for (int g = 0; g < 4; ++g) { const int t0 = 32 * qp + 8 * g + 4 * hi; *(LAS u32x2*)(U + (b * UCST + 256 + t0) * 2) = zp[g]; }
#pragma unroll
    for (int k = 0; k < 2; ++k) *(LAS u32x4*)(R + (lane + 64 * k) * 16) = *(const u32x4*)((const char*)R2 + (lane + 64 * k) * 16);
    LDS_WAIT(); asm volatile("" ::: "memory");
    acc = ctx_conv_pass(U, R, lane);
    bf16_t* yrow = (bf16_t*)(F.ws + AR_YBT) + (size_t)c * MT + ML;
    { const ConvW cw = conv_w(F, l, 4096 + c);
#pragma unroll
      for (int g = 0; g < 4; ++g) { const int t0 = 32 * qp + 8 * g + 4 * hi;
        const u32x2 zz = *(const LAS u32x2*)(U + (b * UCST + 256 + t0) * 2);
        float xx[4]; conv4(x2row + b * LC, t0, LC, cw.w0, cw.w1, cw.w2, cw.bb, xx);
        u32x2 o; o.x = cvt_pk_bf16(xx[0] * (acc[4 * g + 0] + bias1 * bf_lo(zz.x)), xx[1] * (acc[4 * g + 1] + bias1 * bf_hi(zz.x)));
        o.y = cvt_pk_bf16(xx[2] * (acc[4 * g + 2] + bias1 * bf_lo(zz.y)), xx[3] * (acc[4 * g + 3] + bias1 * bf_hi(zz.y)));
        *(u32x2*)(yrow + b * LC + t0) = o; } }
    LDS_WAIT(); asm volatile("" ::: "memory");
}
}

__device__ __forceinline__ void phase_mixers(const Frame& F0, int l) {
    Frame F = enter(F0);
    const bool last = (l == DEPTH - 1);
    const bf16_t* Q = (const bf16_t*)(F.ws + AR_Q); const bf16_t* Kc = (const bf16_t*)(F.ws + AR_KC); const bf16_t* Vc = (const bf16_t*)(F.ws + AR_VC); unsigned* O = (unsigned*)(F.ws + AR_O);
#ifndef NO_ATT
    const int nitems = NB * 16 * 16 + (last ? 0 : NB * 16);
    const int nrep_a = (PROBE == 1) ? 2 : 1;
    for (int itx = F.bid; itx < nitems * nrep_a; itx += F.G) { const int it = itx % nitems;
        int h, b, seq; size_t row0;
        if (it < 1024) {
            const int x = it & 7, rk = (it >> 3) & 31, qb = rk & 15; h = 2 * x + (rk >> 4); b = it >> 8; row0 = (size_t)b * SEQ + qb * 256; seq = SKV; }
        else { const int i2 = it - 1024; h = i2 & 15; b = i2 >> 4; row0 = (size_t)ML + b * LC; seq = LC; }
        att::attn_dense_body(Q + row0 * DM + h * 128, Kc + (size_t)b * SKV * DM + h * 128, Vc + (size_t)b * SKV * DM + (h >> 1) * 256, O + row0 * 2048 + h * 128, seq, F.ldsg, F.wave);
        __syncthreads();
    }
#endif
#ifndef NO_HY
    bool first = true;
    const int nrep_h = (PROBE == 2) ? 2 : 1;
    for (int itx = F.bid; itx < 1024 * nrep_h; itx += F.G) { const int it = itx & 1023; hy::pair_body(F, l, 2 * it, first); first = false; }
#ifndef NO_HYC
    if (!last) for (int cx = F.gw; cx < 2048 * ((PROBE == 9) ? 2 : 1); cx += F.NGW) { const int c = cx & 2047; hy::ctx_body(F, l, c); }
#endif
#endif
}

using pg8::Unit;
constexpr int HALF = 128;
struct EpiBf16Plain {
    static constexpr bool PERM = true, CARRY = false;
    bf16_t* O; int ldc;
    __device__ __forceinline__ void operator()(const f32x4 (&acc)[2][2][4][2], const Unit& u, int wr, int wc, int fr, int fq) const {
        const int row0 = u.pm * 256 + wr * 64 + fr, col0 = u.pn * 256 + wc * 32 + 8 * fq;
#pragma unroll
        for (int ai = 0; ai < 2; ++ai)
#pragma unroll
            for (int m = 0; m < 4; ++m) { bf16_t* rowp = O + (size_t)(row0 + ai * HALF + m * 16) * ldc + col0;
#pragma unroll
                for (int bj = 0; bj < 2; ++bj) { const f32x4 v0 = acc[ai][bj][m][0], v1 = acc[ai][bj][m][1];
                    u32x4 w; w.x = cvt_pk_bf16(v0[0], v0[1]); w.y = cvt_pk_bf16(v0[2], v0[3]); w.z = cvt_pk_bf16(v1[0], v1[1]); w.w = cvt_pk_bf16(v1[2], v1[3]);
                    __builtin_nontemporal_store(w, (u32x4*)(rowp + bj * HALF)); } }
    }
};
struct EpiInProj {
    static constexpr bool PERM = true, CARRY = false;
    bf16_t *Q, *K, *V, *G; const float* bgate; const float* qgain; const float* kgain; const LAS float* rope; LAS unsigned char* lds;
    __device__ __forceinline__ void operator()(const f32x4 (&acc)[2][2][4][2], const Unit& u, int wr, int wc, int fr, int fq) const {
        const int pn = u.pn;
        if (pn < 16) {
            const bool isk = pn >= 8; const bool lat = u.pm < 64;
            LAS float* P = (LAS float*)lds;
#pragma unroll
            for (int ai = 0; ai < 2; ++ai)
#pragma unroll
                for (int m = 0; m < 4; ++m)
#pragma unroll
                    for (int bj = 0; bj < 2; ++bj) { const f32x4 a = acc[ai][bj][m][0], b = acc[ai][bj][m][1];
                        float ss = (a[0] * a[0] + a[1] * a[1]) + (a[2] * a[2] + a[3] * a[3]) + (b[0] * b[0] + b[1] * b[1]) + (b[2] * b[2] + b[3] * b[3]);
                        ss += shx(ss, 16, fr + 16 * fq); ss += shx(ss, 32, fr + 16 * fq);
                        if (fq == 0) P[((wr * 2 + bj) * 128 + ai * 64 + m * 16 + fr) * 4 + wc] = ss; }
            asm volatile("s_waitcnt lgkmcnt(0)" ::: "memory"); __builtin_amdgcn_s_barrier(); asm volatile("" ::: "memory");
            const int axis = wc >> 1, f0 = 16 * (wc & 1) + 4 * fq, d0 = 64 * axis + f0;
            const float* gp = isk ? kgain : qgain;
            const f32x4 g0 = *(const f32x4*)(gp + d0), g1 = *(const f32x4*)(gp + d0 + 32);
            const int rowt = isk ? (lat ? (u.pm >> 4) * SKV + LC + (u.pm & 15) * 256 : (u.pm - 64) * SKV) : u.pm * 256;
            bf16_t* base = (isk ? K : Q) + (size_t)(rowt + wr * 64 + fr) * DM + (isk ? pn - 8 : pn) * 256 + wc * 32 + 8 * fq;
#pragma unroll
            for (int ai = 0; ai < 2; ++ai)
#pragma unroll
                for (int m = 0; m < 4; ++m) {
                    f32x4 cs = (f32x4){1.f, 1.f, 1.f, 1.f}, sn = (f32x4){0.f, 0.f, 0.f, 0.f};
                    if (lat) { const int pos = axis ? (16 * m + fr) : (4 * (u.pm & 15) + 2 * ai + wr); cs = *(const LAS f32x4*)(rope + pos * 32 + f0); sn = *(const LAS f32x4*)(rope + 2048 + pos * 32 + f0); }
#pragma unroll
                    for (int bj = 0; bj < 2; ++bj) {
                        const f32x4 pp = *(const LAS f32x4*)(P + ((wr * 2 + bj) * 128 + ai * 64 + m * 16 + fr) * 4);
                        const float rstd = __builtin_amdgcn_rsqf(((pp[0] + pp[1]) + (pp[2] + pp[3])) * (1.f / 128.f) + EPS);
                        const f32x4 a = (acc[ai][bj][m][0] * rstd) * g0, b = (acc[ai][bj][m][1] * rstd) * g1;
                        const f32x4 ra = a * cs - b * sn, rb = a * sn + b * cs;
                        u32x4 w; w.x = cvt_pk_bf16(ra[0], ra[1]); w.y = cvt_pk_bf16(ra[2], ra[3]); w.z = cvt_pk_bf16(rb[0], rb[1]); w.w = cvt_pk_bf16(rb[2], rb[3]);
                        *(u32x4*)(base + (size_t)(ai * HALF + m * 16) * DM + bj * HALF) = w; } }
            return;
        }
        bf16_t* basep; int ldc = DM, colt; int rowt = u.pm * 256; const bool gate = pn >= 24;
        if (pn < 24) { basep = V; colt = (pn - 16) * 256; rowt = u.pm < 64 ? (u.pm >> 4) * SKV + LC + (u.pm & 15) * 256 : (u.pm - 64) * SKV; }
        else { basep = G; colt = (pn - 24) * 256; ldc = 4096; }
        const int row0 = rowt + wr * 64 + fr, col0 = colt + wc * 32 + 8 * fq;
        f32x4 bv[2][2];
#pragma unroll
        for (int bj = 0; bj < 2; ++bj)
#pragma unroll
            for (int n = 0; n < 2; ++n) bv[bj][n] = gate ? *(const f32x4*)(bgate + col0 + bj * HALF + 4 * n) : (f32x4){0.f, 0.f, 0.f, 0.f};
#pragma unroll
        for (int ai = 0; ai < 2; ++ai)
#pragma unroll
            for (int m = 0; m < 4; ++m) { bf16_t* rowp = basep + (size_t)(row0 + ai * HALF + m * 16) * ldc + col0;
#pragma unroll
                for (int bj = 0; bj < 2; ++bj) { f32x4 v0 = acc[ai][bj][m][0] + bv[bj][0], v1 = acc[ai][bj][m][1] + bv[bj][1];
                    if (gate) {
#pragma unroll
                        for (int i = 0; i < 4; ++i) { v0[i] = __builtin_amdgcn_rcpf(1.f + __expf(-v0[i])); v1[i] = __builtin_amdgcn_rcpf(1.f + __expf(-v1[i])); } }
                    u32x4 w; w.x = cvt_pk_bf16(v0[0], v0[1]); w.y = cvt_pk_bf16(v0[2], v0[3]); w.z = cvt_pk_bf16(v1[0], v1[1]); w.w = cvt_pk_bf16(v1[2], v1[3]);
                    *(u32x4*)(rowp + bj * HALF) = w; } }
    }
};
struct EpiMergePair {
    static constexpr bool PERM = true, CARRY = true;
    const bf16_t* gates; bf16_t* Mo;
    __device__ __forceinline__ bool carry(f32x4 (&acc)[2][2][4][2], const Unit& u, int wr, int wc, int fr, int fq) const {
        const int row0 = u.pm * 256 + wr * 64 + fr, col0 = u.pn * 256 + wc * 32 + 8 * fq;
        const bf16_t* gbase = gates + (size_t)row0 * 4096 + col0;
#define MP_ROW(i) ((size_t)((((i) >> 3) * HALF) + (((i) >> 1) & 3) * 16))
#define MP_G(i, off) (*(const u32x4*)(gbase + MP_ROW(i) * 4096 + ((i) & 1) * HALF + (off)))
#define MP_UNPK(WV, FV) const float FV[8] = {bf_lo(WV.x), bf_hi(WV.x), bf_lo(WV.y), bf_hi(WV.y), bf_lo(WV.z), bf_hi(WV.z), bf_lo(WV.w), bf_hi(WV.w)}
        if (u.kind == 0) {
            u32x4 ga_[2][4], gb_[2][4];
#pragma unroll
            for (int k = 0; k < 4; ++k) { ga_[0][k] = MP_G(k, 0); gb_[0][k] = MP_G(k, DM); }
#pragma unroll
            for (int b = 0; b < 4; ++b) {
                if (b + 1 < 4) {
#pragma unroll
                    for (int k = 0; k < 4; ++k) { ga_[(b + 1) & 1][k] = MP_G(4 * (b + 1) + k, 0); gb_[(b + 1) & 1][k] = MP_G(4 * (b + 1) + k, DM); } }
#pragma unroll
                for (int k = 0; k < 4; ++k) { const int i = 4 * b + k, ai = i >> 3, m = (i >> 1) & 3, bj = i & 1;
                    MP_UNPK(ga_[b & 1][k], ga); MP_UNPK(gb_[b & 1][k], gb);
#pragma unroll
                    for (int e = 0; e < 4; ++e) { acc[ai][bj][m][0][e] *= ga[e] * __builtin_amdgcn_rcpf(gb[e]); acc[ai][bj][m][1][e] *= ga[4 + e] * __builtin_amdgcn_rcpf(gb[4 + e]); } }
            }
            return true;
        }
        u32x4 gb_[2][4];
#pragma unroll
        for (int k = 0; k < 4; ++k) gb_[0][k] = MP_G(k, DM);
        bf16_t* mbase = Mo + (size_t)row0 * DM + col0;
#pragma unroll
        for (int b = 0; b < 4; ++b) {
            if (b + 1 < 4) {
#pragma unroll
                for (int k = 0; k < 4; ++k) gb_[(b + 1) & 1][k] = MP_G(4 * (b + 1) + k, DM); }
#pragma unroll
            for (int k = 0; k < 4; ++k) { const int i = 4 * b + k, ai = i >> 3, m = (i >> 1) & 3, bj = i & 1;
                MP_UNPK(gb_[b & 1][k], gb); const f32x4 v0 = acc[ai][bj][m][0], v1 = acc[ai][bj][m][1];
                u32x4 w; w.x = cvt_pk_bf16(v0[0] * gb[0], v0[1] * gb[1]); w.y = cvt_pk_bf16(v0[2] * gb[2], v0[3] * gb[3]); w.z = cvt_pk_bf16(v1[0] * gb[4], v1[1] * gb[5]); w.w = cvt_pk_bf16(v1[2] * gb[6], v1[3] * gb[7]);
                *(u32x4*)(mbase + MP_ROW(i) * DM + bj * HALF) = w; }
        }
        return false;
#undef MP_ROW
#undef MP_G
#undef MP_UNPK
    }
};
struct EpiInProjDual {
    static constexpr bool PERM = true, CARRY = false;
    EpiInProj e1; EpiBf16Plain e2;
    __device__ __forceinline__ void operator()(const f32x4 (&acc)[2][2][4][2], const Unit& u, int wr, int wc, int fr, int fq) const { if (u.kind == 0) e1(acc, u, wr, wc, fr, fq); else e2(acc, u, wr, wc, fr, fq); }
};
struct EpiOut {
    static constexpr bool PERM = false, CARRY = false;
    float* X; const float* mod_l;
    __device__ __forceinline__ void operator()(const f32x4 (&acc)[2][2][4][2], const Unit& u, int wr, int wc, int fr, int fq) const {
        const int row0 = u.pm * 256 + wr * 64 + fr, col0 = u.pn * 256 + wc * 32 + 4 * fq;
        const int v = u.pm < 64 ? (u.pm >> 4) : 4; const float* g1 = mod_l + (size_t)v * 12288 + 2 * DM;
        f32x4 gv[2][2];
#pragma unroll
        for (int bj = 0; bj < 2; ++bj)
#pragma unroll
            for (int n = 0; n < 2; ++n) gv[bj][n] = *(const f32x4*)(g1 + col0 + bj * HALF + n * 16);
        float* base = X + (size_t)row0 * DM + col0;
        f32x4 xa[8], xb[8];
#define EO_P(b, c, bj, n) ((f32x4*)(base + (size_t)((((2 * (b) + (c)) >> 2) * HALF) + ((2 * (b) + (c)) & 3) * 16) * DM + (bj) * HALF + (n) * 16))
#define EO_LOAD(b, dst) do { _Pragma("unroll") for (int c = 0; c < 2; ++c) _Pragma("unroll") for (int bj = 0; bj < 2; ++bj) _Pragma("unroll") for (int n = 0; n < 2; ++n) dst[c * 4 + bj * 2 + n] = *EO_P(b, c, bj, n); } while (0)
#define EO_STORE(b, src) do { _Pragma("unroll") for (int c = 0; c < 2; ++c) _Pragma("unroll") for (int bj = 0; bj < 2; ++bj) _Pragma("unroll") for (int n = 0; n < 2; ++n) \
        *EO_P(b, c, bj, n) = src[c * 4 + bj * 2 + n] + gv[bj][n] * acc[(2 * (b) + c) >> 2][bj][(2 * (b) + c) & 3][n]; } while (0)
        EO_LOAD(0, xa);
        EO_LOAD(1, xb); EO_STORE(0, xa);
        EO_LOAD(2, xa); EO_STORE(1, xb);
        EO_LOAD(3, xb); EO_STORE(2, xa);
        EO_STORE(3, xb);
#undef EO_P
#undef EO_LOAD
#undef EO_STORE
    }
};
struct EpiDownSlab {
    static constexpr bool PERM = false, CARRY = false;
    float* YSC;
    __device__ __forceinline__ void operator()(const f32x4 (&acc)[2][2][4][2], const Unit& u, int wr, int wc, int fr, int fq) const {
        const int row0 = (u.pm - 64) * 256 + wr * 64 + fr, col0 = u.pn * 256 + wc * 32 + 4 * fq; float* base = YSC + (size_t)u.kind * MC * DM;
#pragma unroll
        for (int ai = 0; ai < 2; ++ai)
#pragma unroll
            for (int m = 0; m < 4; ++m)
#pragma unroll
                for (int bj = 0; bj < 2; ++bj)
#pragma unroll
                    for (int n = 0; n < 2; ++n) *(f32x4*)(base + (size_t)(row0 + ai * HALF + m * 16) * DM + col0 + bj * HALF + n * 16) = acc[ai][bj][m][n];
    }
};
struct EpiUp {
    static constexpr bool PERM = true, CARRY = false;
    bf16_t* act;
    __device__ __forceinline__ void operator()(const f32x4 (&acc)[2][2][4][2], const Unit& u, int wr, int wc, int fr, int fq) const {
        const int row0 = u.pm * 256 + wr * 64 + fr, col0 = u.pn * 128 + wc * 32 + 8 * fq;
#pragma unroll
        for (int ai = 0; ai < 2; ++ai)
#pragma unroll
            for (int m = 0; m < 4; ++m) { bf16_t* rowp = act + (size_t)(row0 + ai * HALF + m * 16) * DFF + col0;
                f32x4 r[2];
#pragma unroll
                for (int n = 0; n < 2; ++n)
#pragma unroll
                    for (int i = 0; i < 4; ++i) { const float a = acc[ai][0][m][n][i], b = acc[ai][1][m][n][i]; r[n][i] = a * b * __builtin_amdgcn_rcpf(1.f + __expf(-a)); }
                u32x4 w; w.x = cvt_pk_bf16(r[0][0], r[0][1]); w.y = cvt_pk_bf16(r[0][2], r[0][3]); w.z = cvt_pk_bf16(r[1][0], r[1][1]); w.w = cvt_pk_bf16(r[1][2], r[1][3]);
                __builtin_nontemporal_store(w, (u32x4*)rowp); }
    }
};

__device__ __forceinline__ void phase_merge_ctx_combine(const Frame& F0) {
    Frame F = enter(F0);
    const float* SL = (const float*)(F.ws + AR_MSLAB); const bf16_t* gates = (const bf16_t*)(F.ws + AR_GATE); bf16_t* Mo = (bf16_t*)(F.ws + AR_M);
    for (int g = F.bid * NTHR + F.tid; g < MC * (DM / 4); g += F.G * NTHR) {
        const int r = g >> 9, col = (g & 511) * 4; const size_t o = (size_t)r * DM + col;
        f32x4 a = *(const f32x4*)(SL + o), b = *(const f32x4*)(SL + (size_t)4 * MC * DM + o);
#pragma unroll
        for (int k = 1; k < 4; ++k) { a = a + *(const f32x4*)(SL + (size_t)k * MC * DM + o); b = b + *(const f32x4*)(SL + (size_t)(4 + k) * MC * DM + o); }
        const u32x2 gaw = *(const u32x2*)(gates + (size_t)(ML + r) * 4096 + col), gbw = *(const u32x2*)(gates + (size_t)(ML + r) * 4096 + DM + col);
        const f32x4 ga = (f32x4){bf_lo(gaw.x), bf_hi(gaw.x), bf_lo(gaw.y), bf_hi(gaw.y)}, gb = (f32x4){bf_lo(gbw.x), bf_hi(gbw.x), bf_lo(gbw.y), bf_hi(gbw.y)};
        const f32x4 m = ga * a + gb * b;
        u32x2 w; w.x = cvt_pk_bf16(m.x, m.y); w.y = cvt_pk_bf16(m.z, m.w);
        *(u32x2*)(Mo + (size_t)(ML + r) * DM + col) = w;
    }
}
__device__ __forceinline__ void moe_tables(const Frame& F0, int l) {
    Frame F = enter(F0);
    LAS int* tab = (LAS int*)(F.lds + LDS_TAB);
    if (F.tid == 0) { const unsigned* cnt = (const unsigned*)(F.ws + WS_CTL) + CW_CNT + (l >> 1) * 8 * 64; int p = 0;
        for (int e = 0; e < 8; ++e) { const int t = ((int)__hip_atomic_load(cnt + e * 64, __ATOMIC_RELAXED, __HIP_MEMORY_SCOPE_AGENT) + 255) >> 8; tab[e] = t; tab[8 + e] = p; p += t; }
        tab[16] = p; }
    __syncthreads();
}

constexpr int PH_PER_LAYER = 9, N_PHASES = 2 + DEPTH * PH_PER_LAYER + 1;

__global__ void __launch_bounds__(NTHR, 2) mega(Args args) {
    extern __shared__ __attribute__((aligned(16))) unsigned char lds_raw[];
    Frame F0;
    F0.lds = (LAS unsigned char*)lds_raw; F0.ldsg = (char*)lds_raw;
    F0.in = args.in; F0.out = args.out; F0.ws = args.ws;
    F0.tid = threadIdx.x; F0.lane = F0.tid & 63; F0.wave = __builtin_amdgcn_readfirstlane(F0.tid >> 6);
    F0.G = gridDim.x; F0.bid = blockIdx.x; F0.gw = F0.bid * NWAVES + F0.wave; F0.NGW = F0.G * NWAVES;
    volatile LAS unsigned* MISC = (volatile LAS unsigned*)(F0.lds + LDS_TAB + 1024);
    if (F0.tid < 8) MISC[F0.tid] = 0u;
    __syncthreads();
#if MK_ONE_LAUNCH
    XcdBarrier bar = xcd_barrier_post((unsigned*)(F0.ws + WS_CTL) + CW_BAR, MISC, F0.wave);
#define GRID_BAR() xcd_barrier(bar)
#else
#define GRID_BAR() do {} while (0)
#endif
    const int lo = args.ph_lo, hi = args.ph_hi;
#ifndef AUDIT
#define AUDIT -1
#endif
#define INA(a, k) ((AUDIT < 0 || AUDIT == (a)) && lo <= (k) && (k) < hi)
#define IN(k) (lo <= (k) && (k) < hi)
#define INL(j) INA(2 + (j), pb + (j))
#define SEAM(k) do { if (IN((k) + 1)) { GRID_BAR(); if (PROBE == 15) GRID_BAR(); } } while (0)
    if (INA(0, 0)) { phase_prologue0(F0); SEAM(0); }
    if (INA(1, 1)) { phase_prologue1(F0); if (PROBE == 8) { GRID_BAR(); phase_prologue1(F0); } SEAM(1); }
    for (int l = 0; l < DEPTH; ++l) {
        const int pb = 2 + l * PH_PER_LAYER; const bool last = (l == DEPTH - 1);
        if (INL(0)) { phase_normmod1(F0, l, PROBE == 14 ? 2 : 1); SEAM(pb + 0); }
        if (INL(1)) { Frame F = enter(F0);
            const bf16_t* W = (const bf16_t*)(F.ws + WS_WIN) + (size_t)l * NIN * DM;
            { LAS f32x4* rl = (LAS f32x4*)(F.lds + LDS_ROPE); const f32x4* rg = (const f32x4*)(F.ws + WS_ROPE); for (int i = F.tid; i < 1024; i += NTHR) rl[i] = rg[i]; __syncthreads(); }
            pg8::DualOrder S; S.S1.init(F.ws + AR_H, W, MT, NQKVG, DM, F.G, F.bid, 1, WGM_INP); S.S2.init(W + (size_t)NQKVG * DM, F.ws + AR_H, HYW, MT, DM, F.G, F.bid, 1, WGM_INP);
            EpiInProjDual E{EpiInProj{(bf16_t*)(F.ws + AR_Q), (bf16_t*)(F.ws + AR_KC), (bf16_t*)(F.ws + AR_VC), (bf16_t*)(F.ws + AR_GATE), F.in[I_BGATE] + (size_t)l * 4096,
                          F.in[I_QNORM] + l * 128, F.in[I_KNORM] + l * 128, (const LAS float*)(F.lds + LDS_ROPE), F.lds + LDS_EPI}, EpiBf16Plain{(bf16_t*)(F.ws + AR_UT), MT}};
            pg8::gemm_phase(F.lds, F.wave, DM, S, E);
            SEAM(pb + 1);
        }
        if (INL(2)) { phase_mixers(F0, l); SEAM(pb + 2); }
        if (INL(3)) { phase_combine_transpose(F0, l); if (PROBE == 7) { GRID_BAR(); phase_combine_transpose(F0, l); } SEAM(pb + 3); }
        if (INL(4)) { Frame F = enter(F0);
            const bf16_t* Wa = (const bf16_t*)(F.ws + WS_WBRA) + (size_t)l * DM * DM; const bf16_t* Wb = (const bf16_t*)(F.ws + WS_WBRB) + (size_t)l * DM * DM;
            pg8::PairOrder S; S.S0.init(F.ws + AR_YAN, Wa, ML, DM, DM, F.G, F.bid);
            S.A1 = (const char*)(F.ws + AR_YB); S.Bt1 = (const char*)Wb;
            EpiMergePair E{(const bf16_t*)(F.ws + AR_GATE), (bf16_t*)(F.ws + AR_M)};
            pg8::gemm_phase(F.lds, F.wave, DM, S, E);
            if (!last) { pg8::CtxPairSplitOrder S2; S2.G = F.G; S2.c = F.bid; S2.A0 = (const char*)(F.ws + AR_YAN); S2.A1 = (const char*)(F.ws + AR_YB); S2.B0 = (const char*)Wa; S2.B1 = (const char*)Wb;
                S2.tstep = (size_t)256 * DM * 2; S2.kbytes = 512 * 2;
                EpiDownSlab E2{(float*)(F.ws + AR_MSLAB)};
                pg8::gemm_phase(F.lds, F.wave, 512, S2, E2, DM); }
            SEAM(pb + 4);
        }
        if (INL(5)) { Frame F = enter(F0);
            const int Mr = last ? ML : MT;
            if (!last) { phase_merge_ctx_combine(F0); GRID_BAR(); }
            pg8::StaticOrder S; S.init(F.ws + AR_M, (const bf16_t*)(F.ws + WS_WOUT) + (size_t)l * DM * DM, Mr, DM, DM, F.G, F.bid);
            EpiOut E{(float*)(F.ws + WS_X), (const float*)(F.ws + WS_MOD) + (size_t)l * 5 * 12288};
            pg8::gemm_phase(F.lds, F.wave, DM, S, E);
            phase_tail_transposes(F0, l, 1);
            SEAM(pb + 5);
        }
        if (INL(6)) { phase_normmod2(F0, l); SEAM(pb + 6); }
        const int wslot = (l & 1) ? 2 + (l >> 1) * 8 : (l >> 1);
        if (INL(7)) { Frame F = enter(F0);
            const bf16_t* Wup = (const bf16_t*)(F.ws + WS_WUP) + (size_t)wslot * 2 * DFF * DM;
            EpiUp E{(bf16_t*)(F.ws + AR_ACT)};
            if (l & 1) { moe_tables(F, l);
                pg8::MoeOrder S; S.tab = (const LAS int*)(F.lds + LDS_TAB); S.nN = 44; S.G = F.G; S.c = F.bid; S.rep = (PROBE == 10) ? 2 : 1; S.wgm = WGM_MOE; S.A = (const char*)(F.ws + AR_H2S); S.W = (const char*)Wup;
                S.a_estride = (size_t)CAP * DM * 2; S.a_tstep = (size_t)256 * DM * 2; S.w_estride = (size_t)2 * DFF * DM * 2; S.w_tstep = (size_t)256 * DM * 2; S.a_by_slot = false;
                pg8::gemm_phase(F.lds, F.wave, DM, S, E);
            } else { pg8::StaticOrder S; S.init(F.ws + AR_H, Wup, last ? ML : MT, 2 * DFF, DM, F.G, F.bid, PROBE == 5 ? 2 : 1); pg8::gemm_phase(F.lds, F.wave, DM, S, E); }
            SEAM(pb + 7);
        }
        if (INL(8)) { Frame F = enter(F0);
            const bf16_t* Wdn = (const bf16_t*)(F.ws + WS_WDN) + (size_t)wslot * DM * DFF;
            EpiBf16Plain E{(bf16_t*)(F.ws + AR_YS), DM};
            if (l & 1) { moe_tables(F, l);
                pg8::MoeOrder S; S.tab = (const LAS int*)(F.lds + LDS_TAB); S.nN = 8; S.G = F.G; S.c = F.bid; S.rep = (PROBE == 11) ? 2 : 1; S.wgm = WGM_MOE; S.A = (const char*)(F.ws + AR_ACT); S.W = (const char*)Wdn;
                S.a_estride = 0; S.a_tstep = (size_t)256 * DFF * 2; S.w_estride = (size_t)DM * DFF * 2; S.w_tstep = (size_t)256 * DFF * 2; S.a_by_slot = true;
                pg8::gemm_phase(F.lds, F.wave, DFF, S, E);
            } else { { pg8::StaticOrder S; S.init(F.ws + AR_ACT, Wdn, ML, DM, DFF, F.G, F.bid, PROBE == 6 ? 2 : 1); pg8::gemm_phase(F.lds, F.wave, DFF, S, E); }
                pg8::SplitKOrder S; S.pm0 = 64; S.nN = 8; S.nT = 32; S.S = 4; S.G = F.G; S.c = F.bid; S.A = (const char*)(F.ws + AR_ACT); S.Bt = (const char*)Wdn; S.tstep = (size_t)256 * DFF * 2; S.kbytes = 1408 * 2;
                EpiDownSlab E2{(float*)(F.ws + AR_YSC)};
                pg8::gemm_phase(F.lds, F.wave, 1408, S, E2, DFF); }
            SEAM(pb + 8);
        }
    }
    if (INA(11, N_PHASES - 1)) phase_final(F0);
#undef IN
#undef INA
#undef INL
#undef SEAM
}

extern "C" void kernel_launch(void* const* d_in, const int* in_sizes, int n_in, void* d_out, int out_size, void* d_ws, size_t ws_size, hipStream_t stream) {
    static int grid = 0;
    if (grid == 0) {
        if (n_in != 38 || out_size != ML * DM || ws_size < WS_END) { fprintf(stderr, "kernel_launch: unexpected shapes: n_in %d out %d ws %zu (need %zu)\n", n_in, out_size, ws_size, (size_t)WS_END); grid = -1; return; }
        int dev = 0, cus = 0, per_cu = 0;
        if (hipGetDevice(&dev) != hipSuccess || hipDeviceGetAttribute(&cus, hipDeviceAttributeMultiprocessorCount, dev) != hipSuccess) { grid = -1; return; }
        if (hipFuncSetAttribute((const void*)mega, hipFuncAttributeMaxDynamicSharedMemorySize, LDS_BYTES) != hipSuccess) { fprintf(stderr, "kernel_launch: hipFuncSetAttribute failed\n"); grid = -1; return; }
        if (hipOccupancyMaxActiveBlocksPerMultiprocessor(&per_cu, (const void*)mega, NTHR, LDS_BYTES) != hipSuccess || per_cu < 1) fprintf(stderr, "kernel_launch: occupancy query reports %d\n", per_cu);
        (void)hipGetLastError();
        grid = cus;
    }
    if (grid < 0) return;
    static_assert((CW_CNT + 2 * 8 * 64) * 4 <= 128 * 1024 && (CW_BAR + XCD_BAR_WORDS) * 4 <= 128 * 1024, "control words inside the zeroed region");
    if (hipMemsetAsync((char*)d_ws + WS_CTL, 0, 128 * 1024, stream) != hipSuccess) return;
    Args a{};
    for (int i = 0; i < 38; ++i) a.in[i] = (const float*)d_in[i];
    a.out = (float*)d_out; a.ws = (unsigned char*)d_ws;
#if MK_ONE_LAUNCH
    a.ph_lo = 0; a.ph_hi = N_PHASES;
    hipLaunchKernelGGL(mega, dim3(grid), dim3(NTHR), LDS_BYTES, stream, a);
#else
    for (int p = 0; p < N_PHASES; ++p) { a.ph_lo = p; a.ph_hi = p + 1; hipLaunchKernelGGL(mega, dim3(grid), dim3(NTHR), LDS_BYTES, stream, a); }
#endif
}
```

```cpp
#include <hip/hip_runtime.h>
#include <cstdio>
#include <cstdint>

#ifndef PROBE
#define PROBE 0
#endif
#ifndef MK_ONE_LAUNCH
#define MK_ONE_LAUNCH 1
#endif

#define LAS __attribute__((address_space(3)))
typedef unsigned short bf16_t;
typedef short bf16x8 __attribute__((ext_vector_type(8)));
typedef short s16x4 __attribute__((ext_vector_type(4)));
typedef float f32x2 __attribute__((ext_vector_type(2)));
typedef float f32x4 __attribute__((ext_vector_type(4)));
typedef float f32x16 __attribute__((ext_vector_type(16)));
typedef unsigned u32x2 __attribute__((ext_vector_type(2)));
typedef unsigned u32x4 __attribute__((ext_vector_type(4)));

constexpr int DM = 2048, NB = 4, SEQ = 4096, LC = 256, ML = NB * SEQ, MC = NB * LC, MT = ML + MC;
constexpr int DEPTH = 4, NIN = 16384, DFF = 5632, NEXP = 8, CAP = MT, SKV = SEQ + LC;
constexpr int NQKVG = 10240;
constexpr int HYW = 6144;
constexpr int MAXSLOT = 36864;
constexpr float EPS = 1e-6f;
constexpr int NWAVES = 8, NTHR = 512;

constexpr size_t MiB = 1u << 20;
constexpr size_t WS_CTL = 0;
constexpr size_t WS_MOD = 1 * MiB;
constexpr size_t WS_LAM = 2 * MiB;
constexpr size_t WS_ROPE = 2 * MiB + 4096;
constexpr size_t WS_HID = 3 * MiB;
constexpr size_t WS_HIDC = WS_HID + 4 * MiB;
constexpr size_t WS_TOK = 8 * MiB;
constexpr size_t WS_RC = 9 * MiB;
constexpr size_t WS_R = 41 * MiB;
constexpr size_t WS_X = 313 * MiB;
constexpr size_t WS_WIN = 449 * MiB;
constexpr size_t WS_WBRA = WS_WIN + 256 * MiB;
constexpr size_t WS_WBRB = WS_WBRA + 32 * MiB;
constexpr size_t WS_WOUT = WS_WBRB + 32 * MiB;
constexpr size_t WS_WUP = WS_WOUT + 32 * MiB;
constexpr size_t WS_WDN = WS_WUP + 18 * 44 * MiB;
constexpr size_t WS_AR = WS_WDN + 18 * 22 * MiB;
constexpr size_t AR_H = WS_AR, AR_Q = WS_AR + 68 * MiB, AR_KRAW = WS_AR + 136 * MiB, AR_KC = WS_AR + 204 * MiB, AR_VC = WS_AR + 272 * MiB;
constexpr size_t AR_UT = WS_AR + 340 * MiB, AR_UT2 = WS_AR + 544 * MiB, AR_GATE = WS_AR + 748 * MiB, AR_O = WS_AR + 884 * MiB, AR_YBT = WS_AR + 1156 * MiB;
constexpr size_t AR_YAN = AR_KRAW, AR_YB = AR_KC, AR_M = AR_VC;
constexpr size_t AR_ACT = WS_AR + 68 * MiB, AR_YS = WS_AR + 464 * MiB, AR_H2S = WS_AR + 680 * MiB;
constexpr size_t AR_YSC = WS_AR + 1224 * MiB;
constexpr size_t WS_END = WS_AR + 1256 * MiB;
static_assert(WS_AR == 1989 * MiB, "map");
constexpr int CW_BAR = 4096;
constexpr int CW_CNT = 16384;

constexpr int LDS_EPI = 131072;
constexpr int LDS_TAB = 143360;
constexpr int LDS_ROPE = 147456;
constexpr int LDS_BYTES = 163840;

__device__ __forceinline__ unsigned cvt_pk_bf16(float lo, float hi) { unsigned r; asm volatile("v_cvt_pk_bf16_f32 %0, %1, %2" : "=v"(r) : "v"(lo), "v"(hi)); return r; }
__device__ __forceinline__ float bf_lo(unsigned w) { return __uint_as_float(w << 16); }
__device__ __forceinline__ float bf_hi(unsigned w) { return __uint_as_float(w & 0xffff0000u); }
__device__ __forceinline__ float bf2f(bf16_t b) { return __uint_as_float(((unsigned)b) << 16); }
__device__ __forceinline__ float shx(float v, int k, int lane) { return __int_as_float(__builtin_amdgcn_ds_bpermute((lane ^ k) << 2, __float_as_int(v))); }
__device__ __forceinline__ float wave_sum(float v, int lane) {
#pragma unroll
    for (int o = 1; o < 64; o <<= 1) v += shx(v, o, lane);
    return v;
}
__device__ __forceinline__ int opaque(int v) { asm volatile("" : "+v"(v)); return v; }
__device__ __forceinline__ int lane_id() { int r; asm volatile("v_mbcnt_lo_u32_b32 %0, -1, 0\n\tv_mbcnt_hi_u32_b32 %0, -1, %0" : "=v"(r)); return r; }
__device__ __forceinline__ int hw_tid(int wave) { return opaque(wave * 64 + lane_id()); }
#define LDS_WAIT() asm volatile("s_waitcnt lgkmcnt(0)" ::: "memory")
#define VM_WAIT() asm volatile("s_waitcnt vmcnt(0)" ::: "memory")

#define XB_TMO      128
#define XB_XCNT(j)  (256  + 64 * (j))
#define XB_XSUB(j)  (1280 + 64 * (j))
#define XB_XGEN(j)  (2304 + 64 * (j))
#define XB_TOP      3328
#define XB_TOPGEN   3392
#define XCD_BAR_WORDS 3456
#define XB_SPIN_CAP (1u << 18)
__device__ __forceinline__ unsigned xb_ld(unsigned* p)              { return __hip_atomic_load(p, __ATOMIC_RELAXED, __HIP_MEMORY_SCOPE_AGENT); }
__device__ __forceinline__ unsigned xb_add(unsigned* p, unsigned v) { return __hip_atomic_fetch_add(p, v, __ATOMIC_RELAXED, __HIP_MEMORY_SCOPE_AGENT); }
__device__ __forceinline__ unsigned xb_xcc_id() { return (unsigned)__builtin_amdgcn_s_getreg((3 << 11) | 20) & 0xFu; }
#define XB_SPIN(cond, bar) do { unsigned _sp = 0; while (cond) { __builtin_amdgcn_s_sleep(1); \
    if ((++_sp & 255u) == 0u) { if (xb_ld(&(bar)[XB_TMO])) break; if (_sp > XB_SPIN_CAP) { atomicAdd(&(bar)[XB_TMO], 1u); break; } } } } while (0)
struct XcdBarrier { unsigned* bar; unsigned x; volatile LAS unsigned* st; int wave; };
__device__ __forceinline__ XcdBarrier xcd_barrier_post(unsigned* bar, volatile LAS unsigned* st, int wave) {
    XcdBarrier b; b.bar = bar; b.x = xb_xcc_id(); b.st = st; b.wave = wave;
    if (threadIdx.x == 0) (void)xb_add(&bar[XB_XCNT(b.x)], 1u);
    return b;
}
__device__ __forceinline__ void xcd_barrier_complete(unsigned* bar, unsigned x, unsigned& nloc, unsigned& nx) {
    const unsigned G = gridDim.x * gridDim.y * gridDim.z;
    unsigned sum, cnt, mine, sp = 0u;
    for (;;) {
        sum = 0u; cnt = 0u; mine = 0u;
#pragma unroll
        for (unsigned j = 0; j < 16; ++j) { const unsigned c = xb_ld(&bar[XB_XCNT(j)]); sum += c; cnt += (c > 0u) ? 1u : 0u; mine = (j == x) ? c : mine; }
        if (sum == G) break;
        __builtin_amdgcn_s_sleep(1);
        if ((++sp & 255u) == 0u) { if (xb_ld(&bar[XB_TMO])) break; if (sp > XB_SPIN_CAP) { atomicAdd(&bar[XB_TMO], 1u); break; } }
    }
    nloc = mine > 0u ? mine : 1u; nx = cnt > 0u ? cnt : 1u;
}
__device__ __forceinline__ void xcd_barrier(const XcdBarrier& b) {
    asm volatile("s_waitcnt vmcnt(0)" ::: "memory");
    __syncthreads();
    if (b.wave == 0 && lane_id() == 0) {
        unsigned* bar = b.bar;
        __builtin_amdgcn_s_waitcnt(0);
        unsigned nloc = b.st[0], nx = b.st[1];
        if (nloc == 0u) { xcd_barrier_complete(bar, b.x, nloc, nx); b.st[0] = nloc; b.st[1] = nx; }
        const unsigned old = xb_add(&bar[XB_XSUB(b.x)], 1u);
        const unsigned gen = old / nloc;
        if (old + 1u == (gen + 1u) * nloc) {
            __builtin_amdgcn_fence(__ATOMIC_RELEASE, "agent");
            asm volatile("s_waitcnt vmcnt(0)" ::: "memory");
            const unsigned og = xb_add(&bar[XB_TOP], 1u);
            const unsigned tg = og / nx;
            if (og + 1u == (tg + 1u) * nx) xb_add(&bar[XB_TOPGEN], 1u);
            else XB_SPIN(xb_ld(&bar[XB_TOPGEN]) == tg, bar);
            __builtin_amdgcn_fence(__ATOMIC_ACQUIRE, "agent");
            xb_add(&bar[XB_XGEN(b.x)], 1u);
            asm volatile("s_waitcnt vmcnt(0)" ::: "memory");
        } else {
            XB_SPIN(xb_ld(&bar[XB_XGEN(b.x)]) == gen, bar);
            __builtin_amdgcn_fence(__ATOMIC_ACQUIRE, "agent");
            asm volatile("s_waitcnt vmcnt(0)" ::: "memory");
        }
    }
    __syncthreads();
}

namespace pg8 {
constexpr int BM = 256, BK = 64, HALF = 128, HTB = HALF * BK * 2, STAGE_BYTES = 8 * HTB;
__host__ __device__ __forceinline__ int lds_byte(int r, int c) { const int st = (r >> 4) * 2 + (c >> 5), rr = r & 15, cc = c & 31, ob = rr * 64 + cc * 2; return st * 1024 + (ob ^ (((ob >> 9) & 1) << 5)); }
__host__ __device__ __forceinline__ void stage_rc(int b, int& R, int& C) { const int st = b / 1024, sb = b % 1024, swz = sb ^ (((sb >> 9) & 1) << 5); R = (st >> 1) * 16 + swz / 64; C = (st & 1) * 32 + (swz % 64) / 2; }
__host__ __device__ __forceinline__ int perm32(int rho) { const int n = rho >> 4, i = rho & 15; return 8 * (i >> 2) + 4 * n + (i & 3); }
struct Unit { int pm, pn; const char* a; const char* b; int kind; };

template <class Epi, class Sched>
__device__ __forceinline__ void gemm_phase(LAS unsigned char* lds, const int wave_, const int K, const Sched& S, const Epi& E, const int ld_ = 0) {
    const int tid = hw_tid(wave_), wid = __builtin_amdgcn_readfirstlane(tid >> 6), lane = tid & 63, wr = wid >> 2, wc = wid & 3, fr = lane & 15, fq = lane >> 4;
    const int nt = K / BK, ld = ld_ ? ld_ : K;
    unsigned voffA[2], voffB[2];
#pragma unroll
    for (int i = 0; i < 2; ++i) { int R, C; stage_rc(tid * 16 + i * 8192, R, C); const int Rb = Epi::PERM ? ((R & ~31) + perm32(R & 31)) : R;
        voffA[i] = (unsigned)(R * ld + C) * 2u; voffB[i] = (unsigned)(Rb * ld + C) * 2u; }
    const size_t kstep = (size_t)(BK * 2);
    const size_t hstep = (size_t)HALF * ld * 2;
    const unsigned ldsw = (unsigned)wid * 1024u;
    const int aoff = lds_byte(wr * 64 + fr, fq * 8), boff = lds_byte(wc * 32 + fr, fq * 8);
#define PG8_SA(b, h) (((b) * 2 + (h)) * HTB)
#define PG8_SB(b, h) ((4 + (b) * 2 + (h)) * HTB)
#define PG8_STAGE(bufoff, gbase, voff) do { _Pragma("unroll") for (int _i = 0; _i < 2; ++_i) \
        __builtin_amdgcn_global_load_lds((const unsigned*)((const char*)(gbase) + (voff)[_i]), (LAS unsigned*)(lds + (bufoff) + ldsw + _i * 8192), 16, 0, 0); } while (0)
#define PG8_LDA(dst, b, h) do { _Pragma("unroll") for (int m = 0; m < 4; ++m) _Pragma("unroll") for (int k = 0; k < 2; ++k) dst[m][k] = *(const LAS bf16x8*)(lds + PG8_SA(b, h) + aoff + m * 2048 + k * 1024); } while (0)
#define PG8_LDB(dst, b, h) do { _Pragma("unroll") for (int n = 0; n < 2; ++n) _Pragma("unroll") for (int k = 0; k < 2; ++k) dst[n][k] = *(const LAS bf16x8*)(lds + PG8_SB(b, h) + boff + n * 2048 + k * 1024); } while (0)
#define PG8_MMA(ai, bj, At, Bt) do { __builtin_amdgcn_s_setprio(1); _Pragma("unroll") for (int m = 0; m < 4; ++m) _Pragma("unroll") for (int n = 0; n < 2; ++n) _Pragma("unroll") for (int k = 0; k < 2; ++k) \
        acc[ai][bj][m][n] = __builtin_amdgcn_mfma_f32_16x16x32_bf16(Bt[n][k], At[m][k], acc[ai][bj][m][n], 0, 0, 0); __builtin_amdgcn_s_setprio(0); } while (0)
#define PG8_WAIT_V(n) asm volatile("s_waitcnt vmcnt(" #n ")" ::: "memory")
#define PG8_WAIT_L(n) asm volatile("s_waitcnt lgkmcnt(" #n ")" ::: "memory")
#define PG8_BAR __builtin_amdgcn_s_barrier()
#define PG8_SCHED __builtin_amdgcn_sched_barrier(0)
    Unit cur, nxt; int ui = 0;
    if (!S.next(0, cur)) return;
    f32x4 acc[2][2][4][2];
#pragma unroll
    for (int a = 0; a < 2; ++a)
#pragma unroll
        for (int b = 0; b < 2; ++b)
#pragma unroll
            for (int m = 0; m < 4; ++m)
#pragma unroll
                for (int n = 0; n < 2; ++n) acc[a][b][m][n] = (f32x4){0.f, 0.f, 0.f, 0.f};
    bf16x8 At[4][2], B0[2][2], B1[2][2];
    const char* cA = cur.a; const char* cB = cur.b;
    PG8_STAGE(PG8_SB(0, 0), cB, voffB); PG8_STAGE(PG8_SA(0, 0), cA, voffA); PG8_STAGE(PG8_SB(0, 1), cB + hstep, voffB); PG8_STAGE(PG8_SA(0, 1), cA + hstep, voffA);
    if (wr == 1) PG8_BAR;
    PG8_WAIT_V(4); PG8_BAR;
    PG8_STAGE(PG8_SB(1, 0), cB + kstep, voffB); PG8_STAGE(PG8_SA(1, 0), cA + kstep, voffA); PG8_STAGE(PG8_SB(1, 1), cB + hstep + kstep, voffB);
    PG8_WAIT_V(6); PG8_BAR;
    for (;;) {
        const bool has_next = S.next(ui + 1, nxt);
        const char* nA = has_next ? nxt.a : cA; const char* nB = has_next ? nxt.b : cB;
        for (int t = 0; t < nt; t += 2) {
            const bool last = (t == nt - 2);
            const char* a1 = cA + (size_t)(t + 1) * kstep;
            const char* a2 = last ? nA : cA + (size_t)(t + 2) * kstep; const char* b2 = last ? nB : cB + (size_t)(t + 2) * kstep;
            const char* a3 = a2 + kstep; const char* b3 = b2 + kstep;
            PG8_LDB(B0, 0, 0); PG8_SCHED; PG8_LDA(At, 0, 0); PG8_STAGE(PG8_SA(1, 1), a1 + hstep, voffA);
            PG8_WAIT_L(8); PG8_BAR; PG8_WAIT_L(0); PG8_MMA(0, 0, At, B0); PG8_BAR; PG8_SCHED;
            PG8_LDB(B1, 0, 1); PG8_STAGE(PG8_SB(0, 0), b2, voffB);
            PG8_BAR; PG8_WAIT_L(0); PG8_MMA(0, 1, At, B1); PG8_BAR;
            PG8_LDA(At, 0, 1); PG8_STAGE(PG8_SA(0, 0), a2, voffA);
            PG8_BAR; PG8_WAIT_L(0); PG8_MMA(1, 0, At, B0); PG8_BAR; PG8_SCHED;
            PG8_STAGE(PG8_SB(0, 1), b2 + hstep, voffB);
            PG8_WAIT_V(6); PG8_BAR; PG8_MMA(1, 1, At, B1); PG8_BAR;
            PG8_LDB(B0, 1, 0); PG8_SCHED; PG8_LDA(At, 1, 0); PG8_STAGE(PG8_SA(0, 1), a2 + hstep, voffA);
            PG8_WAIT_L(8); PG8_BAR; PG8_WAIT_L(0); PG8_MMA(0, 0, At, B0); PG8_BAR; PG8_SCHED;
            PG8_LDB(B1, 1, 1); PG8_STAGE(PG8_SB(1, 0), b3, voffB);
            PG8_BAR; PG8_WAIT_L(0); PG8_MMA(0, 1, At, B1); PG8_BAR;
            PG8_LDA(At, 1, 1); PG8_STAGE(PG8_SA(1, 0), a3, voffA);
            PG8_BAR; PG8_WAIT_L(0); PG8_MMA(1, 0, At, B0); PG8_BAR; PG8_SCHED;
            PG8_STAGE(PG8_SB(1, 1), b3 + hstep, voffB);
            PG8_WAIT_V(6); PG8_BAR; PG8_MMA(1, 1, At, B1); PG8_BAR;
        }
        bool keep = false;
        if constexpr (Epi::CARRY) keep = E.carry(acc, cur, wr, wc, fr, fq); else E(acc, cur, wr, wc, fr, fq);
        if (!has_next) break;
        if (!keep) {
#pragma unroll
        for (int a = 0; a < 2; ++a)
#pragma unroll
            for (int b = 0; b < 2; ++b)
#pragma unroll
                for (int m = 0; m < 4; ++m)
#pragma unroll
                    for (int n = 0; n < 2; ++n) acc[a][b][m][n] = (f32x4){0.f, 0.f, 0.f, 0.f}; }
        cur = nxt; cA = nA; cB = nB; ++ui;
    }
    PG8_WAIT_V(0);
    if (wr == 0) PG8_BAR;
    PG8_BAR;
#undef PG8_SA
#undef PG8_SB
#undef PG8_STAGE
#undef PG8_LDA
#undef PG8_LDB
#undef PG8_MMA
#undef PG8_WAIT_V
#undef PG8_WAIT_L
#undef PG8_BAR
#undef PG8_SCHED
}

#ifndef WGM_MOE
#define WGM_MOE 4
#endif
#ifndef WGM_INP
#define WGM_INP 4
#endif
constexpr int NXCD = 8, WGM = 4;
struct StaticOrder {
    int nM, nN, nwg, G, c, rep, wgm; const char* A; const char* Bt; size_t tstep;
    __device__ void init(const void* A_, const void* Bt_, int M, int N, int K, int G_, int c_, int rep_ = 1, int wgm_ = WGM) { nM = M / BM; nN = N / BM; nwg = nM * nN; G = G_; c = c_; rep = rep_; wgm = wgm_; A = (const char*)A_; Bt = (const char*)Bt_; tstep = (size_t)BM * K * 2; }
    __device__ bool next(int i, Unit& u) const {
        const long L = (long)i * G + c; if (L >= (long)nwg * rep) return false;
        map((int)(L % nwg), u); u.kind = 0; return true;
    }
    __device__ void map(int wgid, Unit& u) const {
        { const int q = nwg / NXCD, r = nwg % NXCD, xcd = wgid % NXCD, off = wgid / NXCD; wgid = (xcd < r ? xcd * (q + 1) : r * (q + 1) + (xcd - r) * q) + off; }
        const int nig = wgm * nN, gid = wgid / nig, fm = gid * wgm, gsz = (nM - fm) < wgm ? (nM - fm) : wgm;
        u.pm = fm + ((wgid % nig) % gsz); u.pn = (wgid % nig) / gsz; u.a = A + (size_t)u.pm * tstep; u.b = Bt + (size_t)u.pn * tstep;
    }
};
struct DualOrder {
    StaticOrder S1, S2;
    __device__ bool next(int i, Unit& u) const {
        const int L = i * S1.G + S1.c; if (L < S1.nwg) { S1.map(L, u); u.kind = 0; return true; }
        if (L - S1.nwg < S2.nwg) { S2.map(L - S1.nwg, u); u.kind = 1; return true; }
        return false;
    }
};
struct PairOrder {
    StaticOrder S0; const char* A1; const char* Bt1;
    __device__ bool next(int i, Unit& u) const {
        const int w = (i >> 1) * S0.G + S0.c; if (w >= S0.nwg) return false;
        S0.map(w, u); u.kind = i & 1;
        if (i & 1) { u.a = A1 + (size_t)u.pm * S0.tstep; u.b = Bt1 + (size_t)u.pn * S0.tstep; }
        return true;
    }
};
struct SplitKOrder {
    int pm0, nN, nT, S, G, c; const char* A; const char* Bt; size_t tstep, kbytes;
    __device__ bool next(int i, Unit& u) const {
        const int L = i * G + c; if (L >= nT * S) return false;
        const int un = L / S, ks = L - un * S; u.pm = pm0 + un / nN; u.pn = un % nN; u.kind = ks;
        u.a = A + (size_t)u.pm * tstep + (size_t)ks * kbytes; u.b = Bt + (size_t)u.pn * tstep + (size_t)ks * kbytes; return true;
    }
};
struct MoeOrder {
    const LAS int* tab; int nN, G, c, rep, wgm; const char* A; const char* W; size_t a_estride, a_tstep, w_estride, w_tstep; bool a_by_slot;
    __device__ bool next(int i, Unit& u) const {
        int L = i * G + c; const int total = tab[16] * nN; if (L >= total * rep) return false; if (L >= total) L -= total;
        int e = 0;
#pragma unroll
        for (int k = 1; k < 8; ++k) e += (L >= tab[8 + k] * nN) ? 1 : 0;
        const int te = tab[e], ts = tab[8 + e]; const int ne = te * nN; int idx = L - ts * nN;
        { const int q = ne / NXCD, r = ne % NXCD, xcd = idx % NXCD, off = idx / NXCD; idx = (xcd < r ? xcd * (q + 1) : r * (q + 1) + (xcd - r) * q) + off; }
        const int nig = wgm * nN, gid = idx / nig, fm = gid * wgm, gsz = (te - fm) < wgm ? (te - fm) : wgm;
        const int r = fm + ((idx % nig) % gsz), pn = (idx % nig) / gsz;
        const int ee = __builtin_amdgcn_readfirstlane(e), pnn = __builtin_amdgcn_readfirstlane(pn), rr = __builtin_amdgcn_readfirstlane(r), tss = __builtin_amdgcn_readfirstlane(ts);
        u.pm = tss + rr; u.pn = pnn; u.kind = 0;
        u.a = a_by_slot ? A + (size_t)u.pm * a_tstep : A + (size_t)ee * a_estride + (size_t)rr * a_tstep;
        u.b = W + (size_t)ee * w_estride + (size_t)pnn * w_tstep; return true;
    }
};
}

namespace att {
constexpr int D = 128, DV = 256, NW = 8, QBLK = 32, KVBLK = 32;
constexpr float SCALE = 0.088388347648318440f;
constexpr float THR = 8.f;
#ifndef ATT_SDEPTH
#define ATT_SDEPTH 1
#endif
constexpr int SDEPTH = ATT_SDEPTH;
constexpr int LDQ = DM, LDK = DM, LDO = 4096;
constexpr size_t SHM_V = KVBLK * DV * 2, SHM_K = KVBLK * D * 2, SHM_Q0 = 2 * SHM_V + 2 * SHM_K + NW * 64 * 4, SHM_ATTN = SHM_Q0 + NW * 8192;
#define KSWZ(row, colB) ((row) * 256 + ((colB) ^ (((row) & 7) << 4)))
#define SBAR() __builtin_amdgcn_sched_barrier(0)
__device__ __forceinline__ int crow(int r, int hi) { return (r & 3) + 8 * (r >> 2) + 4 * hi; }
__device__ __forceinline__ unsigned cvtpk(float lo, float hi) { unsigned r; asm volatile("v_cvt_pk_bf16_f32 %0, %1, %2" : "=v"(r) : "v"(lo), "v"(hi)); return r; }
__device__ __forceinline__ void partialSM(f32x16& p0, float& m_reg, float& mn, float& alpha) {
  constexpr float C = SCALE * 1.4426950408889634f;
  float pmax = p0[0]; for (int r = 1; r < 16; ++r) pmax = fmaxf(pmax, p0[r]);
  { auto rr = __builtin_amdgcn_permlane32_swap(__float_as_uint(pmax), __float_as_uint(pmax), false, false);
    pmax = fmaxf(__uint_as_float(rr[0]), __uint_as_float(rr[1])); }
  if (__builtin_expect(__all(pmax - m_reg <= THR / SCALE), 1)) { mn = m_reg; alpha = 1.f; }
  else { mn = fmaxf(m_reg, pmax); alpha = __builtin_amdgcn_exp2f((m_reg - mn) * C); m_reg = mn; }
  float mnC = -mn * C;
  for (int r = 0; r < 16; ++r) p0[r] = fmaf(p0[r], C, mnC);
  for (int r = 0; r < 8; ++r) p0[r] = __builtin_amdgcn_exp2f(p0[r]);
}
__device__ __forceinline__ void finishSM(f32x16& p0, float alpha, float& l_reg, bf16x8& pa0, bf16x8& pa1) {
  for (int r = 8; r < 16; ++r) p0[r] = __builtin_amdgcn_exp2f(p0[r]);
  float ps = 0; for (int r = 0; r < 16; ++r) ps += p0[r];
  { auto rr = __builtin_amdgcn_permlane32_swap(__float_as_uint(ps), __float_as_uint(ps), false, false);
    ps = __uint_as_float(rr[0]) + __uint_as_float(rr[1]); }
  l_reg = l_reg * alpha + ps;
#define PK4(P, BASE, OUT) do { unsigned a0 = cvtpk(P[BASE + 0], P[BASE + 1]), a1 = cvtpk(P[BASE + 2], P[BASE + 3]);   \
    unsigned b0 = cvtpk(P[BASE + 4], P[BASE + 5]), b1 = cvtpk(P[BASE + 6], P[BASE + 7]);                              \
    auto r0 = __builtin_amdgcn_permlane32_swap(a0, b0, false, false); auto r1 = __builtin_amdgcn_permlane32_swap(a1, b1, false, false); \
    u32x4 w = {r0[0], r1[0], r0[1], r1[1]}; OUT = *reinterpret_cast<bf16x8*>(&w); } while (0)
  PK4(p0, 0, pa0); PK4(p0, 8, pa1);
#undef PK4
}
#ifndef ATT_QLDS
#define ATT_QLDS 0
#endif
#if ATT_QLDS
typedef const char* qfrag_t;
#define QV(d0) (*reinterpret_cast<const bf16x8*>(qp + (d0) * 1024))
#else
typedef const bf16x8* qfrag_t;
#define QV(d0) (qp[d0])
#endif
__device__ __forceinline__ void qkt(f32x16& p0, const bf16_t* Ks, qfrag_t qp, int r32, int hi) {
  p0 = f32x16{};
  for (int d0 = 0; d0 < 8; ++d0) { int cb = (d0 * 16 + hi * 8) * 2; const bf16x8 qv = QV(d0);
    bf16x8 b0 = *reinterpret_cast<const bf16x8*>((const char*)Ks + KSWZ(r32, cb));
    p0 = __builtin_amdgcn_mfma_f32_32x32x16_bf16(b0, qv, p0, 0, 0, 0); }
}
__device__ __forceinline__ int v_st(int k, int c) { const int kk = (k & ~0xC) | ((k & 4) << 1) | ((k & 8) >> 1); return ((kk >> 3) * 8 + (c >> 5)) * 512 + ((kk & 7) * 32 + (c & 31)) * 2; }
__device__ __forceinline__ int v_rd_base(int lane) { return ((lane & 3) << 3) | (((lane >> 2) & 3) << 6) | (((lane >> 4) & 1) << 5) | (((lane >> 5) & 1) << 8); }
constexpr int v_rd_off(int d0, int ks, int half) { return d0 * 512 + ks * 8192 + half * 4096; }
template <int OFF> __device__ __forceinline__ s16x4 tr_read(int vb) {
  s16x4 r; asm volatile("ds_read_b64_tr_b16 %0, %1 offset:%2" : "=&v"(r) : "v"(vb), "i"(OFF) : "memory"); return r;
}
template <int D0> __device__ __forceinline__ void pv_two(f32x16& oa, f32x16& ob, int vb, bf16x8 pa0, bf16x8 pa1) {
  const s16x4 l0 = tr_read<v_rd_off(D0, 0, 0)>(vb), h0 = tr_read<v_rd_off(D0, 0, 1)>(vb), l1 = tr_read<v_rd_off(D0, 1, 0)>(vb), h1 = tr_read<v_rd_off(D0, 1, 1)>(vb);
  const s16x4 l2 = tr_read<v_rd_off(D0 + 1, 0, 0)>(vb), h2 = tr_read<v_rd_off(D0 + 1, 0, 1)>(vb), l3 = tr_read<v_rd_off(D0 + 1, 1, 0)>(vb), h3 = tr_read<v_rd_off(D0 + 1, 1, 1)>(vb);
  asm volatile("s_waitcnt lgkmcnt(0)" ::: "memory"); SBAR();
#define PK(L, H) (bf16x8){L[0], L[1], L[2], L[3], H[0], H[1], H[2], H[3]}
  oa = __builtin_amdgcn_mfma_f32_32x32x16_bf16(pa0, PK(l0, h0), oa, 0, 0, 0);
  oa = __builtin_amdgcn_mfma_f32_32x32x16_bf16(pa1, PK(l1, h1), oa, 0, 0, 0);
  ob = __builtin_amdgcn_mfma_f32_32x32x16_bf16(pa0, PK(l2, h2), ob, 0, 0, 0);
  ob = __builtin_amdgcn_mfma_f32_32x32x16_bf16(pa1, PK(l3, h3), ob, 0, 0, 0);
#undef PK
}
#ifndef ATT_PV1
#define ATT_PV1 1
#endif
template <int D0> __device__ __forceinline__ void pv_one(f32x16& oa, int vb, bf16x8 pa0, bf16x8 pa1) {
  const s16x4 l0 = tr_read<v_rd_off(D0, 0, 0)>(vb), h0 = tr_read<v_rd_off(D0, 0, 1)>(vb), l1 = tr_read<v_rd_off(D0, 1, 0)>(vb), h1 = tr_read<v_rd_off(D0, 1, 1)>(vb);
  asm volatile("s_waitcnt lgkmcnt(0)" ::: "memory"); SBAR();
#define PK(L, H) (bf16x8){L[0], L[1], L[2], L[3], H[0], H[1], H[2], H[3]}
  oa = __builtin_amdgcn_mfma_f32_32x32x16_bf16(pa0, PK(l0, h0), oa, 0, 0, 0);
  oa = __builtin_amdgcn_mfma_f32_32x32x16_bf16(pa1, PK(l1, h1), oa, 0, 0, 0);
#undef PK
}
#ifndef ATT_PVPIPE
#define ATT_PVPIPE 1
#endif
#define PVR(D0, l0, h0, l1, h1) do { l0 = tr_read<v_rd_off(D0, 0, 0)>(vb); h0 = tr_read<v_rd_off(D0, 0, 1)>(vb); l1 = tr_read<v_rd_off(D0, 1, 0)>(vb); h1 = tr_read<v_rd_off(D0, 1, 1)>(vb); } while (0)
#define PVM(OA, l0, h0, l1, h1) do { OA = __builtin_amdgcn_mfma_f32_32x32x16_bf16(pa0, ((bf16x8){l0[0], l0[1], l0[2], l0[3], h0[0], h0[1], h0[2], h0[3]}), OA, 0, 0, 0); \
    OA = __builtin_amdgcn_mfma_f32_32x32x16_bf16(pa1, ((bf16x8){l1[0], l1[1], l1[2], l1[3], h1[0], h1[1], h1[2], h1[3]}), OA, 0, 0, 0); } while (0)
#define PIN(x) asm volatile("" : "+v"(x))
#define PVW(n) do { asm volatile("s_waitcnt lgkmcnt(" #n ")" ::: "memory"); SBAR(); } while (0)
__device__ __forceinline__ void pv_all_pipe(f32x16* o, int vb, bf16x8 pa0, bf16x8 pa1) {
  s16x4 a0, a1, a2, a3, b0, b1, b2, b3;
  PVR(0, a0, a1, a2, a3);
  PVR(1, b0, b1, b2, b3); PVW(4); PVM(o[0], a0, a1, a2, a3);
  PVR(2, a0, a1, a2, a3); PVW(4); PVM(o[1], b0, b1, b2, b3);
  PVR(3, b0, b1, b2, b3); PVW(4); PVM(o[2], a0, a1, a2, a3);
  PVR(4, a0, a1, a2, a3); PVW(4); PVM(o[3], b0, b1, b2, b3);
  PVR(5, b0, b1, b2, b3); PVW(4); PVM(o[4], a0, a1, a2, a3);
  PVR(6, a0, a1, a2, a3); PVW(4); PVM(o[5], b0, b1, b2, b3);
  PVR(7, b0, b1, b2, b3); PVW(4); PVM(o[6], a0, a1, a2, a3);
  PVW(0); PVM(o[7], b0, b1, b2, b3);
}
__device__ __forceinline__ void pv_all_sm(f32x16& o0, f32x16& o1, f32x16& o2, f32x16& o3, f32x16& o4, f32x16& o5, f32x16& o6, f32x16& o7, int vb, bf16x8 pa0, bf16x8 pa1,
                                          f32x16& p0, float& m_reg, float& mn, float& alpha) {
  constexpr float C = SCALE * 1.4426950408889634f;
  s16x4 a0, a1, a2, a3, b0, b1, b2, b3;
  float t0, t1, mnC;
  PVR(0, a0, a1, a2, a3);
  PVR(1, b0, b1, b2, b3);
  t0 = fmaxf(fmaxf(fmaxf(p0[0], p0[1]), fmaxf(p0[2], p0[3])), fmaxf(fmaxf(p0[4], p0[5]), fmaxf(p0[6], p0[7]))); PIN(t0);
  PVW(4); PVM(o0, a0, a1, a2, a3);
  PVR(2, a0, a1, a2, a3);
  t1 = fmaxf(fmaxf(fmaxf(p0[8], p0[9]), fmaxf(p0[10], p0[11])), fmaxf(fmaxf(p0[12], p0[13]), fmaxf(p0[14], p0[15])));
  t0 = fmaxf(t0, t1);
  { auto rr = __builtin_amdgcn_permlane32_swap(__float_as_uint(t0), __float_as_uint(t0), false, false); t0 = fmaxf(__uint_as_float(rr[0]), __uint_as_float(rr[1])); } PIN(t0);
  PVW(4); PVM(o1, b0, b1, b2, b3);
  PVR(3, b0, b1, b2, b3);
  { const bool keep = __all(t0 - m_reg <= THR / SCALE);
    mn = keep ? m_reg : fmaxf(m_reg, t0); alpha = keep ? 1.f : __builtin_amdgcn_exp2f((m_reg - mn) * C); m_reg = mn; mnC = -mn * C; PIN(alpha); PIN(mnC); }
  PVW(4); PVM(o2, a0, a1, a2, a3);
  PVR(4, a0, a1, a2, a3);
#pragma unroll
  for (int r = 0; r < 8; ++r) { p0[r] = fmaf(p0[r], C, mnC); PIN(p0[r]); }
  PVW(4); PVM(o3, b0, b1, b2, b3);
  PVR(5, b0, b1, b2, b3);
#pragma unroll
  for (int r = 8; r < 16; ++r) { p0[r] = fmaf(p0[r], C, mnC); PIN(p0[r]); }
  PVW(4); PVM(o4, a0, a1, a2, a3);
  PVR(6, a0, a1, a2, a3);
#pragma unroll
  for (int r = 0; r < 3; ++r) { p0[r] = __builtin_amdgcn_exp2f(p0[r]); PIN(p0[r]); }
  PVW(4); PVM(o5, b0, b1, b2, b3);
  PVR(7, b0, b1, b2, b3);
#pragma unroll
  for (int r = 3; r < 6; ++r) { p0[r] = __builtin_amdgcn_exp2f(p0[r]); PIN(p0[r]); }
  PVW(4); PVM(o6, a0, a1, a2, a3);
#pragma unroll
  for (int r = 6; r < 8; ++r) { p0[r] = __builtin_amdgcn_exp2f(p0[r]); PIN(p0[r]); }
  PVW(0); PVM(o7, b0, b1, b2, b3);
}
__device__ __forceinline__ void qkt_fsm(f32x16& pn, const bf16_t* Ks, const bf16x8 (&q)[8], int r32, int hi, f32x16& p0, float alpha, float& l_reg, bf16x8& pa0, bf16x8& pa1) {
  pn = f32x16{};
  const char* kbp = (const char*)Ks;
  bf16x8 kf[2];
  kf[0] = *reinterpret_cast<const bf16x8*>(kbp + KSWZ(r32, (hi * 8) * 2));
  float ps = 0.f; unsigned c0 = 0, c1 = 0, c2 = 0, c3 = 0, e0 = 0, e1 = 0, e2 = 0, e3 = 0;
#define QSTEP(d0, ...) do { if ((d0) < 7) kf[((d0) + 1) & 1] = *reinterpret_cast<const bf16x8*>(kbp + KSWZ(r32, (((d0) + 1) * 16 + hi * 8) * 2)); \
    pn = __builtin_amdgcn_mfma_f32_32x32x16_bf16(kf[(d0) & 1], q[d0], pn, 0, 0, 0); __VA_ARGS__; SBAR(); } while (0)
  QSTEP(0, { p0[8] = __builtin_amdgcn_exp2f(p0[8]); p0[9] = __builtin_amdgcn_exp2f(p0[9]); PIN(p0[8]); PIN(p0[9]); });
  QSTEP(1, { p0[10] = __builtin_amdgcn_exp2f(p0[10]); p0[11] = __builtin_amdgcn_exp2f(p0[11]); PIN(p0[10]); PIN(p0[11]); });
  QSTEP(2, { p0[12] = __builtin_amdgcn_exp2f(p0[12]); p0[13] = __builtin_amdgcn_exp2f(p0[13]); PIN(p0[12]); PIN(p0[13]); });
  QSTEP(3, { p0[14] = __builtin_amdgcn_exp2f(p0[14]); p0[15] = __builtin_amdgcn_exp2f(p0[15]); PIN(p0[14]); PIN(p0[15]); });
  QSTEP(4, { ps = ((p0[0] + p0[1]) + (p0[2] + p0[3])) + ((p0[4] + p0[5]) + (p0[6] + p0[7])); PIN(ps); });
  QSTEP(5, { ps += ((p0[8] + p0[9]) + (p0[10] + p0[11])) + ((p0[12] + p0[13]) + (p0[14] + p0[15]));
    { auto rr = __builtin_amdgcn_permlane32_swap(__float_as_uint(ps), __float_as_uint(ps), false, false); ps = __uint_as_float(rr[0]) + __uint_as_float(rr[1]); }
    l_reg = l_reg * alpha + ps; PIN(l_reg); });
  QSTEP(6, { c0 = cvtpk(p0[0], p0[1]); c1 = cvtpk(p0[2], p0[3]); c2 = cvtpk(p0[4], p0[5]); c3 = cvtpk(p0[6], p0[7]);
    auto r0 = __builtin_amdgcn_permlane32_swap(c0, c2, false, false); auto r1 = __builtin_amdgcn_permlane32_swap(c1, c3, false, false);
    u32x4 w = {r0[0], r1[0], r0[1], r1[1]}; PIN(w); pa0 = *reinterpret_cast<bf16x8*>(&w); });
  QSTEP(7, { e0 = cvtpk(p0[8], p0[9]); e1 = cvtpk(p0[10], p0[11]); e2 = cvtpk(p0[12], p0[13]); e3 = cvtpk(p0[14], p0[15]);
    auto r0 = __builtin_amdgcn_permlane32_swap(e0, e2, false, false); auto r1 = __builtin_amdgcn_permlane32_swap(e1, e3, false, false);
    u32x4 w = {r0[0], r1[0], r0[1], r1[1]}; PIN(w); pa1 = *reinterpret_cast<bf16x8*>(&w); });
#undef QSTEP
}
#undef PVR
#undef PVM
#undef PVW
#undef PIN
__device__ __forceinline__ void pv_all(f32x16* o, int vb, bf16x8 pa0, bf16x8 pa1) {
#if ATT_PVPIPE
  pv_all_pipe(o, vb, pa0, pa1);
#elif ATT_PV1
  pv_one<0>(o[0], vb, pa0, pa1); pv_one<1>(o[1], vb, pa0, pa1); pv_one<2>(o[2], vb, pa0, pa1); pv_one<3>(o[3], vb, pa0, pa1);
  pv_one<4>(o[4], vb, pa0, pa1); pv_one<5>(o[5], vb, pa0, pa1); pv_one<6>(o[6], vb, pa0, pa1); pv_one<7>(o[7], vb, pa0, pa1);
#else
  pv_two<0>(o[0], o[1], vb, pa0, pa1); pv_two<2>(o[2], o[3], vb, pa0, pa1); pv_two<4>(o[4], o[5], vb, pa0, pa1); pv_two<6>(o[6], o[7], vb, pa0, pa1);
#endif
}
__device__ __forceinline__ void attn_dense_body(const bf16_t* __restrict__ Qb, const bf16_t* __restrict__ Kh, const bf16_t* __restrict__ Vh,
                                                unsigned* __restrict__ Ob, int seq, char* lds, int wave_) {
  const int tid = hw_tid(wave_), wid = tid >> 6, lane = tid & 63, r32 = lane & 31, hi = lane >> 5;
#ifndef ATT_DMA3
#define ATT_DMA3 1
#endif
#if ATT_DMA3
  constexpr int NVB = 4, NKB = 3;
  static_assert(!ATT_QLDS, "the LDS-DMA body keeps Q in registers");
#else
  constexpr int NVB = 2, NKB = 2;
#endif
  bf16_t* V_lds = (bf16_t*)lds; bf16_t* K_lds = (bf16_t*)(lds + NVB * SHM_V);
  float* ws = (float*)(lds + NVB * SHM_V + NKB * SHM_K) + wid * 64; float* li_l = ws; float* al_l = ws + 32;
  float m_reg = -1e30f, l_reg = 0; f32x16 o[8] = {};
#if ATT_QLDS
  char* qr = lds + SHM_Q0 + wid * 8192 + lane * 16;
#else
  bf16x8 qr[8];
#endif
  const bf16_t* Qw = Qb + (long)(wid * QBLK + r32) * LDQ + hi * 8;
#pragma unroll
#if ATT_QLDS
  for (int d0 = 0; d0 < 8; ++d0) *reinterpret_cast<bf16x8*>(qr + d0 * 1024) = *reinterpret_cast<const bf16x8*>(Qw + d0 * 16);
#else
  for (int d0 = 0; d0 < 8; ++d0) qr[d0] = *reinterpret_cast<const bf16x8*>(Qw + d0 * 16);
#endif
  const int vb0 = (int)(uintptr_t)V_lds + v_rd_base(lane);
#define RESC(a) do { if (__any((a) < 1.f)) { if (hi == 0) al_l[r32] = (a); asm volatile("s_waitcnt lgkmcnt(0)" ::: "memory"); \
    for (int d = 0; d < 8; ++d) for (int r = 0; r < 16; ++r) o[d][r] *= al_l[crow(r, hi)]; } } while (0)
#if ATT_DMA3
  const int widu = __builtin_amdgcn_readfirstlane(wid);
  const unsigned kdl = (unsigned)(uintptr_t)(LAS unsigned char*)K_lds + ((unsigned)widu << 10), vdl = (unsigned)(uintptr_t)(LAS unsigned char*)V_lds + ((unsigned)widu << 10);
  const unsigned kofs = (unsigned)(((tid >> 4) * LDK + ((((tid & 15) ^ ((tid >> 4) & 7))) << 3)) * 2);
  unsigned vofs[2];
#pragma unroll
  for (int i = 0; i < 2; ++i) { const int sl = tid + 512 * i, sub = sl >> 5, w = sl & 31, kk = (sub >> 3) * 8 + (w >> 2), c = (sub & 7) * 32 + (w & 3) * 8, k = (kk & ~0xC) | ((kk & 4) << 1) | ((kk & 8) >> 1);
    vofs[i] = (unsigned)((k * LDK + c) * 2); }
  const int NT = seq / KVBLK;
#define DMA(t, kb, vbi) do { const int t_ = (t) < NT ? (t) : NT - 1; const char* kt_ = (const char*)(Kh + (long)t_ * (KVBLK * LDK)); const char* vt_ = (const char*)(Vh + (long)t_ * (KVBLK * LDK)); \
    __builtin_amdgcn_global_load_lds((const unsigned*)(kt_ + kofs), (LAS unsigned*)(kdl + (unsigned)(kb) * (unsigned)SHM_K), 16, 0, 0); \
    __builtin_amdgcn_global_load_lds((const unsigned*)(vt_ + vofs[0]), (LAS unsigned*)(vdl + (unsigned)(vbi) * (unsigned)SHM_V), 16, 0, 0); \
    __builtin_amdgcn_global_load_lds((const unsigned*)(vt_ + vofs[1]), (LAS unsigned*)(vdl + (unsigned)(vbi) * (unsigned)SHM_V + 8192u), 16, 0, 0); } while (0)
#define LAND() do { asm volatile("s_waitcnt vmcnt(3)" ::: "memory"); __builtin_amdgcn_s_barrier(); asm volatile("" ::: "memory"); } while (0)
#define KB(i) ((bf16_t*)((char*)K_lds + (i) * (int)SHM_K))
#ifndef ATT_QKV
#define ATT_QKV 6
#endif
#define QK_SCHED() do { _Pragma("unroll") for (int i_ = 0; i_ < 8; ++i_) { __builtin_amdgcn_sched_group_barrier(0x100, 1, 0); __builtin_amdgcn_sched_group_barrier(0x008, 1, 0); \
    __builtin_amdgcn_sched_group_barrier(0x002, ATT_QKV, 0); } } while (0)
  f32x16 pA, pB; float mnA, mnB, alA, alB; bf16x8 pa0, pa1;
  DMA(0, 0, 0); DMA(1, 1, 1); LAND();
  qkt(pA, KB(0), qr, r32, hi); partialSM(pA, m_reg, mnA, alA);
  DMA(2, 2, 2); LAND();
  int k1 = 1;
  for (int j = 1; j + 1 < NT; j += 2) {
    const int kA = k1, kB = (kA == 2 ? 0 : kA + 1), kC = (kB == 2 ? 0 : kB + 1);
    SBAR(); qkt_fsm(pB, KB(kA), qr, r32, hi, pA, alA, l_reg, pa0, pa1);
    DMA(j + 2, kC, (j + 2) & 3); SBAR();
    pv_all_sm(o[0], o[1], o[2], o[3], o[4], o[5], o[6], o[7], vb0 + ((j - 1) & 3) * (int)SHM_V, pa0, pa1, pB, m_reg, mnB, alB);
    LAND(); RESC(alB);
    SBAR(); qkt_fsm(pA, KB(kB), qr, r32, hi, pB, alB, l_reg, pa0, pa1);
    DMA(j + 3, kA, (j + 3) & 3); SBAR();
    pv_all_sm(o[0], o[1], o[2], o[3], o[4], o[5], o[6], o[7], vb0 + (j & 3) * (int)SHM_V, pa0, pa1, pA, m_reg, mnA, alA);
    LAND(); RESC(alA);
    k1 = kC;
  }
  SBAR(); qkt(pB, KB(k1), qr, r32, hi);
  finishSM(pA, alA, l_reg, pa0, pa1); SBAR();
  pv_all(o, vb0 + ((NT - 2) & 3) * (int)SHM_V, pa0, pa1); partialSM(pB, m_reg, mnB, alB);
  RESC(alB);
  finishSM(pB, alB, l_reg, pa0, pa1); SBAR();
  pv_all(o, vb0 + ((NT - 1) & 3) * (int)SHM_V, pa0, pa1);
  asm volatile("s_waitcnt vmcnt(0)" ::: "memory");
#undef DMA
#undef LAND
#undef KB
#undef QK_SCHED
#else
  const int sr = tid >> 4, sc = (tid & 15) * 8, vst0 = v_st(sr, sc), vst1 = v_st(sr, 128 + sc);
#ifndef ATT_KDMA
#define ATT_KDMA 1
#endif
#if ATT_KDMA
  struct { bf16x8 vs0, vs1; } sr_[SDEPTH];
  const int kdc = (((tid & 15) ^ (sr & 7)) << 3);
  const unsigned kdl = (unsigned)(uintptr_t)(LAS unsigned char*)K_lds + ((unsigned)__builtin_amdgcn_readfirstlane(wid) << 10);
#define KDMA(b, k0) __builtin_amdgcn_global_load_lds((const unsigned*)(Kh + (long)((k0) + sr) * LDK + kdc), (LAS unsigned*)(kdl + (b) * (unsigned)SHM_K), 16, 0, 0)
#define SLOAD(i, k0, b) do { sr_[i].vs0 = *reinterpret_cast<const bf16x8*>(&Vh[(long)((k0) + sr) * LDK + sc]); sr_[i].vs1 = *reinterpret_cast<const bf16x8*>(&Vh[(long)((k0) + sr) * LDK + 128 + sc]); KDMA(b, k0); } while (0)
#define SWRITE(b, i) do { *(bf16x8*)((char*)V_lds + (b) * SHM_V + vst0) = sr_[i].vs0;          \
    *(bf16x8*)((char*)V_lds + (b) * SHM_V + vst1) = sr_[i].vs1; } while (0)
#else
  struct { bf16x8 vs0, vs1, ks0; } sr_[SDEPTH];
#define SLOAD(i, k0, b) do { sr_[i].vs0 = *reinterpret_cast<const bf16x8*>(&Vh[(long)((k0) + sr) * LDK + sc]); sr_[i].vs1 = *reinterpret_cast<const bf16x8*>(&Vh[(long)((k0) + sr) * LDK + 128 + sc]); \
    sr_[i].ks0 = *reinterpret_cast<const bf16x8*>(&Kh[(long)((k0) + sr) * LDK + sc]); } while (0)
#define SWRITE(b, i) do { *(bf16x8*)((char*)V_lds + (b) * SHM_V + vst0) = sr_[i].vs0;          \
    *(bf16x8*)((char*)V_lds + (b) * SHM_V + vst1) = sr_[i].vs1;                                 \
    *(bf16x8*)((char*)K_lds + (b) * SHM_K + KSWZ(sr, sc * 2)) = sr_[i].ks0; } while (0)
#endif
#define SWAIT() do { if constexpr (SDEPTH == 2) asm volatile("s_waitcnt vmcnt(3)" ::: "memory"); else asm volatile("s_waitcnt vmcnt(0)" ::: "memory"); } while (0)
  f32x16 pA, pB; float mnA, mnB, alA, alB; bf16x8 pa0, pa1; const int NT = seq / KVBLK;
  constexpr int SE = 0, SO = SDEPTH - 1;
  SLOAD(SE, 0, 0); asm volatile("s_waitcnt vmcnt(0)" ::: "memory"); SWRITE(0, SE); __syncthreads();
  qkt(pA, K_lds, qr, r32, hi); partialSM(pA, m_reg, mnA, alA);
  SLOAD(SO, KVBLK, 1); if constexpr (SDEPTH == 2) { if (2 < NT) SLOAD(SE, 2 * KVBLK, 0); }
  SWAIT(); SWRITE(1, SO); __syncthreads();
  for (int j = 1; j + 1 < NT; j += 2) {
    SBAR(); qkt(pB, (bf16_t*)((char*)K_lds + SHM_K), qr, r32, hi);
    finishSM(pA, alA, l_reg, pa0, pa1); SBAR();
    SLOAD(SO, (j + SDEPTH) * KVBLK, 0); SBAR();
    pv_all(o, vb0, pa0, pa1); partialSM(pB, m_reg, mnB, alB);
    __syncthreads(); SWAIT(); SWRITE(0, SE);
    RESC(alB); __syncthreads();
    SBAR(); qkt(pA, K_lds, qr, r32, hi);
    finishSM(pB, alB, l_reg, pa0, pa1); SBAR();
    if (SDEPTH == 1 || j + 3 < NT) SLOAD(SE, (j + 1 + SDEPTH) * KVBLK, 1); SBAR();
    pv_all(o, vb0 + (int)SHM_V, pa0, pa1); partialSM(pA, m_reg, mnA, alA);
    __syncthreads(); SWAIT(); SWRITE(1, SO);
    RESC(alA); __syncthreads();
  }
  SBAR(); qkt(pB, (bf16_t*)((char*)K_lds + SHM_K), qr, r32, hi);
  finishSM(pA, alA, l_reg, pa0, pa1); SBAR();
  pv_all(o, vb0, pa0, pa1); partialSM(pB, m_reg, mnB, alB);
  __syncthreads(); RESC(alB);
  finishSM(pB, alB, l_reg, pa0, pa1); SBAR();
  pv_all(o, vb0 + (int)SHM_V, pa0, pa1);
#undef SLOAD
#undef SWRITE
#undef SWAIT
#ifdef KDMA
#undef KDMA
#endif
#endif
  if (hi == 0) li_l[r32] = l_reg; asm volatile("s_waitcnt lgkmcnt(0)" ::: "memory");
  float rli[16];
#pragma unroll
  for (int r = 0; r < 16; ++r) rli[r] = __builtin_amdgcn_rcpf(li_l[crow(r, hi)]);
  unsigned* Ow = Ob + (long)(wid * QBLK) * (LDO / 2);
#pragma unroll
  for (int r = 0; r < 16; ++r) { int orow = crow(r, hi);
    for (int k = 0; k < 4; ++k) Ow[(long)orow * (LDO / 2) + k * 32 + r32] = cvtpk(o[2 * k][r] * rli[r], o[2 * k + 1][r] * rli[r]); }
#undef RESC
}
#undef KSWZ
#undef SBAR
#undef QV
}

struct Args { const float* in[38]; float* out; unsigned char* ws; int ph_lo, ph_hi; };
enum { I_X = 0, I_C, I_CTX, I_CCTX, I_WADA, I_BADA, I_NORM1, I_NORM2, I_WIN, I_BGATE, I_QNORM, I_KNORM, I_LQ1, I_LK1, I_LQ2, I_LK2, I_SUBN, I_HCW, I_HCB,
       I_HW1, I_HB1, I_HW2, I_HB2, I_HW3, I_HB3, I_HW4, I_HFREQ, I_HBIAS, I_WBRA, I_WBRB, I_WOUT, I_FW1, I_FW3, I_FW2, I_ROUTER, I_MW1, I_MW3, I_MW2 };

struct Frame {
    LAS unsigned char* lds; char* ldsg;
    const float* const* in; float* out; unsigned char* ws;
    int tid, lane, wave, G, bid, gw, NGW;
};

__device__ __forceinline__ Frame enter(const Frame& F0) {
    Frame F = F0; __attribute__((address_space(1))) unsigned char* w = (__attribute__((address_space(1))) unsigned char*)F0.ws; asm volatile("" : "+s"(w)); F.ws = (unsigned char*)w;
    const int t = hw_tid(F0.wave); F.tid = t; F.lane = t & 63; return F;
}
__host__ __device__ __forceinline__ int qk_perm(int d) { const int axis = d >> 6, half = (d >> 5) & 1, f = d & 31; return 32 * (2 * axis + (f >> 4)) + 8 * ((f >> 2) & 3) + 4 * half + (f & 3); }
__device__ __forceinline__ void transpose_item(const float* W, int K, int N, bf16_t* WT, int kb, int nb, int dst_row0, LAS float* scr, int lane, bool qkperm = false) {
    const int k0 = 64 * kb, n0 = 32 * nb;
    { f32x4 v[8]; const float* wp = W + (size_t)(k0 + (lane >> 3)) * N + n0 + 4 * (lane & 7);
#pragma unroll
      for (int i = 0; i < 8; ++i) v[i] = __builtin_nontemporal_load((const f32x4*)(wp + (size_t)(8 * i) * N));
#pragma unroll
      for (int i = 0; i < 8; ++i) { LAS float* d = scr + (8 * i + (lane >> 3)) * 33 + 4 * (lane & 7); d[0] = v[i].x; d[1] = v[i].y; d[2] = v[i].z; d[3] = v[i].w; } }
    LDS_WAIT(); asm volatile("" ::: "memory");
    const int c = lane & 7;
#pragma unroll
    for (int j = 0; j < 4; ++j) { const int n = (lane >> 3) + 8 * j; const LAS float* s = scr + (8 * c) * 33 + n;
        u32x4 o; o.x = cvt_pk_bf16(s[0 * 33], s[1 * 33]); o.y = cvt_pk_bf16(s[2 * 33], s[3 * 33]); o.z = cvt_pk_bf16(s[4 * 33], s[5 * 33]); o.w = cvt_pk_bf16(s[6 * 33], s[7 * 33]);
        const int drow = qkperm ? ((n0 + n) & ~127) + qk_perm((n0 + n) & 127) : dst_row0 + n;
        __builtin_nontemporal_store(o, (u32x4*)(WT + (size_t)drow * K + k0 + 8 * c)); }
    LDS_WAIT(); asm volatile("" ::: "memory");
}
__device__ __forceinline__ float silu_f(float v) { return v / (1.f + __expf(-v)); }

namespace zt {
constexpr int L_WIN = 32 * 512, L_BR = 3 * 32 * 64, L_UP1 = 2 * 32 * 176, L_DN1 = 88 * 64;
constexpr int L_DENSE = L_WIN + L_BR + L_UP1 + L_DN1, L_MOE = L_WIN + L_BR + 8 * (L_UP1 + L_DN1);
constexpr int Z1 = L_DENSE, Z2 = Z1 + L_MOE, Z3 = Z2 + L_DENSE, ZEND = Z3 + L_MOE;
#ifndef ZT_NH
#define ZT_NH 16
#endif
#ifndef ZT_NI
#define ZT_NI 7
#endif
constexpr int BUSY = 32, WORKERS = (256 - BUSY) * NWAVES, CH = ZT_NH * WORKERS, CI = ZT_NI * WORKERS, CL = CH + CI;
constexpr int ZB0 = Z1, ZB1 = ZB0 + CL, ZB2 = Z2 + L_WIN + L_BR;
static_assert(ZB1 + CL <= Z2 && ZB2 + CL <= ZEND, "tail ranges");
__device__ __forceinline__ bool deferred(int G) { return G == 256 && CL > 0; }
}
__device__ __forceinline__ void transpose_z(const Frame& F, int z, LAS float* scr) {
    const int l = z < zt::Z1 ? 0 : (z < zt::Z2 ? 1 : (z < zt::Z3 ? 2 : 3)); int r = z - (l == 0 ? 0 : (l == 1 ? zt::Z1 : (l == 2 ? zt::Z2 : zt::Z3)));
    const float* src; bf16_t* dst; int K, N, kb, nb, dr; bool qp = false;
    if (r < zt::L_WIN) { kb = r / 512; nb = r % 512; const int n0 = 32 * nb; K = DM; N = NIN;
        dr = n0 < 6144 ? n0 : (n0 < 12288 ? NQKVG + (n0 - 6144) : 6144 + (n0 - 12288)); qp = n0 < 4096;
        src = F.in[I_WIN] + (size_t)l * DM * NIN; dst = (bf16_t*)(F.ws + WS_WIN) + (size_t)l * NIN * DM; }
    else if ((r -= zt::L_WIN) < zt::L_BR) { const int w = r / 2048, q = r % 2048; kb = q / 64; nb = q % 64; K = DM; N = DM; dr = 32 * nb;
        src = F.in[w == 0 ? I_WBRA : (w == 1 ? I_WBRB : I_WOUT)] + (size_t)l * DM * DM;
        dst = (bf16_t*)(F.ws + (w == 0 ? WS_WBRA : (w == 1 ? WS_WBRB : WS_WOUT))) + (size_t)l * DM * DM; }
    else { r -= zt::L_BR; const bool moe = (l & 1) != 0; const int ns = moe ? 8 : 1, slot0 = moe ? 2 + (l >> 1) * 8 : (l >> 1);
        if (r < ns * zt::L_UP1) { const int slot = slot0 + r / zt::L_UP1, q0 = r % zt::L_UP1, which = q0 / (32 * 176), q = q0 % (32 * 176); kb = q / 176; nb = q % 176; const int n0 = 32 * nb; K = DM; N = DFF;
            dr = (n0 / 128) * 256 + which * 128 + (n0 % 128);
            src = slot < 2 ? F.in[which ? I_FW3 : I_FW1] + (size_t)slot * DM * DFF : F.in[which ? I_MW3 : I_MW1] + (size_t)(slot - 2) * DM * DFF;
            dst = (bf16_t*)(F.ws + WS_WUP) + (size_t)slot * 2 * DFF * DM; }
        else { r -= ns * zt::L_UP1; const int slot = slot0 + r / zt::L_DN1, q = r % zt::L_DN1; kb = q / 64; nb = q % 64; K = DFF; N = DM; dr = 32 * nb;
            src = slot < 2 ? F.in[I_FW2] + (size_t)slot * DFF * DM : F.in[I_MW2] + (size_t)(slot - 2) * DFF * DM;
            dst = (bf16_t*)(F.ws + WS_WDN) + (size_t)slot * DM * DFF; } }
    transpose_item(src, K, N, dst, kb, nb, dr, scr, F.lane, qp);
}
__device__ __forceinline__ void phase_tail_transposes(const Frame& F0, int l, int which) {
    Frame F = enter(F0);
    if (!zt::deferred(F.G) || F.bid < zt::BUSY || l >= DEPTH - 1) return;
    LAS float* scr = (LAS float*)(F.lds + F.wave * 16384);
    const int zlo = (l == 0 ? zt::ZB0 : (l == 1 ? zt::ZB1 : zt::ZB2)) + (which ? zt::CH : 0), zhi = zlo + (which ? zt::CI : zt::CH);
    for (int z = zlo + (F.bid - zt::BUSY) * NWAVES + F.wave; z < zhi; z += zt::WORKERS) transpose_z(F, z, scr);
}
__device__ __forceinline__ void phase_prologue0(const Frame& F0) {
    Frame F = enter(F0);
    LAS float* scr = (LAS float*)(F.lds + F.wave * 16384);
    {
        const bool defer = zt::deferred(F.G);
        const int n0 = defer ? zt::ZB0 : zt::ZEND, n1 = defer ? zt::ZB2 - (zt::ZB1 + zt::CL) : 0, n2 = defer ? zt::ZEND - (zt::ZB2 + zt::CL) : 0, np = n0 + n1 + n2;
        for (int px = F.gw; px < np * ((PROBE == 4) ? 2 : 1); px += F.NGW) { const int p = px % np;
            const int z = p < n0 ? p : (p < n0 + n1 ? zt::ZB1 + zt::CL + (p - n0) : zt::ZB2 + zt::CL + (p - n0 - n1));
            transpose_z(F, z, scr); }
    }
    {
        LAS float* zb = (LAS float*)(F.lds + F.wave * 16384);
        const int l = F.gw & 3, j = F.lane;
        float w1c[33], w2c[64], w3c[64];
#pragma unroll
        for (int i = 0; i < 33; ++i) w1c[i] = F.in[I_HW1][((size_t)l * 33 + i) * 64 + j];
#pragma unroll
        for (int i = 0; i < 64; ++i) { w2c[i] = F.in[I_HW2][((size_t)l * 64 + i) * 64 + j]; w3c[i] = F.in[I_HW3][((size_t)l * 64 + i) * 64 + j]; }
        const float fr = F.in[I_HFREQ][l * 64 + j], b1 = F.in[I_HB1][l * 64 + j], b2 = F.in[I_HB2][l * 64 + j], b3 = F.in[I_HB3][l * 64 + j];
        const int nq = 4352 * ((PROBE == 12) ? 2 : 1);
        for (int qx = F.gw >> 2; qx < nq; qx += F.NGW >> 2) {
            const int q = qx % 4352; const int var = q >= 4096, t = var ? q - 4096 : q, L = var ? 256 : 4096;
            float z = 0.f;
            if (j == 0) z = (float)t / (float)(L - 1);
            else if (j < 33) { const int k = (j - 1) & 15; const float w = 6.283185307179586f * (float)t / (float)L; const float f = 1e-4f + (float)k * ((15.f - 1e-4f) / 15.f);
                z = (j < 17) ? cosf(w * f) : -sinf(w * f); }
            zb[j] = z; LDS_WAIT(); asm volatile("" ::: "memory");
            float a = b1;
#pragma unroll
            for (int i = 0; i < 33; ++i) a += zb[i] * w1c[i];
            float h = sinf(fr * a);
            zb[64 + j] = h; LDS_WAIT(); asm volatile("" ::: "memory");
            a = b2;
#pragma unroll
            for (int i = 0; i < 64; ++i) a += zb[64 + i] * w2c[i];
            h = sinf(fr * a);
            zb[j] = h; LDS_WAIT(); asm volatile("" ::: "memory");
            a = b3;
#pragma unroll
            for (int i = 0; i < 64; ++i) a += zb[i] * w3c[i];
            h = sinf(fr * a);
            float* dst = var ? (float*)(F.ws + WS_HIDC) + ((size_t)l * 256 + t) * 64 : (float*)(F.ws + WS_HID) + ((size_t)l * 4096 + t) * 64;
            dst[j] = h;
            LDS_WAIT(); asm volatile("" ::: "memory");
        }
    }
    if (F.bid == 0 && F.wave < 4) {
        const int l = F.wave; const int j = F.lane;
        float s1 = F.in[I_LQ1][l * 128 + j] * F.in[I_LK1][l * 128 + j] + F.in[I_LQ1][l * 128 + 64 + j] * F.in[I_LK1][l * 128 + 64 + j];
        float s2 = F.in[I_LQ2][l * 128 + j] * F.in[I_LK2][l * 128 + j] + F.in[I_LQ2][l * 128 + 64 + j] * F.in[I_LK2][l * 128 + 64 + j];
        s1 = wave_sum(s1, j); s2 = wave_sum(s2, j);
        const float lam_init = 0.8f - 0.6f * expf(-0.3f * (float)l);
        if (j == 0) ((float*)(F.ws + WS_LAM))[l] = expf(s1) - expf(s2) + lam_init;
    }
    if (F.bid == 1 % F.G) {
        for (int i = F.tid; i < 2048; i += NTHR) { const int pos = i >> 5, f = i & 31; const float inv = expf(-(float)f * (9.210340371976184f / 32.f)); const float ang = (float)pos * inv;
            ((float*)(F.ws + WS_ROPE))[i] = cosf(ang); ((float*)(F.ws + WS_ROPE))[2048 + i] = sinf(ang); }
    }
    __syncthreads();
    {
        LAS float* sv = (LAS float*)F.lds;
        LAS float* red = (LAS float*)(F.lds + 65536);
        bool have = false;
        const int half = F.lane >> 5, l4 = (F.lane & 31) * 4;
        for (int itx = F.bid; itx < 4 * 96 * ((PROBE == 13) ? 2 : 1); itx += F.G) { const int it = itx % (4 * 96);
            if (!have) { for (int i = F.tid; i < 5 * DM; i += NTHR) { const int v = i / DM, k = i % DM; const float cv = v < 4 ? F.in[I_C][v * DM + k] : F.in[I_CCTX][k]; sv[i] = silu_f(cv); } have = true; __syncthreads(); }
            const int l = it / 96, cc = it % 96;
            const float* W = F.in[I_WADA] + (size_t)l * DM * 12288 + cc * 128 + l4;
            f32x4 acc[5];
#pragma unroll
            for (int v = 0; v < 5; ++v) acc[v] = (f32x4){0.f, 0.f, 0.f, 0.f};
            const int k0 = F.wave * 256 + half;
#pragma unroll 8
            for (int kk = 0; kk < 128; ++kk) { const int k = k0 + 2 * kk; const f32x4 w = *(const f32x4*)(W + (size_t)k * 12288);
#pragma unroll
                for (int v = 0; v < 5; ++v) acc[v] += w * sv[v * DM + k]; }
#pragma unroll
            for (int v = 0; v < 5; ++v)
#pragma unroll
                for (int q = 0; q < 4; ++q) acc[v][q] += shx(acc[v][q], 32, F.lane);
            if (half == 0) {
#pragma unroll
                for (int v = 0; v < 5; ++v) *(LAS f32x4*)(red + (F.wave * 5 + v) * 128 + l4) = acc[v]; }
            __syncthreads();
            for (int i = F.tid; i < 5 * 128; i += NTHR) { const int v = i / 128, c = i % 128; float sm = 0.f;
#pragma unroll
                for (int w = 0; w < 8; ++w) sm += red[(w * 5 + v) * 128 + c];
                ((float*)(F.ws + WS_MOD))[((size_t)l * 5 + v) * 12288 + cc * 128 + c] = sm + F.in[I_BADA][l * 12288 + cc * 128 + c]; }
            __syncthreads();
        }
    }
}

__device__ __forceinline__ void split8(const float (&x)[8], bf16x8& hi, bf16x8& lo) {
    u32x4 h, l;
#pragma unroll
    for (int k = 0; k < 4; ++k) { const unsigned hw = cvt_pk_bf16(x[2 * k], x[2 * k + 1]); h[k] = hw; l[k] = cvt_pk_bf16(x[2 * k] - bf_lo(hw), x[2 * k + 1] - bf_hi(hw)); }
    hi = *reinterpret_cast<bf16x8*>(&h); lo = *reinterpret_cast<bf16x8*>(&l);
}
__device__ __forceinline__ void phase_prologue1(const Frame& F0) {
    Frame F = enter(F0);
    const int n = F.lane & 31, hi = F.lane >> 5;
    for (int it = F.gw; it < 4 * 256 * 2; it += F.NGW) {
        const int l = it >> 9, cb = (it >> 1) & 255, half = it & 1;
        const int col0 = cb * 32, f = col0 >> 12, dir = (col0 >> 11) & 1, c0 = col0 & 2047;
        const float* w4 = F.in[I_HW4] + (size_t)l * 64 * 8192 + col0 + n;
        bf16x8 Ah[4], Al[4];
#pragma unroll
        for (int ks = 0; ks < 4; ++ks) { float xv[8];
#pragma unroll
            for (int i = 0; i < 8; ++i) xv[i] = w4[(size_t)(16 * ks + 8 * hi + i) * 8192];
            split8(xv, Ah[ks], Al[ks]); }
        const float da = -3.0701134573253945f, db = -15.350567286626972f;
#pragma unroll
        for (int var = 0; var < 2; ++var) {
            if (var == 1 && half != 0) continue;
            const int L = var ? 256 : 4096, ntb = var ? 8 : 64, tb0 = var ? 0 : half * 64;
            const float invL = 1.f / (float)(L - 1);
            float base[16], step[16];
#pragma unroll
            for (int r = 0; r < 16; ++r) { const int ch = c0 + (r & 3) + 8 * (r >> 2) + 4 * hi; const float delta = fabsf(da + (float)ch * ((db - da) / 2047.f));
                base[r] = expf(-delta * (float)(tb0 * 32 + n) * invL); step[r] = expf(-delta * 32.f * invL); }
            const float* hsrc = (var ? (const float*)(F.ws + WS_HIDC) + (size_t)l * 256 * 64 : (const float*)(F.ws + WS_HID) + (size_t)l * 4096 * 64) + (size_t)(tb0 * 32 + n) * 64 + 8 * hi;
            bf16_t* Rl = var ? (bf16_t*)(F.ws + WS_RC) + (((size_t)l * 2 + f) * 2048 + c0 + 4 * hi) * 1024 + 512 : (bf16_t*)(F.ws + WS_R) + (((size_t)l * 2 + f) * 2048 + c0 + 4 * hi) * 8704 + 4352;
            const int rstride = var ? 1024 : 8704;
            f32x4 hn[8];
#pragma unroll
            for (int ks = 0; ks < 4; ++ks) { hn[2 * ks] = *(const f32x4*)(hsrc + 16 * ks); hn[2 * ks + 1] = *(const f32x4*)(hsrc + 16 * ks + 4); }
            for (int tb = 0; tb < ntb; ++tb) {
                f32x16 acc = f32x16{};
                f32x4 hc[8];
#pragma unroll
                for (int k = 0; k < 8; ++k) hc[k] = hn[k];
                { const int tn = tb + 1 < ntb ? tb + 1 : tb;
#pragma unroll
                  for (int ks = 0; ks < 4; ++ks) { hn[2 * ks] = *(const f32x4*)(hsrc + (size_t)tn * 2048 + 16 * ks); hn[2 * ks + 1] = *(const f32x4*)(hsrc + (size_t)tn * 2048 + 16 * ks + 4); } }
#pragma unroll
                for (int ks = 0; ks < 4; ++ks) { const f32x4 b0 = hc[2 * ks], b1 = hc[2 * ks + 1];
                    const float xv[8] = {b0.x, b0.y, b0.z, b0.w, b1.x, b1.y, b1.z, b1.w}; bf16x8 Bh, Bl; split8(xv, Bh, Bl);
                    acc = __builtin_amdgcn_mfma_f32_32x32x16_bf16(Ah[ks], Bh, acc, 0, 0, 0);
                    acc = __builtin_amdgcn_mfma_f32_32x32x16_bf16(Ah[ks], Bl, acc, 0, 0, 0);
                    acc = __builtin_amdgcn_mfma_f32_32x32x16_bf16(Al[ks], Bh, acc, 0, 0, 0); }
                const int t = (tb0 + tb) * 32 + n;
#pragma unroll
                for (int r = 0; r < 16; ++r) { const float val = acc[r] * base[r]; base[r] *= step[r];
                    bf16_t* Rr = Rl + (size_t)((r & 3) + 8 * (r >> 2)) * rstride;
                    const bf16_t bv = (bf16_t)(cvt_pk_bf16(val, 0.f) & 0xffffu);
                    if (dir == 0) Rr[-t] = bv; else if (t >= 1) Rr[t] = bv; }
            }
        }
    }
    for (int it = F.gw; it < 4 * 2 * 2048; it += F.NGW) {
        bf16_t* R = (bf16_t*)(F.ws + WS_R) + (size_t)it * 8704; bf16_t* Rc = (bf16_t*)(F.ws + WS_RC) + (size_t)it * 1024;
        for (int x = F.lane; x < 257; x += 64) { R[x] = 0; Rc[x] = 0; }
        for (int x = F.lane; x < 256; x += 64) { R[8448 + x] = 0; Rc[768 + x] = 0; }
    }
}

__device__ __forceinline__ void ffn_row_load(Frame& F, int lp, int row, f32x4 (&f)[8]) {
    const bf16_t* ys = (const bf16_t*)(F.ws + AR_YS);
    if ((lp & 1) == 0) {
        if (row < ML) { const u32x2* p = (const u32x2*)(ys + (size_t)row * DM) + F.lane;
#pragma unroll
            for (int j = 0; j < 8; ++j) { const u32x2 w = __builtin_nontemporal_load(p + 64 * j); f[j] = (f32x4){bf_lo(w.x), bf_hi(w.x), bf_lo(w.y), bf_hi(w.y)}; }
        } else { const f32x4* p = (const f32x4*)((const float*)(F.ws + AR_YSC) + (size_t)(row - ML) * DM) + F.lane;
#pragma unroll
            for (int j = 0; j < 8; ++j) f[j] = ((p[64 * j] + p[64 * j + MC * DM / 4]) + p[64 * j + 2 * (MC * DM / 4)]) + p[64 * j + 3 * (MC * DM / 4)]; }
    } else {
        const int* ti = (const int*)(F.ws + WS_TOK) + (size_t)row * 8;
        const int e1 = ti[0], p1 = ti[1], e2 = ti[2], p2 = ti[3]; const float w1 = __int_as_float(ti[4]), w2 = __int_as_float(ti[5]);
        const unsigned* cnt = (const unsigned*)(F.ws + WS_CTL) + CW_CNT + (lp >> 1) * 8 * 64;
        int s1 = 0, s2 = 0;
#pragma unroll
        for (int e = 0; e < 8; ++e) { const int tl = ((int)cnt[e * 64] + 255) >> 8; s1 += (e < e1) ? tl : 0; s2 += (e < e2) ? tl : 0; }
        const u32x2* pa = (const u32x2*)(ys + (size_t)(s1 * 256 + p1) * DM) + F.lane;
        const u32x2* pb = (const u32x2*)(ys + (size_t)(s2 * 256 + p2) * DM) + F.lane;
#pragma unroll
        for (int j = 0; j < 8; ++j) { const u32x2 a = __builtin_nontemporal_load(pa + 64 * j), b = __builtin_nontemporal_load(pb + 64 * j);
            f[j] = (f32x4){w1 * bf_lo(a.x) + w2 * bf_lo(b.x), w1 * bf_hi(a.x) + w2 * bf_hi(b.x), w1 * bf_lo(a.y) + w2 * bf_lo(b.y), w1 * bf_hi(a.y) + w2 * bf_hi(b.y)}; }
    }
}
__device__ __forceinline__ void phase_normmod1(const Frame& F0, int l, int npass = 1) {
    Frame F = enter(F0);
#pragma nounroll
    for (int pass = 0; pass < npass; ++pass) { const bool dry = pass + 1 < npass;
    float* X = (float*)(F.ws + WS_X); bf16_t* H = (bf16_t*)(F.ws + (dry ? AR_O : AR_H)); float* Xw = dry ? (float*)(F.ws + AR_O + 68 * MiB) : X;
    const float* mod = (const float*)(F.ws + WS_MOD);
    f32x4 xn[8];
    { const int row = F.gw; const f32x4* src = (const f32x4*)(l == 0 ? (row < ML ? F.in[I_X] + (size_t)row * DM : F.in[I_CTX] + (size_t)(row - ML) * DM) : X + (size_t)row * DM) + F.lane;
#pragma unroll
      for (int j = 0; j < 8; ++j) xn[j] = src[64 * j]; }
    for (int row = F.gw; row < MT; row += F.NGW) {
        const int v = row < ML ? row / SEQ : 4;
        f32x4 x[8];
#pragma unroll
        for (int j = 0; j < 8; ++j) x[j] = xn[j];
        { const int rn = row + F.NGW < MT ? row + F.NGW : row;
          const f32x4* src = (const f32x4*)(l == 0 ? (rn < ML ? F.in[I_X] + (size_t)rn * DM : F.in[I_CTX] + (size_t)(rn - ML) * DM) : X + (size_t)rn * DM) + F.lane;
#pragma unroll
          for (int j = 0; j < 8; ++j) xn[j] = __builtin_nontemporal_load(src + 64 * j); }
        if (l != 0) {
            const f32x4* g2 = (const f32x4*)(mod + ((size_t)(l - 1) * 5 + v) * 12288 + 5 * DM) + F.lane;
            f32x4 f[8]; ffn_row_load(F, l - 1, row, f);
#pragma unroll
            for (int j = 0; j < 8; ++j) x[j] = x[j] + g2[64 * j] * f[j];
        }
        { f32x4* dst = (f32x4*)(Xw + (size_t)row * DM) + F.lane;
#pragma unroll
            for (int j = 0; j < 8; ++j) __builtin_nontemporal_store(x[j], dst + 64 * j); }
        float ss = 0.f;
#pragma unroll
        for (int j = 0; j < 8; ++j) ss += (x[j].x * x[j].x + x[j].y * x[j].y) + (x[j].z * x[j].z + x[j].w * x[j].w);
        const float rstd = 1.f / sqrtf(wave_sum(ss, F.lane) * (1.f / DM) + EPS);
        const f32x4* gn = (const f32x4*)(F.in[I_NORM1] + (size_t)l * DM) + F.lane;
        const f32x4* sh = (const f32x4*)(mod + ((size_t)l * 5 + v) * 12288) + F.lane;
        const f32x4* sc = (const f32x4*)(mod + ((size_t)l * 5 + v) * 12288 + DM) + F.lane;
        u32x2* o = (u32x2*)(H + (size_t)row * DM) + F.lane;
#pragma unroll
        for (int j = 0; j < 8; ++j) { const f32x4 y = (x[j] * rstd) * gn[64 * j]; const f32x4 h = y * (sc[64 * j] + 1.f) + sh[64 * j];
            u32x2 w; w.x = cvt_pk_bf16(h.x, h.y); w.y = cvt_pk_bf16(h.z, h.w); o[64 * j] = w; }
    }
    }
}
__device__ __forceinline__ void phase_final(const Frame& F0) {
    Frame F = enter(F0);
    const float* X = (const float*)(F.ws + WS_X); const float* mod = (const float*)(F.ws + WS_MOD);
    for (int row = F.gw; row < ML; row += F.NGW) {
        const int v = row / SEQ;
        const f32x4* src = (const f32x4*)(X + (size_t)row * DM) + F.lane;
        const f32x4* g2 = (const f32x4*)(mod + ((size_t)3 * 5 + v) * 12288 + 5 * DM) + F.lane;
        f32x4 f[8]; ffn_row_load(F, 3, row, f);
        f32x4* dst = (f32x4*)(F.out + (size_t)row * DM) + F.lane;
#pragma unroll
        for (int j = 0; j < 8; ++j) __builtin_nontemporal_store(__builtin_nontemporal_load(src + 64 * j) + g2[64 * j] * f[j], dst + 64 * j);
    }
}
__device__ __forceinline__ void phase_normmod2(const Frame& F0, int l) {
    Frame F = enter(F0);
    const float* X = (const float*)(F.ws + WS_X); const float* mod = (const float*)(F.ws + WS_MOD);
    const bool moe = (l & 1) != 0; const int nrows = (l == DEPTH - 1) ? ML : MT;
    bf16_t* H = (bf16_t*)(F.ws + AR_H); bf16_t* H2S = (bf16_t*)(F.ws + AR_H2S);
    unsigned* cnt = (unsigned*)(F.ws + WS_CTL) + CW_CNT + (l >> 1) * 8 * 64;
    const float* router = F.in[I_ROUTER] + (size_t)(l >> 1) * DM * 8;
    f32x4 xn[8];
    { const f32x4* src = (const f32x4*)(X + (size_t)(F.gw < nrows ? F.gw : 0) * DM) + F.lane;
#pragma unroll
      for (int j = 0; j < 8; ++j) xn[j] = src[64 * j]; }
    for (int row = F.gw; row < nrows; row += F.NGW) {
        const int v = row < ML ? row / SEQ : 4;
        f32x4 x[8]; float ss = 0.f;
#pragma unroll
        for (int j = 0; j < 8; ++j) { x[j] = xn[j]; ss += (x[j].x * x[j].x + x[j].y * x[j].y) + (x[j].z * x[j].z + x[j].w * x[j].w); }
        { const int rn = row + F.NGW < nrows ? row + F.NGW : row; const f32x4* src = (const f32x4*)(X + (size_t)rn * DM) + F.lane;
#pragma unroll
          for (int j = 0; j < 8; ++j) xn[j] = __builtin_nontemporal_load(src + 64 * j); }
        const float rstd = 1.f / sqrtf(wave_sum(ss, F.lane) * (1.f / DM) + EPS);
        const f32x4* gn = (const f32x4*)(F.in[I_NORM2] + (size_t)l * DM) + F.lane;
        const f32x4* sh = (const f32x4*)(mod + ((size_t)l * 5 + v) * 12288 + 3 * DM) + F.lane;
        const f32x4* sc = (const f32x4*)(mod + ((size_t)l * 5 + v) * 12288 + 4 * DM) + F.lane;
        u32x2 hw[8];
#pragma unroll
        for (int j = 0; j < 8; ++j) { const f32x4 y = (x[j] * rstd) * gn[64 * j]; x[j] = y * (sc[64 * j] + 1.f) + sh[64 * j];
            hw[j].x = cvt_pk_bf16(x[j].x, x[j].y); hw[j].y = cvt_pk_bf16(x[j].z, x[j].w); }
        if (!moe) {
            u32x2* o = (u32x2*)(H + (size_t)row * DM) + F.lane;
#pragma unroll
            for (int j = 0; j < 8; ++j) o[64 * j] = hw[j];
        } else {
            float lg[8];
#pragma unroll
            for (int e = 0; e < 8; ++e) lg[e] = 0.f;
#pragma unroll
            for (int j = 0; j < 8; ++j) {
                const f32x4* rp = (const f32x4*)(router + (size_t)(4 * (F.lane + 64 * j)) * 8);
#pragma unroll
                for (int i = 0; i < 4; ++i) { const f32x4 r0 = rp[2 * i], r1 = rp[2 * i + 1]; const float xv = x[j][i];
                    lg[0] += xv * r0.x; lg[1] += xv * r0.y; lg[2] += xv * r0.z; lg[3] += xv * r0.w; lg[4] += xv * r1.x; lg[5] += xv * r1.y; lg[6] += xv * r1.z; lg[7] += xv * r1.w; }
            }
#pragma unroll
            for (int e = 0; e < 8; ++e) lg[e] = wave_sum(lg[e], F.lane);
            float v1 = lg[0]; int i1 = 0;
#pragma unroll
            for (int e = 1; e < 8; ++e) if (lg[e] > v1) { v1 = lg[e]; i1 = e; }
            float v2 = -3.0e38f; int i2 = -1;
#pragma unroll
            for (int e = 0; e < 8; ++e) if (e != i1 && lg[e] > v2) { v2 = lg[e]; i2 = e; }
            const float w2 = 1.f / (1.f + expf(v1 - v2)), w1 = 1.f - w2;
            int p1 = 0, p2 = 0;
            if (F.lane == 0) { p1 = (int)__hip_atomic_fetch_add(cnt + i1 * 64, 1u, __ATOMIC_RELAXED, __HIP_MEMORY_SCOPE_AGENT); p2 = (int)__hip_atomic_fetch_add(cnt + i2 * 64, 1u, __ATOMIC_RELAXED, __HIP_MEMORY_SCOPE_AGENT); }
            p1 = __builtin_amdgcn_readfirstlane(p1); p2 = __builtin_amdgcn_readfirstlane(p2);
            if (F.lane == 0) { int* ti = (int*)(F.ws + WS_TOK) + (size_t)row * 8; ti[0] = i1; ti[1] = p1; ti[2] = i2; ti[3] = p2; ti[4] = __float_as_int(w1); ti[5] = __float_as_int(w2); }
            u32x2* oa = (u32x2*)(H2S + ((size_t)i1 * CAP + p1) * DM) + F.lane;
            u32x2* ob = (u32x2*)(H2S + ((size_t)i2 * CAP + p2) * DM) + F.lane;
#pragma unroll
            for (int j = 0; j < 8; ++j) { oa[64 * j] = hw[j]; ob[64 * j] = hw[j]; }
        }
    }
}
__device__ __forceinline__ void phase_combine_transpose(const Frame& F0, int l) {
    Frame F = enter(F0);
    const bool last = (l == DEPTH - 1); const int nrows = last ? ML : MT;
    const unsigned* O = (const unsigned*)(F.ws + AR_O); bf16_t* YA = (bf16_t*)(F.ws + AR_YAN);
    const float lam = ((const float*)(F.ws + WS_LAM))[l];
    const float lam_init = 0.8f - 0.6f * expf(-0.3f * (float)l);
    const int c0 = 64 * (F.lane >> 4) + 2 * (F.lane & 15);
    const float* gs = F.in[I_SUBN] + l * 256;
    const float g00 = gs[c0], g01 = gs[c0 + 32], g10 = gs[c0 + 1], g11 = gs[c0 + 33];
    for (int it = F.gw; it < nrows * 8; it += F.NGW) {
        const int row = it >> 3, d = it & 7;
        const u32x2 a = __builtin_nontemporal_load((const u32x2*)(O + (size_t)row * 2048 + (2 * d) * 128) + F.lane), b = __builtin_nontemporal_load((const u32x2*)(O + (size_t)row * 2048 + (2 * d + 1) * 128) + F.lane);
        const float o00 = bf_lo(a.x) - lam * bf_lo(b.x), o01 = bf_hi(a.x) - lam * bf_hi(b.x), o10 = bf_lo(a.y) - lam * bf_lo(b.y), o11 = bf_hi(a.y) - lam * bf_hi(b.y);
        const float ss = wave_sum((o00 * o00 + o01 * o01) + (o10 * o10 + o11 * o11), F.lane);
        const float rstd = (1.f - lam_init) / sqrtf(ss * (1.f / 256.f) + EPS);
        bf16_t* yp = YA + (size_t)row * DM + d * 256 + c0;
        *(unsigned*)yp = cvt_pk_bf16(o00 * rstd * g00, o10 * rstd * g10);
        *(unsigned*)(yp + 32) = cvt_pk_bf16(o01 * rstd * g01, o11 * rstd * g11);
    }
    const bf16_t* YBT = (const bf16_t*)(F.ws + AR_YBT); bf16_t* YB = (bf16_t*)(F.ws + AR_YB);
    LAS bf16_t* scr = (LAS bf16_t*)(F.lds + F.wave * 16384);
    const int ntt = nrows / 64;
    for (int it = F.gw; it < 32 * ntt; it += F.NGW) {
        const int cb = it / ntt, tb = it % ntt;
#pragma unroll
        for (int i = 0; i < 8; ++i) { const int c = 8 * i + (F.lane >> 3), tq = F.lane & 7;
            const u32x4 w = *(const u32x4*)(YBT + (size_t)(cb * 64 + c) * MT + tb * 64 + tq * 8);
            LAS unsigned* d = (LAS unsigned*)(scr + c * 66 + tq * 8); d[0] = w.x; d[1] = w.y; d[2] = w.z; d[3] = w.w; }
        LDS_WAIT(); asm volatile("" ::: "memory");
#pragma unroll
        for (int i = 0; i < 8; ++i) { const int t = 8 * i + (F.lane >> 3), cq = F.lane & 7;
            unsigned short e[8];
#pragma unroll
            for (int k = 0; k < 8; ++k) e[k] = scr[(cq * 8 + k) * 66 + t];
            u32x4 o; o.x = e[0] | ((unsigned)e[1] << 16); o.y = e[2] | ((unsigned)e[3] << 16); o.z = e[4] | ((unsigned)e[5] << 16); o.w = e[6] | ((unsigned)e[7] << 16);
            *(u32x4*)(YB + (size_t)(tb * 64 + t) * DM + cb * 64 + cq * 8) = o; }
        LDS_WAIT(); asm volatile("" ::: "memory");
    }
}

namespace hy {
constexpr int UST = 4616, UBYTES = 4 * UST * 2, RLEN = 8704, RBYTES = RLEN * 2, CH_BYTES = UBYTES + RBYTES;
__device__ __forceinline__ int crow(int r, int hi) { return (r & 3) + 8 * (r >> 2) + 4 * hi; }

__device__ __forceinline__ void conv_pass(const LAS unsigned char* U, const LAS unsigned char* R, int j0, int lane, f32x16 (&acc)[4]) {
    const int n = lane & 31, hi = lane >> 5, b = n & 3, qp = n >> 2;
#pragma unroll
    for (int j = 0; j < 4; ++j) acc[j] = f32x16{};
    const int xl = 4352 - n + 8 * hi - 256 * j0 - 768;
    const unsigned sh = (unsigned)(xl & 1) << 4;
    const int ub = (b * UST + 256 + 32 * qp + 8 * hi) * 2;
#ifndef HY_PF
#define HY_PF 1
#endif
    for (int dp = 0; dp < 16; ++dp) {
        const LAS unsigned char* pG = U + ub - 32 * dp;
        const LAS unsigned* pA = (const LAS unsigned*)R + ((xl - 16 * dp) >> 1);
        bf16x8 Gw[6];
        unsigned ra[HY_PF + 1][5];
#pragma unroll
        for (int p = 0; p < HY_PF; ++p) {
            Gw[p] = *(const LAS bf16x8*)(pG + 512 * p);
#pragma unroll
            for (int k = 0; k < 5; ++k) ra[p][k] = pA[128 * p + k];
        }
#pragma unroll
        for (int e2 = 0; e2 < 20; ++e2) {
            if (e2 + HY_PF < 20) {
#pragma unroll
                for (int k = 0; k < 5; ++k) ra[(e2 + HY_PF) % (HY_PF + 1)][k] = pA[128 * (e2 + HY_PF) + k];
                if (e2 + HY_PF <= 16) Gw[(e2 + HY_PF) % 6] = *(const LAS bf16x8*)(pG + 512 * (e2 + HY_PF));
            }
            const unsigned (&rc)[5] = ra[e2 % (HY_PF + 1)];
            u32x4 w; w.x = __builtin_amdgcn_alignbit(rc[1], rc[0], sh); w.y = __builtin_amdgcn_alignbit(rc[2], rc[1], sh); w.z = __builtin_amdgcn_alignbit(rc[3], rc[2], sh); w.w = __builtin_amdgcn_alignbit(rc[4], rc[3], sh);
            const bf16x8 A = *reinterpret_cast<const bf16x8*>(&w);
#pragma unroll
            for (int j = 0; j < 4; ++j) { const int J = j + e2 - 3; if (J >= 0 && J <= 16) acc[j] = __builtin_amdgcn_mfma_f32_32x32x16_bf16(A, Gw[J % 6], acc[j], 0, 0, 0); }
            __builtin_amdgcn_sched_barrier(0);
        }
    }
}

__device__ __forceinline__ void conv4(const bf16_t* seq, int s0, int Ls, float w0, float w1, float w2, float bb, float (&y)[4]) {
    const u32x2 w = *(const u32x2*)(seq + s0);
    const float l = s0 > 0 ? bf2f(seq[s0 - 1]) : 0.f, r = (s0 + 4 < Ls) ? bf2f(seq[s0 + 4]) : 0.f;
    const float x0 = bf_lo(w.x), x1 = bf_hi(w.x), x2 = bf_lo(w.y), x3 = bf_hi(w.y);
    y[0] = l * w0 + x0 * w1 + x1 * w2 + bb; y[1] = x0 * w0 + x1 * w1 + x2 * w2 + bb; y[2] = x1 * w0 + x2 * w1 + x3 * w2 + bb; y[3] = x2 * w0 + x3 * w1 + r * w2 + bb;
}
__device__ __forceinline__ u32x4 conv8_pk(const bf16_t* seq, int s0, int Ls, float w0, float w1, float w2, float bb) {
    const u32x4 w = *(const u32x4*)(seq + s0);
    const float left = s0 > 0 ? bf2f(seq[s0 - 1]) : 0.f, right = (s0 + 8 < Ls) ? bf2f(seq[s0 + 8]) : 0.f;
    const float xv[10] = {left, bf_lo(w.x), bf_hi(w.x), bf_lo(w.y), bf_hi(w.y), bf_lo(w.z), bf_hi(w.z), bf_lo(w.w), bf_hi(w.w), right};
    float y[8];
#pragma unroll
    for (int k = 0; k < 8; ++k) y[k] = xv[k] * w0 + xv[k + 1] * w1 + xv[k + 2] * w2 + bb;
    u32x4 o; o.x = cvt_pk_bf16(y[0], y[1]); o.y = cvt_pk_bf16(y[2], y[3]); o.z = cvt_pk_bf16(y[4], y[5]); o.w = cvt_pk_bf16(y[6], y[7]); return o;
}
typedef unsigned u32x4_a4 __attribute__((ext_vector_type(4), aligned(4)));
__device__ __forceinline__ u32x4 conv4_load(const bf16_t* seq, int s0) { const u32x4_a4 w = *(const u32x4_a4*)(seq + s0 - 2); return (u32x4){w.x, w.y, w.z, w.w}; }
__device__ __forceinline__ void conv4_eval(const u32x4 w, int s0, int Ls, float w0, float w1, float w2, float bb, float (&y)[4]) {
    const float l = s0 > 0 ? bf_hi(w.x) : 0.f, r = (s0 + 4 < Ls) ? bf_lo(w.w) : 0.f;
    const float x0 = bf_lo(w.y), x1 = bf_hi(w.y), x2 = bf_lo(w.z), x3 = bf_hi(w.z);
    y[0] = l * w0 + x0 * w1 + x1 * w2 + bb; y[1] = x0 * w0 + x1 * w1 + x2 * w2 + bb; y[2] = x1 * w0 + x2 * w1 + x3 * w2 + bb; y[3] = x2 * w0 + x3 * w1 + r * w2 + bb;
}
struct Conv8Raw { u32x4 w; unsigned lw, rw; };
__device__ __forceinline__ Conv8Raw conv8_load(const bf16_t* seq, int s0) { Conv8Raw r; r.w = *(const u32x4*)(seq + s0); r.lw = *(const unsigned*)(seq + s0 - 2); r.rw = *(const unsigned*)(seq + s0 + 8); return r; }
__device__ __forceinline__ u32x4 conv8_eval(const Conv8Raw& q, int s0, int Ls, float w0, float w1, float w2, float bb) {
    const u32x4 w = q.w;
    const float left = s0 > 0 ? bf_hi(q.lw) : 0.f, right = (s0 + 8 < Ls) ? bf_lo(q.rw) : 0.f;
    const float xv[10] = {left, bf_lo(w.x), bf_hi(w.x), bf_lo(w.y), bf_hi(w.y), bf_lo(w.z), bf_hi(w.z), bf_lo(w.w), bf_hi(w.w), right};
    float y[8];
#pragma unroll
    for (int k = 0; k < 8; ++k) y[k] = xv[k] * w0 + xv[k + 1] * w1 + xv[k + 2] * w2 + bb;
    u32x4 o; o.x = cvt_pk_bf16(y[0], y[1]); o.y = cvt_pk_bf16(y[2], y[3]); o.z = cvt_pk_bf16(y[4], y[5]); o.w = cvt_pk_bf16(y[6], y[7]); return o;
}
struct ConvW { float w0, w1, w2, bb; };
__device__ __forceinline__ ConvW conv_w(const Frame& F, int l, int cc) {
    ConvW w; w.w0 = F.in[I_HCW][((size_t)l * 3 + 0) * HYW + cc]; w.w1 = F.in[I_HCW][((size_t)l * 3 + 1) * HYW + cc]; w.w2 = F.in[I_HCW][((size_t)l * 3 + 2) * HYW + cc]; w.bb = F.in[I_HCB][(size_t)l * HYW + cc]; return w;
}

__device__ __forceinline__ void pair_body(Frame& F, int l, int c0, bool first) {
    const int tidq = opaque(F.tid); const int ch = F.wave >> 2, j0 = 4 * (F.wave & 3), c = c0 + ch, ltid = tidq & 255, lane = tidq & 63;
    LAS unsigned char* U = F.lds + ch * CH_BYTES; LAS unsigned char* R = U + UBYTES;
    const bf16_t* uT = (const bf16_t*)(F.ws + AR_UT);
    const bf16_t* vrow = uT + (size_t)c * MT, *x1row = uT + (size_t)(2048 + c) * MT, *x2row = uT + (size_t)(4096 + c) * MT;
    const bf16_t* Rg = (const bf16_t*)(F.ws + WS_R) + (((size_t)l * 2 + 0) * 2048 + c) * RLEN;
    const bf16_t* Rg2 = (const bf16_t*)(F.ws + WS_R) + (((size_t)l * 2 + 1) * 2048 + c) * RLEN;
    const float bias0 = F.in[I_HBIAS][((size_t)l * 2 + 0) * 2048 + c], bias1 = F.in[I_HBIAS][((size_t)l * 2 + 1) * 2048 + c];
    if (first) {
        for (int i = ltid; i < 4 * 65; i += 256) { const int b = i / 65, k = i % 65; const int el = k < 32 ? k * 8 : 4352 + (k - 32) * 8;
            *(LAS u32x4*)(U + (b * UST + el) * 2) = (u32x4){0u, 0u, 0u, 0u}; }
    }
    { const ConvW cw = conv_w(F, l, c); Conv8Raw raw[8];
#pragma unroll
      for (int k = 0; k < 8; ++k) { const int q = ltid + 256 * k, tok = 8 * q, b = tok >> 12, s = tok & 4095; raw[k] = conv8_load(vrow + b * SEQ, s); }
#pragma unroll
      for (int k = 0; k < 8; ++k) { const int q = ltid + 256 * k, tok = 8 * q, b = tok >> 12, s = tok & 4095;
        *(LAS u32x4*)(U + (b * UST + 256 + s) * 2) = conv8_eval(raw[k], s, SEQ, cw.w0, cw.w1, cw.w2, cw.bb); } }
    { u32x4 rr[5];
#pragma unroll
      for (int k = 0; k < 5; ++k) { const int q = ltid + 256 * k; if (q < RBYTES / 16) rr[k] = *(const u32x4*)((const char*)Rg + q * 16); }
#pragma unroll
      for (int k = 0; k < 5; ++k) { const int q = ltid + 256 * k; if (q < RBYTES / 16) *(LAS u32x4*)(R + q * 16) = rr[k]; } }
    __syncthreads();
    f32x16 acc[4];
    conv_pass(U, R, j0, lane, acc);
    const int n = lane & 31, hi = lane >> 5, b = n & 3, qp = n >> 2;
    u32x2 zp[4][4];
    { const ConvW cw = conv_w(F, l, 2048 + c); u32x4 xr[4][4];
#pragma unroll
    for (int j = 0; j < 4; ++j)
#pragma unroll
        for (int g = 0; g < 4; ++g) xr[j][g] = conv4_load(x1row + b * SEQ, 32 * (8 * (j0 + j) + qp) + 8 * g + 4 * hi);
#pragma unroll
    for (int j = 0; j < 4; ++j)
#pragma unroll
        for (int g = 0; g < 4; ++g) {
            const int t0 = 32 * (8 * (j0 + j) + qp) + 8 * g + 4 * hi;
            const u32x2 vv = *(const LAS u32x2*)(U + (b * UST + 256 + t0) * 2);
            float xx[4]; conv4_eval(xr[j][g], t0, SEQ, cw.w0, cw.w1, cw.w2, cw.bb, xx);
            const float z0 = xx[0] * (acc[j][4 * g + 0] + bias0 * bf_lo(vv.x)), z1 = xx[1] * (acc[j][4 * g + 1] + bias0 * bf_hi(vv.x));
            const float z2 = xx[2] * (acc[j][4 * g + 2] + bias0 * bf_lo(vv.y)), z3 = xx[3] * (acc[j][4 * g + 3] + bias0 * bf_hi(vv.y));
            zp[j][g].x = cvt_pk_bf16(z0, z1); zp[j][g].y = cvt_pk_bf16(z2, z3);
        } }
    __syncthreads();
#pragma unroll
    for (int j = 0; j < 4; ++j)
#pragma unroll
        for (int g = 0; g < 4; ++g) { const int t0 = 32 * (8 * (j0 + j) + qp) + 8 * g + 4 * hi; *(LAS u32x2*)(U + (b * UST + 256 + t0) * 2) = zp[j][g]; }
    { u32x4 rr[5];
#pragma unroll
      for (int k = 0; k < 5; ++k) { const int q = ltid + 256 * k; if (q < RBYTES / 16) rr[k] = *(const u32x4*)((const char*)Rg2 + q * 16); }
#pragma unroll
      for (int k = 0; k < 5; ++k) { const int q = ltid + 256 * k; if (q < RBYTES / 16) *(LAS u32x4*)(R + q * 16) = rr[k]; } }
    __syncthreads();
    conv_pass(U, R, j0, lane, acc);
    bf16_t* yrow = (bf16_t*)(F.ws + AR_YBT) + (size_t)c * MT;
    { const ConvW cw = conv_w(F, l, 4096 + c); u32x4 xr[4][4];
#pragma unroll
    for (int j = 0; j < 4; ++j)
#pragma unroll
        for (int g = 0; g < 4; ++g) xr[j][g] = conv4_load(x2row + b * SEQ, 32 * (8 * (j0 + j) + qp) + 8 * g + 4 * hi);
#pragma unroll
    for (int j = 0; j < 4; ++j)
#pragma unroll
        for (int g = 0; g < 4; ++g) {
            const int t0 = 32 * (8 * (j0 + j) + qp) + 8 * g + 4 * hi;
            const u32x2 zz = *(const LAS u32x2*)(U + (b * UST + 256 + t0) * 2);
            float xx[4]; conv4_eval(xr[j][g], t0, SEQ, cw.w0, cw.w1, cw.w2, cw.bb, xx);
            const float y0 = xx[0] * (acc[j][4 * g + 0] + bias1 * bf_lo(zz.x)), y1 = xx[1] * (acc[j][4 * g + 1] + bias1 * bf_hi(zz.x));
            const float y2 = xx[2] * (acc[j][4 * g + 2] + bias1 * bf_lo(zz.y)), y3 = xx[3] * (acc[j][4 * g + 3] + bias1 * bf_hi(zz.y));
            u32x2 o; o.x = cvt_pk_bf16(y0, y1); o.y = cvt_pk_bf16(y2, y3);
            *(u32x2*)(yrow + b * SEQ + t0) = o;
        } }
    __syncthreads();
}
constexpr int UCST = 776, UCBYTES = 4 * UCST * 2;
__device__ __forceinline__ f32x16 ctx_conv_pass(const LAS unsigned char* U, const LAS unsigned char* R, int lane) {
    const int n = lane & 31, hi = lane >> 5, b = n & 3, qp = n >> 2;
    f32x16 acc = f32x16{};
    const int xl = 512 + 240 - n + 8 * hi;
    const unsigned sh = (unsigned)(xl & 1) << 4;
    const LAS unsigned* pA = (const LAS unsigned*)R + (xl >> 1);
    const LAS unsigned char* pG = U + (b * UCST + 256 + 240 + 32 * qp + 8 * hi) * 2;
#pragma unroll
    for (int e = 0; e < 31; ++e) {
        const LAS unsigned* p = pA - 8 * e;
        const unsigned d0 = p[0], d1 = p[1], d2 = p[2], d3 = p[3], d4 = p[4];
        u32x4 w; w.x = __builtin_amdgcn_alignbit(d1, d0, sh); w.y = __builtin_amdgcn_alignbit(d2, d1, sh); w.z = __builtin_amdgcn_alignbit(d3, d2, sh); w.w = __builtin_amdgcn_alignbit(d4, d3, sh);
        const bf16x8 G = *(const LAS bf16x8*)(pG - 32 * e);
        acc = __builtin_amdgcn_mfma_f32_32x32x16_bf16(*reinterpret_cast<const bf16x8*>(&w), G, acc, 0, 0, 0);
    }
    return acc;
}
__device__ __forceinline__ void ctx_body(Frame& F, int l, int c) {
    const int lane = opaque(F.tid) & 63;
    LAS unsigned char* U = F.lds + F.wave * 16384; LAS unsigned char* R = U + UCBYTES;
    const bf16_t* uT = (const bf16_t*)(F.ws + AR_UT);
    const bf16_t* vrow = uT + (size_t)c * MT + ML, *x1row = uT + (size_t)(2048 + c) * MT + ML, *x2row = uT + (size_t)(4096 + c) * MT + ML;
    const bf16_t* R1 = (const bf16_t*)(F.ws + WS_RC) + (((size_t)l * 2 + 0) * 2048 + c) * 1024, *R2 = (const bf16_t*)(F.ws + WS_RC) + (((size_t)l * 2 + 1) * 2048 + c) * 1024;
    const float bias0 = F.in[I_HBIAS][((size_t)l * 2 + 0) * 2048 + c], bias1 = F.in[I_HBIAS][((size_t)l * 2 + 1) * 2048 + c];
    for (int i = lane; i < 4 * 65; i += 64) { const int b = i / 65, k = i % 65; const int el = k < 32 ? k * 8 : 512 + (k - 32) * 8;
        *(LAS u32x4*)(U + (b * UCST + el) * 2) = (u32x4){0u, 0u, 0u, 0u}; }
    { const ConvW cw = conv_w(F, l, c);
#pragma unroll
      for (int k = 0; k < 2; ++k) { const int q = lane + 64 * k, b = q >> 5, s = (q & 31) * 8;
        *(LAS u32x4*)(U + (b * UCST + 256 + s) * 2) = conv8_pk(vrow + b * LC, s, LC, cw.w0, cw.w1, cw.w2, cw.bb); } }
#pragma unroll
    for (int k = 0; k < 2; ++k) *(LAS u32x4*)(R + (lane + 64 * k) * 16) = *(const u32x4*)((const char*)R1 + (lane + 64 * k) * 16);
    LDS_WAIT(); asm volatile("" ::: "memory");
    f32x16 acc = ctx_conv_pass(U, R, lane);
    const int n = lane & 31, hi = lane >> 5, b = n & 3, qp = n >> 2;
    u32x2 zp[4];
    { const ConvW cw = conv_w(F, l, 2048 + c);
#pragma unroll
      for (int g = 0; g < 4; ++g) { const int t0 = 32 * qp + 8 * g + 4 * hi;
        const u32x2 vv = *(const LAS u32x2*)(U + (b * UCST + 256 + t0) * 2);
        float xx[4]; conv4(x1row + b * LC, t0, LC, cw.w0, cw.w1, cw.w2, cw.bb, xx);
        zp[g].x = cvt_pk_bf16(xx[0] * (acc[4 * g + 0] + bias0 * bf_lo(vv.x)), xx[1] * (acc[4 * g + 1] + bias0 * bf_hi(vv.x)));
        zp[g].y = cvt_pk_bf16(xx[2] * (acc[4 * g + 2] + bias0 * bf_lo(vv.y)), xx[3] * (acc[4 * g + 3] + bias0 * bf_hi(vv.y))); } }
    LDS_WAIT(); asm volatile("" ::: "memory");
#pragma unroll
    for (int g = 0; g < 4; ++g) { const int t0 = 32 * qp + 8 * g + 4 * hi; *(LAS u32x2*)(U + (b * UCST + 256 + t0) * 2) = zp[g]; }
#pragma unroll
    for (int k = 0; k < 2; ++k) *(LAS u32x4*)(R + (lane + 64 * k) * 16) = *(const u32x4*)((const char*)R2 + (lane + 64 * k) * 16);
    LDS_WAIT(); asm volatile("" ::: "memory");
    acc = ctx_conv_pass(U, R, lane);
    bf16_t* yrow = (bf16_t*)(F.ws + AR_YBT) + (size_t)c * MT + ML;
    { const ConvW cw = conv_w(F, l, 4096 + c);
#pragma unroll
      for (int g = 0; g < 4; ++g) { const int t0 = 32 * qp + 8 * g + 4 * hi;
        const u32x2 zz = *(const LAS u32x2*)(U + (b * UCST + 256 + t0) * 2);
        float xx[4]; conv4(x2row + b * LC, t0, LC, cw.w0, cw.w1, cw.w2, cw.bb, xx);
        u32x2 o; o.x = cvt_pk_bf16(xx[0] * (acc[4 * g + 0] + bias1 * bf_lo(zz.x)), xx[1] * (acc[4 * g + 1] + bias1 * bf_hi(zz.x)));
        o.y = cvt_pk_bf16(xx[2] * (acc[4 * g + 2] + bias1 * bf_lo(zz.y)), xx[3] * (acc[4 * g + 3] + bias1 * bf_hi(zz.y)));
        *(u32x2*)(yrow + b * LC + t0) = o; } }
    LDS_WAIT(); asm volatile("" ::: "memory");
}
}

__device__ __forceinline__ void phase_mixers(const Frame& F0, int l) {
    Frame F = enter(F0);
    const bool last = (l == DEPTH - 1);
    const bf16_t* Q = (const bf16_t*)(F.ws + AR_Q); const bf16_t* Kc = (const bf16_t*)(F.ws + AR_KC); const bf16_t* Vc = (const bf16_t*)(F.ws + AR_VC); unsigned* O = (unsigned*)(F.ws + AR_O);
#ifndef NO_ATT
    const int nitems = NB * 16 * 16 + (last ? 0 : NB * 16);
    const int nrep_a = (PROBE == 1) ? 2 : 1;
    for (int itx = F.bid; itx < nitems * nrep_a; itx += F.G) { const int it = itx % nitems;
        int h, b, seq; size_t row0;
        if (it < 1024) {
            const int x = it & 7, rk = (it >> 3) & 31, qb = rk & 15; h = 2 * x + (rk >> 4); b = it >> 8; row0 = (size_t)b * SEQ + qb * 256; seq = SKV; }
        else { const int i2 = it - 1024; h = i2 & 15; b = i2 >> 4; row0 = (size_t)ML + b * LC; seq = LC; }
        att::attn_dense_body(Q + row0 * DM + h * 128, Kc + (size_t)b * SKV * DM + h * 128, Vc + (size_t)b * SKV * DM + (h >> 1) * 256, O + row0 * 2048 + h * 128, seq, F.ldsg, F.wave);
        __syncthreads();
    }
#endif
#ifndef NO_HY
    bool first = true;
    const int nrep_h = (PROBE == 2) ? 2 : 1;
    for (int itx = F.bid; itx < 1024 * nrep_h; itx += F.G) { const int it = itx & 1023; hy::pair_body(F, l, 2 * it, first); first = false; }
#ifndef NO_HYC
    if (!last) for (int cx = F.gw; cx < 2048 * ((PROBE == 9) ? 2 : 1); cx += F.NGW) { const int c = cx & 2047; hy::ctx_body(F, l, c); }
#endif
#endif
}

using pg8::Unit;
constexpr int HALF = 128;
struct EpiBf16Plain {
    static constexpr bool PERM = true, CARRY = false;
    bf16_t* O; int ldc;
    __device__ __forceinline__ void operator()(const f32x4 (&acc)[2][2][4][2], const Unit& u, int wr, int wc, int fr, int fq) const {
        const int row0 = u.pm * 256 + wr * 64 + fr, col0 = u.pn * 256 + wc * 32 + 8 * fq;
#pragma unroll
        for (int ai = 0; ai < 2; ++ai)
#pragma unroll
            for (int m = 0; m < 4; ++m) { bf16_t* rowp = O + (size_t)(row0 + ai * HALF + m * 16) * ldc + col0;
#pragma unroll
                for (int bj = 0; bj < 2; ++bj) { const f32x4 v0 = acc[ai][bj][m][0], v1 = acc[ai][bj][m][1];
                    u32x4 w; w.x = cvt_pk_bf16(v0[0], v0[1]); w.y = cvt_pk_bf16(v0[2], v0[3]); w.z = cvt_pk_bf16(v1[0], v1[1]); w.w = cvt_pk_bf16(v1[2], v1[3]);
                    __builtin_nontemporal_store(w, (u32x4*)(rowp + bj * HALF)); } }
    }
};
struct EpiInProj {
    static constexpr bool PERM = true, CARRY = false;
    bf16_t *Q, *K, *V, *G; const float* bgate; const float* qgain; const float* kgain; const LAS float* rope; LAS unsigned char* lds;
    __device__ __forceinline__ void operator()(const f32x4 (&acc)[2][2][4][2], const Unit& u, int wr, int wc, int fr, int fq) const {
        const int pn = u.pn;
        if (pn < 16) {
            const bool isk = pn >= 8; const bool lat = u.pm < 64;
            LAS float* P = (LAS float*)lds;
#pragma unroll
            for (int ai = 0; ai < 2; ++ai)
#pragma unroll
                for (int m = 0; m < 4; ++m)
#pragma unroll
                    for (int bj = 0; bj < 2; ++bj) { const f32x4 a = acc[ai][bj][m][0], b = acc[ai][bj][m][1];
                        float ss = (a[0] * a[0] + a[1] * a[1]) + (a[2] * a[2] + a[3] * a[3]) + (b[0] * b[0] + b[1] * b[1]) + (b[2] * b[2] + b[3] * b[3]);
                        ss += shx(ss, 16, fr + 16 * fq); ss += shx(ss, 32, fr + 16 * fq);
                        if (fq == 0) P[((wr * 2 + bj) * 128 + ai * 64 + m * 16 + fr) * 4 + wc] = ss; }
            asm volatile("s_waitcnt lgkmcnt(0)" ::: "memory"); __builtin_amdgcn_s_barrier(); asm volatile("" ::: "memory");
            const int axis = wc >> 1, f0 = 16 * (wc & 1) + 4 * fq, d0 = 64 * axis + f0;
            const float* gp = isk ? kgain : qgain;
            const f32x4 g0 = *(const f32x4*)(gp + d0), g1 = *(const f32x4*)(gp + d0 + 32);
            const int rowt = isk ? (lat ? (u.pm >> 4) * SKV + LC + (u.pm & 15) * 256 : (u.pm - 64) * SKV) : u.pm * 256;
            bf16_t* base = (isk ? K : Q) + (size_t)(rowt + wr * 64 + fr) * DM + (isk ? pn - 8 : pn) * 256 + wc * 32 + 8 * fq;
#pragma unroll
            for (int ai = 0; ai < 2; ++ai)
#pragma unroll
                for (int m = 0; m < 4; ++m) {
                    f32x4 cs = (f32x4){1.f, 1.f, 1.f, 1.f}, sn = (f32x4){0.f, 0.f, 0.f, 0.f};
                    if (lat) { const int pos = axis ? (16 * m + fr) : (4 * (u.pm & 15) + 2 * ai + wr); cs = *(const LAS f32x4*)(rope + pos * 32 + f0); sn = *(const LAS f32x4*)(rope + 2048 + pos * 32 + f0); }
#pragma unroll
                    for (int bj = 0; bj < 2; ++bj) {
                        const f32x4 pp = *(const LAS f32x4*)(P + ((wr * 2 + bj) * 128 + ai * 64 + m * 16 + fr) * 4);
                        const float rstd = __builtin_amdgcn_rsqf(((pp[0] + pp[1]) + (pp[2] + pp[3])) * (1.f / 128.f) + EPS);
                        const f32x4 a = (acc[ai][bj][m][0] * rstd) * g0, b = (acc[ai][bj][m][1] * rstd) * g1;
                        const f32x4 ra = a * cs - b * sn, rb = a * sn + b * cs;
                        u32x4 w; w.x = cvt_pk_bf16(ra[0], ra[1]); w.y = cvt_pk_bf16(ra[2], ra[3]); w.z = cvt_pk_bf16(rb[0], rb[1]); w.w = cvt_pk_bf16(rb[2], rb[3]);
                        *(u32x4*)(base + (size_t)(ai * HALF + m * 16) * DM + bj * HALF) = w; } }
            return;
        }
        bf16_t* basep; int ldc = DM, colt; int rowt = u.pm * 256; const bool gate = pn >= 24;
        if (pn < 24) { basep = V; colt = (pn - 16) * 256; rowt = u.pm < 64 ? (u.pm >> 4) * SKV + LC + (u.pm & 15) * 256 : (u.pm - 64) * SKV; }
        else { basep = G; colt = (pn - 24) * 256; ldc = 4096; }
        const int row0 = rowt + wr * 64 + fr, col0 = colt + wc * 32 + 8 * fq;
        f32x4 bv[2][2];
#pragma unroll
        for (int bj = 0; bj < 2; ++bj)
#pragma unroll
            for (int n = 0; n < 2; ++n) bv[bj][n] = gate ? *(const f32x4*)(bgate + col0 + bj * HALF + 4 * n) : (f32x4){0.f, 0.f, 0.f, 0.f};
#pragma unroll
        for (int ai = 0; ai < 2; ++ai)
#pragma unroll
            for (int m = 0; m < 4; ++m) { bf16_t* rowp = basep + (size_t)(row0 + ai * HALF + m * 16) * ldc + col0;
#pragma unroll
                for (int bj = 0; bj < 2; ++bj) { f32x4 v0 = acc[ai][bj][m][0] + bv[bj][0], v1 = acc[ai][bj][m][1] + bv[bj][1];
                    if (gate) { v0 = v0 * -1.4426950408889634f; v1 = v1 * -1.4426950408889634f;
#pragma unroll
                        for (int i = 0; i < 4; ++i) { v0[i] = __builtin_amdgcn_exp2f(v0[i]); v1[i] = __builtin_amdgcn_exp2f(v1[i]); }
                        v0 = v0 + 1.f; v1 = v1 + 1.f;
#pragma unroll
                        for (int i = 0; i < 4; ++i) { v0[i] = __builtin_amdgcn_rcpf(v0[i]); v1[i] = __builtin_amdgcn_rcpf(v1[i]); } }
                    u32x4 w; w.x = cvt_pk_bf16(v0[0], v0[1]); w.y = cvt_pk_bf16(v0[2], v0[3]); w.z = cvt_pk_bf16(v1[0], v1[1]); w.w = cvt_pk_bf16(v1[2], v1[3]);
                    *(u32x4*)(rowp + bj * HALF) = w; } }
    }
};
struct EpiMergePair {
    static constexpr bool PERM = true, CARRY = true;
    const bf16_t* gates; bf16_t* Mo;
    __device__ __forceinline__ bool carry(f32x4 (&acc)[2][2][4][2], const Unit& u, int wr, int wc, int fr, int fq) const {
        const int row0 = u.pm * 256 + wr * 64 + fr, col0 = u.pn * 256 + wc * 32 + 8 * fq;
        const bf16_t* gbase = gates + (size_t)row0 * 4096 + col0;
#define MP_ROW(i) ((size_t)((((i) >> 3) * HALF) + (((i) >> 1) & 3) * 16))
#define MP_G(i, off) (*(const u32x4*)(gbase + MP_ROW(i) * 4096 + ((i) & 1) * HALF + (off)))
#define MP_UNPK(WV, FV) const float FV[8] = {bf_lo(WV.x), bf_hi(WV.x), bf_lo(WV.y), bf_hi(WV.y), bf_lo(WV.z), bf_hi(WV.z), bf_lo(WV.w), bf_hi(WV.w)}
        if (u.kind == 0) {
            u32x4 ga_[2][4], gb_[2][4];
#pragma unroll
            for (int k = 0; k < 4; ++k) { ga_[0][k] = MP_G(k, 0); gb_[0][k] = MP_G(k, DM); }
#pragma unroll
            for (int b = 0; b < 4; ++b) {
                if (b + 1 < 4) {
#pragma unroll
                    for (int k = 0; k < 4; ++k) { ga_[(b + 1) & 1][k] = MP_G(4 * (b + 1) + k, 0); gb_[(b + 1) & 1][k] = MP_G(4 * (b + 1) + k, DM); } }
#pragma unroll
                for (int k = 0; k < 4; ++k) { const int i = 4 * b + k, ai = i >> 3, m = (i >> 1) & 3, bj = i & 1;
                    MP_UNPK(ga_[b & 1][k], ga); MP_UNPK(gb_[b & 1][k], gb);
#pragma unroll
                    for (int e = 0; e < 4; ++e) { acc[ai][bj][m][0][e] *= ga[e] * __builtin_amdgcn_rcpf(gb[e]); acc[ai][bj][m][1][e] *= ga[4 + e] * __builtin_amdgcn_rcpf(gb[4 + e]); } }
            }
            return true;
        }
        u32x4 gb_[2][4];
#pragma unroll
        for (int k = 0; k < 4; ++k) gb_[0][k] = MP_G(k, DM);
        bf16_t* mbase = Mo + (size_t)row0 * DM + col0;
#pragma unroll
        for (int b = 0; b < 4; ++b) {
            if (b + 1 < 4) {
#pragma unroll
                for (int k = 0; k < 4; ++k) gb_[(b + 1) & 1][k] = MP_G(4 * (b + 1) + k, DM); }
#pragma unroll
            for (int k = 0; k < 4; ++k) { const int i = 4 * b + k, ai = i >> 3, m = (i >> 1) & 3, bj = i & 1;
                MP_UNPK(gb_[b & 1][k], gb); const f32x4 v0 = acc[ai][bj][m][0], v1 = acc[ai][bj][m][1];
                u32x4 w; w.x = cvt_pk_bf16(v0[0] * gb[0], v0[1] * gb[1]); w.y = cvt_pk_bf16(v0[2] * gb[2], v0[3] * gb[3]); w.z = cvt_pk_bf16(v1[0] * gb[4], v1[1] * gb[5]); w.w = cvt_pk_bf16(v1[2] * gb[6], v1[3] * gb[7]);
                *(u32x4*)(mbase + MP_ROW(i) * DM + bj * HALF) = w; }
        }
        return false;
#undef MP_ROW
#undef MP_G
#undef MP_UNPK
    }
};
struct EpiInProjDual {
    static constexpr bool PERM = true, CARRY = false;
    EpiInProj e1; EpiBf16Plain e2;
    __device__ __forceinline__ void operator()(const f32x4 (&acc)[2][2][4][2], const Unit& u, int wr, int wc, int fr, int fq) const { if (u.kind == 0) e1(acc, u, wr, wc, fr, fq); else e2(acc, u, wr, wc, fr, fq); }
};
struct EpiOut {
    static constexpr bool PERM = false, CARRY = false;
    float* X; const float* mod_l;
    __device__ __forceinline__ void operator()(const f32x4 (&acc)[2][2][4][2], const Unit& u, int wr, int wc, int fr, int fq) const {
        const int row0 = u.pm * 256 + wr * 64 + fr, col0 = u.pn * 256 + wc * 32 + 4 * fq;
        const int v = u.pm < 64 ? (u.pm >> 4) : 4; const float* g1 = mod_l + (size_t)v * 12288 + 2 * DM;
        f32x4 gv[2][2];
#pragma unroll
        for (int bj = 0; bj < 2; ++bj)
#pragma unroll
            for (int n = 0; n < 2; ++n) gv[bj][n] = *(const f32x4*)(g1 + col0 + bj * HALF + n * 16);
        float* base = X + (size_t)row0 * DM + col0;
        f32x4 xa[8], xb[8];
#define EO_P(b, c, bj, n) ((f32x4*)(base + (size_t)((((2 * (b) + (c)) >> 2) * HALF) + ((2 * (b) + (c)) & 3) * 16) * DM + (bj) * HALF + (n) * 16))
#define EO_LOAD(b, dst) do { _Pragma("unroll") for (int c = 0; c < 2; ++c) _Pragma("unroll") for (int bj = 0; bj < 2; ++bj) _Pragma("unroll") for (int n = 0; n < 2; ++n) dst[c * 4 + bj * 2 + n] = *EO_P(b, c, bj, n); } while (0)
#define EO_STORE(b, src) do { _Pragma("unroll") for (int c = 0; c < 2; ++c) _Pragma("unroll") for (int bj = 0; bj < 2; ++bj) _Pragma("unroll") for (int n = 0; n < 2; ++n) \
        *EO_P(b, c, bj, n) = src[c * 4 + bj * 2 + n] + gv[bj][n] * acc[(2 * (b) + c) >> 2][bj][(2 * (b) + c) & 3][n]; } while (0)
        EO_LOAD(0, xa);
        EO_LOAD(1, xb); EO_STORE(0, xa);
        EO_LOAD(2, xa); EO_STORE(1, xb);
        EO_LOAD(3, xb); EO_STORE(2, xa);
        EO_STORE(3, xb);
#undef EO_P
#undef EO_LOAD
#undef EO_STORE
    }
};
struct EpiDownSlab {
    static constexpr bool PERM = false, CARRY = false;
    float* YSC;
    __device__ __forceinline__ void operator()(const f32x4 (&acc)[2][2][4][2], const Unit& u, int wr, int wc, int fr, int fq) const {
        const int row0 = (u.pm - 64) * 256 + wr * 64 + fr, col0 = u.pn * 256 + wc * 32 + 4 * fq; float* base = YSC + (size_t)u.kind * MC * DM;
#pragma unroll
        for (int ai = 0; ai < 2; ++ai)
#pragma unroll
            for (int m = 0; m < 4; ++m)
#pragma unroll
                for (int bj = 0; bj < 2; ++bj)
#pragma unroll
                    for (int n = 0; n < 2; ++n) *(f32x4*)(base + (size_t)(row0 + ai * HALF + m * 16) * DM + col0 + bj * HALF + n * 16) = acc[ai][bj][m][n];
    }
};
struct EpiUp {
    static constexpr bool PERM = true, CARRY = false;
    bf16_t* act;
    __device__ __forceinline__ void operator()(const f32x4 (&acc)[2][2][4][2], const Unit& u, int wr, int wc, int fr, int fq) const {
        const int row0 = u.pm * 256 + wr * 64 + fr, col0 = u.pn * 128 + wc * 32 + 8 * fq;
#pragma unroll
        for (int ai = 0; ai < 2; ++ai)
#pragma unroll
            for (int m = 0; m < 4; ++m) { bf16_t* rowp = act + (size_t)(row0 + ai * HALF + m * 16) * DFF + col0;
                f32x4 r[2];
#pragma unroll
                for (int n = 0; n < 2; ++n) {
                    const f32x4 a = acc[ai][0][m][n], ab = a * acc[ai][1][m][n]; f32x4 t = a * -1.4426950408889634f;
#pragma unroll
                    for (int i = 0; i < 4; ++i) t[i] = __builtin_amdgcn_exp2f(t[i]);
                    t = t + 1.f;
#pragma unroll
                    for (int i = 0; i < 4; ++i) t[i] = __builtin_amdgcn_rcpf(t[i]);
                    r[n] = ab * t; }
                u32x4 w; w.x = cvt_pk_bf16(r[0][0], r[0][1]); w.y = cvt_pk_bf16(r[0][2], r[0][3]); w.z = cvt_pk_bf16(r[1][0], r[1][1]); w.w = cvt_pk_bf16(r[1][2], r[1][3]);
                __builtin_nontemporal_store(w, (u32x4*)rowp); }
    }
};

__device__ __forceinline__ void moe_tables(const Frame& F0, int l) {
    Frame F = enter(F0);
    LAS int* tab = (LAS int*)(F.lds + LDS_TAB);
    if (F.tid == 0) { const unsigned* cnt = (const unsigned*)(F.ws + WS_CTL) + CW_CNT + (l >> 1) * 8 * 64; int p = 0;
        for (int e = 0; e < 8; ++e) { const int t = ((int)__hip_atomic_load(cnt + e * 64, __ATOMIC_RELAXED, __HIP_MEMORY_SCOPE_AGENT) + 255) >> 8; tab[e] = t; tab[8 + e] = p; p += t; }
        tab[16] = p; }
    __syncthreads();
}

constexpr int PH_PER_LAYER = 9, N_PHASES = 2 + DEPTH * PH_PER_LAYER + 1;

__global__ void __launch_bounds__(NTHR, 2) mega(Args args) {
    extern __shared__ __attribute__((aligned(16))) unsigned char lds_raw[];
    Frame F0;
    F0.lds = (LAS unsigned char*)lds_raw; F0.ldsg = (char*)lds_raw;
    F0.in = args.in; F0.out = args.out; F0.ws = args.ws;
    F0.tid = threadIdx.x; F0.lane = F0.tid & 63; F0.wave = __builtin_amdgcn_readfirstlane(F0.tid >> 6);
    F0.G = gridDim.x; F0.bid = blockIdx.x; F0.gw = F0.bid * NWAVES + F0.wave; F0.NGW = F0.G * NWAVES;
    volatile LAS unsigned* MISC = (volatile LAS unsigned*)(F0.lds + LDS_TAB + 1024);
    if (F0.tid < 8) MISC[F0.tid] = 0u;
    __syncthreads();
#if MK_ONE_LAUNCH
    XcdBarrier bar = xcd_barrier_post((unsigned*)(F0.ws + WS_CTL) + CW_BAR, MISC, F0.wave);
#define GRID_BAR() xcd_barrier(bar)
#else
#define GRID_BAR() do {} while (0)
#endif
    const int lo = args.ph_lo, hi = args.ph_hi;
#ifndef AUDIT
#define AUDIT -1
#endif
#define INA(a, k) ((AUDIT < 0 || AUDIT == (a)) && lo <= (k) && (k) < hi)
#define IN(k) (lo <= (k) && (k) < hi)
#define INL(j) INA(2 + (j), pb + (j))
#define SEAM(k) do { if (IN((k) + 1)) { GRID_BAR(); if (PROBE == 15) GRID_BAR(); } } while (0)
    if (INA(0, 0)) { phase_prologue0(F0); SEAM(0); }
    if (INA(1, 1)) { phase_prologue1(F0); if (PROBE == 8) { GRID_BAR(); phase_prologue1(F0); } SEAM(1); }
    for (int l = 0; l < DEPTH; ++l) {
        const int pb = 2 + l * PH_PER_LAYER; const bool last = (l == DEPTH - 1);
        if (INL(0)) { phase_normmod1(F0, l, PROBE == 14 ? 2 : 1); SEAM(pb + 0); }
        if (INL(1)) { Frame F = enter(F0);
            const bf16_t* W = (const bf16_t*)(F.ws + WS_WIN) + (size_t)l * NIN * DM;
            { LAS f32x4* rl = (LAS f32x4*)(F.lds + LDS_ROPE); const f32x4* rg = (const f32x4*)(F.ws + WS_ROPE); for (int i = F.tid; i < 1024; i += NTHR) rl[i] = rg[i]; __syncthreads(); }
            pg8::DualOrder S; S.S1.init(F.ws + AR_H, W, MT, NQKVG, DM, F.G, F.bid, 1, WGM_INP); S.S2.init(W + (size_t)NQKVG * DM, F.ws + AR_H, HYW, MT, DM, F.G, F.bid, 1, WGM_INP);
            EpiInProjDual E{EpiInProj{(bf16_t*)(F.ws + AR_Q), (bf16_t*)(F.ws + AR_KC), (bf16_t*)(F.ws + AR_VC), (bf16_t*)(F.ws + AR_GATE), F.in[I_BGATE] + (size_t)l * 4096,
                          F.in[I_QNORM] + l * 128, F.in[I_KNORM] + l * 128, (const LAS float*)(F.lds + LDS_ROPE), F.lds + LDS_EPI}, EpiBf16Plain{(bf16_t*)(F.ws + AR_UT), MT}};
            pg8::gemm_phase(F.lds, F.wave, DM, S, E);
            SEAM(pb + 1);
        }
        if (INL(2)) { phase_mixers(F0, l); SEAM(pb + 2); }
        if (INL(3)) { phase_combine_transpose(F0, l); if (PROBE == 7) { GRID_BAR(); phase_combine_transpose(F0, l); } SEAM(pb + 3); }
        if (INL(4)) { Frame F = enter(F0);
            const int Mr = last ? ML : MT;
            pg8::PairOrder S; S.S0.init(F.ws + AR_YAN, (const bf16_t*)(F.ws + WS_WBRA) + (size_t)l * DM * DM, Mr, DM, DM, F.G, F.bid);
            S.A1 = (const char*)(F.ws + AR_YB); S.Bt1 = (const char*)((const bf16_t*)(F.ws + WS_WBRB) + (size_t)l * DM * DM);
            EpiMergePair E{(const bf16_t*)(F.ws + AR_GATE), (bf16_t*)(F.ws + AR_M)};
            pg8::gemm_phase(F.lds, F.wave, DM, S, E);
            phase_tail_transposes(F0, l, 0);
            SEAM(pb + 4);
        }
        if (INL(5)) { Frame F = enter(F0);
            const int Mr = last ? ML : MT;
            pg8::StaticOrder S; S.init(F.ws + AR_M, (const bf16_t*)(F.ws + WS_WOUT) + (size_t)l * DM * DM, Mr, DM, DM, F.G, F.bid);
            EpiOut E{(float*)(F.ws + WS_X), (const float*)(F.ws + WS_MOD) + (size_t)l * 5 * 12288};
            pg8::gemm_phase(F.lds, F.wave, DM, S, E);
            phase_tail_transposes(F0, l, 1);
            SEAM(pb + 5);
        }
        if (INL(6)) { phase_normmod2(F0, l); SEAM(pb + 6); }
        const int wslot = (l & 1) ? 2 + (l >> 1) * 8 : (l >> 1);
        if (INL(7)) { Frame F = enter(F0);
            const bf16_t* Wup = (const bf16_t*)(F.ws + WS_WUP) + (size_t)wslot * 2 * DFF * DM;
            EpiUp E{(bf16_t*)(F.ws + AR_ACT)};
            if (l & 1) { moe_tables(F, l);
                pg8::MoeOrder S; S.tab = (const LAS int*)(F.lds + LDS_TAB); S.nN = 44; S.G = F.G; S.c = F.bid; S.rep = (PROBE == 10) ? 2 : 1; S.wgm = WGM_MOE; S.A = (const char*)(F.ws + AR_H2S); S.W = (const char*)Wup;
                S.a_estride = (size_t)CAP * DM * 2; S.a_tstep = (size_t)256 * DM * 2; S.w_estride = (size_t)2 * DFF * DM * 2; S.w_tstep = (size_t)256 * DM * 2; S.a_by_slot = false;
                pg8::gemm_phase(F.lds, F.wave, DM, S, E);
            } else { pg8::StaticOrder S; S.init(F.ws + AR_H, Wup, last ? ML : MT, 2 * DFF, DM, F.G, F.bid, PROBE == 5 ? 2 : 1); pg8::gemm_phase(F.lds, F.wave, DM, S, E); }
            SEAM(pb + 7);
        }
        if (INL(8)) { Frame F = enter(F0);
            const bf16_t* Wdn = (const bf16_t*)(F.ws + WS_WDN) + (size_t)wslot * DM * DFF;
            EpiBf16Plain E{(bf16_t*)(F.ws + AR_YS), DM};
            if (l & 1) { moe_tables(F, l);
                pg8::MoeOrder S; S.tab = (const LAS int*)(F.lds + LDS_TAB); S.nN = 8; S.G = F.G; S.c = F.bid; S.rep = (PROBE == 11) ? 2 : 1; S.wgm = WGM_MOE; S.A = (const char*)(F.ws + AR_ACT); S.W = (const char*)Wdn;
                S.a_estride = 0; S.a_tstep = (size_t)256 * DFF * 2; S.w_estride = (size_t)DM * DFF * 2; S.w_tstep = (size_t)256 * DFF * 2; S.a_by_slot = true;
                pg8::gemm_phase(F.lds, F.wave, DFF, S, E);
            } else { { pg8::StaticOrder S; S.init(F.ws + AR_ACT, Wdn, ML, DM, DFF, F.G, F.bid, PROBE == 6 ? 2 : 1); pg8::gemm_phase(F.lds, F.wave, DFF, S, E); }
                pg8::SplitKOrder S; S.pm0 = 64; S.nN = 8; S.nT = 32; S.S = 4; S.G = F.G; S.c = F.bid; S.A = (const char*)(F.ws + AR_ACT); S.Bt = (const char*)Wdn; S.tstep = (size_t)256 * DFF * 2; S.kbytes = 1408 * 2;
                EpiDownSlab E2{(float*)(F.ws + AR_YSC)};
                pg8::gemm_phase(F.lds, F.wave, 1408, S, E2, DFF); }
            SEAM(pb + 8);
        }
    }
    if (INA(11, N_PHASES - 1)) phase_final(F0);
#undef IN
#undef INA
#undef INL
#undef SEAM
}

extern "C" void kernel_launch(void* const* d_in, const int* in_sizes, int n_in, void* d_out, int out_size, void* d_ws, size_t ws_size, hipStream_t stream) {
    static int grid = 0;
    if (grid == 0) {
        if (n_in != 38 || out_size != ML * DM || ws_size < WS_END) { fprintf(stderr, "kernel_launch: unexpected shapes: n_in %d out %d ws %zu (need %zu)\n", n_in, out_size, ws_size, (size_t)WS_END); grid = -1; return; }
        int dev = 0, cus = 0, per_cu = 0;
        if (hipGetDevice(&dev) != hipSuccess || hipDeviceGetAttribute(&cus, hipDeviceAttributeMultiprocessorCount, dev) != hipSuccess) { grid = -1; return; }
        if (hipFuncSetAttribute((const void*)mega, hipFuncAttributeMaxDynamicSharedMemorySize, LDS_BYTES) != hipSuccess) { fprintf(stderr, "kernel_launch: hipFuncSetAttribute failed\n"); grid = -1; return; }
        if (hipOccupancyMaxActiveBlocksPerMultiprocessor(&per_cu, (const void*)mega, NTHR, LDS_BYTES) != hipSuccess || per_cu < 1) fprintf(stderr, "kernel_launch: occupancy query reports %d\n", per_cu);
        (void)hipGetLastError();
        grid = cus;
    }
    if (grid < 0) return;
    static_assert((CW_CNT + 2 * 8 * 64) * 4 <= 128 * 1024 && (CW_BAR + XCD_BAR_WORDS) * 4 <= 128 * 1024, "control words inside the zeroed region");
    if (hipMemsetAsync((char*)d_ws + WS_CTL, 0, 128 * 1024, stream) != hipSuccess) return;
    Args a{};
    for (int i = 0; i < 38; ++i) a.in[i] = (const float*)d_in[i];
    a.out = (float*)d_out; a.ws = (unsigned char*)d_ws;
#if MK_ONE_LAUNCH
    a.ph_lo = 0; a.ph_hi = N_PHASES;
    hipLaunchKernelGGL(mega, dim3(grid), dim3(NTHR), LDS_BYTES, stream, a);
#else
    for (int p = 0; p < N_PHASES; ++p) { a.ph_lo = p; a.ph_hi = p + 1; hipLaunchKernelGGL(mega, dim3(grid), dim3(NTHR), LDS_BYTES, stream, a); }
#endif
}
```

```cpp
#include <hip/hip_runtime.h>
#include <cstdio>
#include <cstdint>

#ifndef PROBE
#define PROBE 0
#endif
#ifndef MK_ONE_LAUNCH
#define MK_ONE_LAUNCH 1
#endif

#define LAS __attribute__((address_space(3)))
typedef unsigned short bf16_t;
typedef short bf16x8 __attribute__((ext_vector_type(8)));
typedef short s16x4 __attribute__((ext_vector_type(4)));
typedef float f32x2 __attribute__((ext_vector_type(2)));
typedef float f32x4 __attribute__((ext_vector_type(4)));
typedef float f32x16 __attribute__((ext_vector_type(16)));
typedef unsigned u32x2 __attribute__((ext_vector_type(2)));
typedef unsigned u32x4 __attribute__((ext_vector_type(4)));

constexpr int DM = 2048, NB = 4, SEQ = 4096, LC = 256, ML = NB * SEQ, MC = NB * LC, MT = ML + MC;
constexpr int DEPTH = 4, NIN = 16384, DFF = 5632, NEXP = 8, CAP = MT, SKV = SEQ + LC;
constexpr int NQKVG = 10240;
constexpr int HYW = 6144;
constexpr int MAXSLOT = 36864;
constexpr float EPS = 1e-6f;
constexpr int NWAVES = 8, NTHR = 512;

constexpr size_t MiB = 1u << 20;
constexpr size_t WS_CTL = 0;
constexpr size_t WS_MOD = 1 * MiB;
constexpr size_t WS_LAM = 2 * MiB;
constexpr size_t WS_ROPE = 2 * MiB + 4096;
constexpr size_t WS_HID = 3 * MiB;
constexpr size_t WS_HIDC = WS_HID + 4 * MiB;
constexpr size_t WS_TOK = 8 * MiB;
constexpr size_t WS_RC = 9 * MiB;
constexpr size_t WS_R = 41 * MiB;
constexpr size_t WS_X = 313 * MiB;
constexpr size_t WS_WIN = 449 * MiB;
constexpr size_t WS_WBRA = WS_WIN + 256 * MiB;
constexpr size_t WS_WBRB = WS_WBRA + 32 * MiB;
constexpr size_t WS_WOUT = WS_WBRB + 32 * MiB;
constexpr size_t WS_WUP = WS_WOUT + 32 * MiB;
constexpr size_t WS_WDN = WS_WUP + 18 * 44 * MiB;
constexpr size_t WS_AR = WS_WDN + 18 * 22 * MiB;
constexpr size_t AR_H = WS_AR, AR_Q = WS_AR + 68 * MiB, AR_KRAW = WS_AR + 136 * MiB, AR_KC = WS_AR + 204 * MiB, AR_VC = WS_AR + 272 * MiB;
constexpr size_t AR_UT = WS_AR + 340 * MiB, AR_UT2 = WS_AR + 544 * MiB, AR_GATE = WS_AR + 748 * MiB, AR_O = WS_AR + 884 * MiB, AR_YBT = WS_AR + 1156 * MiB;
constexpr size_t AR_YAN = AR_KRAW, AR_YB = AR_KC, AR_M = AR_VC;
constexpr size_t AR_ACT = WS_AR + 68 * MiB, AR_YS = WS_AR + 464 * MiB, AR_H2S = WS_AR + 680 * MiB;
constexpr size_t AR_YSC = WS_AR + 1224 * MiB;
constexpr size_t WS_END = WS_AR + 1256 * MiB;
static_assert(WS_AR == 1989 * MiB, "map");
constexpr int CW_BAR = 4096;
constexpr int CW_CNT = 16384;

constexpr int LDS_EPI = 131072;
constexpr int LDS_TAB = 143360;
constexpr int LDS_ROPE = 147456;
constexpr int LDS_BYTES = 163840;

__device__ __forceinline__ unsigned cvt_pk_bf16(float lo, float hi) { unsigned r; asm volatile("v_cvt_pk_bf16_f32 %0, %1, %2" : "=v"(r) : "v"(lo), "v"(hi)); return r; }
__device__ __forceinline__ float bf_lo(unsigned w) { return __uint_as_float(w << 16); }
__device__ __forceinline__ float bf_hi(unsigned w) { return __uint_as_float(w & 0xffff0000u); }
__device__ __forceinline__ float bf2f(bf16_t b) { return __uint_as_float(((unsigned)b) << 16); }
__device__ __forceinline__ float shx(float v, int k, int lane) { return __int_as_float(__builtin_amdgcn_ds_bpermute((lane ^ k) << 2, __float_as_int(v))); }
__device__ __forceinline__ float wave_sum(float v, int lane) {
#pragma unroll
    for (int o = 1; o < 64; o <<= 1) v += shx(v, o, lane);
    return v;
}
__device__ __forceinline__ int opaque(int v) { asm volatile("" : "+v"(v)); return v; }
__device__ __forceinline__ int lane_id() { int r; asm volatile("v_mbcnt_lo_u32_b32 %0, -1, 0\n\tv_mbcnt_hi_u32_b32 %0, -1, %0" : "=v"(r)); return r; }
__device__ __forceinline__ int hw_tid(int wave) { return opaque(wave * 64 + lane_id()); }
#define LDS_WAIT() asm volatile("s_waitcnt lgkmcnt(0)" ::: "memory")
#define VM_WAIT() asm volatile("s_waitcnt vmcnt(0)" ::: "memory")

#define XB_TMO      128
#define XB_XCNT(j)  (256  + 64 * (j))
#define XB_XSUB(j)  (1280 + 64 * (j))
#define XB_XGEN(j)  (2304 + 64 * (j))
#define XB_TOP      3328
#define XB_TOPGEN   3392
#define XCD_BAR_WORDS 3456
#define XB_SPIN_CAP (1u << 18)
__device__ __forceinline__ unsigned xb_ld(unsigned* p)              { return __hip_atomic_load(p, __ATOMIC_RELAXED, __HIP_MEMORY_SCOPE_AGENT); }
__device__ __forceinline__ unsigned xb_add(unsigned* p, unsigned v) { return __hip_atomic_fetch_add(p, v, __ATOMIC_RELAXED, __HIP_MEMORY_SCOPE_AGENT); }
__device__ __forceinline__ unsigned xb_xcc_id() { return (unsigned)__builtin_amdgcn_s_getreg((3 << 11) | 20) & 0xFu; }
#define XB_SPIN(cond, bar) do { unsigned _sp = 0; while (cond) { __builtin_amdgcn_s_sleep(1); \
    if ((++_sp & 255u) == 0u) { if (xb_ld(&(bar)[XB_TMO])) break; if (_sp > XB_SPIN_CAP) { atomicAdd(&(bar)[XB_TMO], 1u); break; } } } } while (0)
struct XcdBarrier { unsigned* bar; unsigned x; volatile LAS unsigned* st; int wave; };
__device__ __forceinline__ XcdBarrier xcd_barrier_post(unsigned* bar, volatile LAS unsigned* st, int wave) {
    XcdBarrier b; b.bar = bar; b.x = xb_xcc_id(); b.st = st; b.wave = wave;
    if (threadIdx.x == 0) (void)xb_add(&bar[XB_XCNT(b.x)], 1u);
    return b;
}
__device__ __forceinline__ void xcd_barrier_complete(unsigned* bar, unsigned x, unsigned& nloc, unsigned& nx) {
    const unsigned G = gridDim.x * gridDim.y * gridDim.z;
    unsigned sum, cnt, mine, sp = 0u;
    for (;;) {
        sum = 0u; cnt = 0u; mine = 0u;
#pragma unroll
        for (unsigned j = 0; j < 16; ++j) { const unsigned c = xb_ld(&bar[XB_XCNT(j)]); sum += c; cnt += (c > 0u) ? 1u : 0u; mine = (j == x) ? c : mine; }
        if (sum == G) break;
        __builtin_amdgcn_s_sleep(1);
        if ((++sp & 255u) == 0u) { if (xb_ld(&bar[XB_TMO])) break; if (sp > XB_SPIN_CAP) { atomicAdd(&bar[XB_TMO], 1u); break; } }
    }
    nloc = mine > 0u ? mine : 1u; nx = cnt > 0u ? cnt : 1u;
}
__device__ __forceinline__ void xcd_barrier(const XcdBarrier& b) {
    asm volatile("s_waitcnt vmcnt(0)" ::: "memory");
    __syncthreads();
    if (b.wave == 0 && lane_id() == 0) {
        unsigned* bar = b.bar;
        __builtin_amdgcn_s_waitcnt(0);
        unsigned nloc = b.st[0], nx = b.st[1];
        if (nloc == 0u) { xcd_barrier_complete(bar, b.x, nloc, nx); b.st[0] = nloc; b.st[1] = nx; }
        const unsigned old = xb_add(&bar[XB_XSUB(b.x)], 1u);
        const unsigned gen = old / nloc;
        if (old + 1u == (gen + 1u) * nloc) {
            __builtin_amdgcn_fence(__ATOMIC_RELEASE, "agent");
            asm volatile("s_waitcnt vmcnt(0)" ::: "memory");
            const unsigned og = xb_add(&bar[XB_TOP], 1u);
            const unsigned tg = og / nx;
            if (og + 1u == (tg + 1u) * nx) xb_add(&bar[XB_TOPGEN], 1u);
            else XB_SPIN(xb_ld(&bar[XB_TOPGEN]) == tg, bar);
            __builtin_amdgcn_fence(__ATOMIC_ACQUIRE, "agent");
            xb_add(&bar[XB_XGEN(b.x)], 1u);
            asm volatile("s_waitcnt vmcnt(0)" ::: "memory");
        } else {
            XB_SPIN(xb_ld(&bar[XB_XGEN(b.x)]) == gen, bar);
            __builtin_amdgcn_fence(__ATOMIC_ACQUIRE, "agent");
            asm volatile("s_waitcnt vmcnt(0)" ::: "memory");
        }
    }
    __syncthreads();
}

namespace pg8 {
constexpr int BM = 256, BK = 64, HALF = 128, HTB = HALF * BK * 2, STAGE_BYTES = 8 * HTB;
__host__ __device__ __forceinline__ int lds_byte(int r, int c) { const int st = (r >> 4) * 2 + (c >> 5), rr = r & 15, cc = c & 31, ob = rr * 64 + cc * 2; return st * 1024 + (ob ^ (((ob >> 9) & 1) << 5)); }
__host__ __device__ __forceinline__ void stage_rc(int b, int& R, int& C) { const int st = b / 1024, sb = b % 1024, swz = sb ^ (((sb >> 9) & 1) << 5); R = (st >> 1) * 16 + swz / 64; C = (st & 1) * 32 + (swz % 64) / 2; }
__host__ __device__ __forceinline__ int perm32(int rho) { const int n = rho >> 4, i = rho & 15; return 8 * (i >> 2) + 4 * n + (i & 3); }
struct Unit { int pm, pn; const char* a; const char* b; int kind; };

template <class Epi, class Sched>
__device__ __forceinline__ void gemm_phase(LAS unsigned char* lds, const int wave_, const int K, const Sched& S, const Epi& E, const int ld_ = 0) {
    const int tid = hw_tid(wave_), wid = __builtin_amdgcn_readfirstlane(tid >> 6), lane = tid & 63, wr = wid >> 2, wc = wid & 3, fr = lane & 15, fq = lane >> 4;
    const int nt = K / BK, ld = ld_ ? ld_ : K;
    unsigned voffA[2], voffB[2];
#pragma unroll
    for (int i = 0; i < 2; ++i) { int R, C; stage_rc(tid * 16 + i * 8192, R, C); const int Rb = Epi::PERM ? ((R & ~31) + perm32(R & 31)) : R;
        voffA[i] = (unsigned)(R * ld + C) * 2u; voffB[i] = (unsigned)(Rb * ld + C) * 2u; }
    const size_t kstep = (size_t)(BK * 2);
    const size_t hstep = (size_t)HALF * ld * 2;
    const unsigned ldsw = (unsigned)wid * 1024u;
    const int aoff = lds_byte(wr * 64 + fr, fq * 8), boff = lds_byte(wc * 32 + fr, fq * 8);
#define PG8_SA(b, h) (((b) * 2 + (h)) * HTB)
#define PG8_SB(b, h) ((4 + (b) * 2 + (h)) * HTB)
#define PG8_STAGE(bufoff, gbase, voff) do { _Pragma("unroll") for (int _i = 0; _i < 2; ++_i) \
        __builtin_amdgcn_global_load_lds((const unsigned*)((const char*)(gbase) + (voff)[_i]), (LAS unsigned*)(lds + (bufoff) + ldsw + _i * 8192), 16, 0, 0); } while (0)
#define PG8_LDA(dst, b, h) do { _Pragma("unroll") for (int m = 0; m < 4; ++m) _Pragma("unroll") for (int k = 0; k < 2; ++k) dst[m][k] = *(const LAS bf16x8*)(lds + PG8_SA(b, h) + aoff + m * 2048 + k * 1024); } while (0)
#define PG8_LDB(dst, b, h) do { _Pragma("unroll") for (int n = 0; n < 2; ++n) _Pragma("unroll") for (int k = 0; k < 2; ++k) dst[n][k] = *(const LAS bf16x8*)(lds + PG8_SB(b, h) + boff + n * 2048 + k * 1024); } while (0)
#define PG8_MMA(ai, bj, At, Bt) do { __builtin_amdgcn_s_setprio(1); _Pragma("unroll") for (int m = 0; m < 4; ++m) _Pragma("unroll") for (int n = 0; n < 2; ++n) _Pragma("unroll") for (int k = 0; k < 2; ++k) \
        acc[ai][bj][m][n] = __builtin_amdgcn_mfma_f32_16x16x32_bf16(Bt[n][k], At[m][k], acc[ai][bj][m][n], 0, 0, 0); __builtin_amdgcn_s_setprio(0); } while (0)
#define PG8_WAIT_V(n) asm volatile("s_waitcnt vmcnt(" #n ")" ::: "memory")
#define PG8_WAIT_L(n) asm volatile("s_waitcnt lgkmcnt(" #n ")" ::: "memory")
#define PG8_BAR __builtin_amdgcn_s_barrier()
#define PG8_SCHED __builtin_amdgcn_sched_barrier(0)
    Unit cur, nxt; int ui = 0;
    if (!S.next(0, cur)) return;
    f32x4 acc[2][2][4][2];
#pragma unroll
    for (int a = 0; a < 2; ++a)
#pragma unroll
        for (int b = 0; b < 2; ++b)
#pragma unroll
            for (int m = 0; m < 4; ++m)
#pragma unroll
                for (int n = 0; n < 2; ++n) acc[a][b][m][n] = (f32x4){0.f, 0.f, 0.f, 0.f};
    bf16x8 At[4][2], B0[2][2], B1[2][2];
    const char* cA = cur.a; const char* cB = cur.b;
    PG8_STAGE(PG8_SB(0, 0), cB, voffB); PG8_STAGE(PG8_SA(0, 0), cA, voffA); PG8_STAGE(PG8_SB(0, 1), cB + hstep, voffB); PG8_STAGE(PG8_SA(0, 1), cA + hstep, voffA);
    if (wr == 1) PG8_BAR;
    PG8_WAIT_V(4); PG8_BAR;
    PG8_STAGE(PG8_SB(1, 0), cB + kstep, voffB); PG8_STAGE(PG8_SA(1, 0), cA + kstep, voffA); PG8_STAGE(PG8_SB(1, 1), cB + hstep + kstep, voffB);
    PG8_WAIT_V(6); PG8_BAR;
    for (;;) {
        const bool has_next = S.next(ui + 1, nxt);
        const char* nA = has_next ? nxt.a : cA; const char* nB = has_next ? nxt.b : cB;
        for (int t = 0; t < nt; t += 2) {
            const bool last = (t == nt - 2);
            const char* a1 = cA + (size_t)(t + 1) * kstep;
            const char* a2 = last ? nA : cA + (size_t)(t + 2) * kstep; const char* b2 = last ? nB : cB + (size_t)(t + 2) * kstep;
            const char* a3 = a2 + kstep; const char* b3 = b2 + kstep;
            PG8_LDB(B0, 0, 0); PG8_SCHED; PG8_LDA(At, 0, 0); PG8_STAGE(PG8_SA(1, 1), a1 + hstep, voffA);
            PG8_WAIT_L(8); PG8_BAR; PG8_WAIT_L(0); PG8_MMA(0, 0, At, B0); PG8_BAR; PG8_SCHED;
            PG8_LDB(B1, 0, 1); PG8_STAGE(PG8_SB(0, 0), b2, voffB);
            PG8_BAR; PG8_WAIT_L(0); PG8_MMA(0, 1, At, B1); PG8_BAR;
            PG8_LDA(At, 0, 1); PG8_STAGE(PG8_SA(0, 0), a2, voffA);
            PG8_BAR; PG8_WAIT_L(0); PG8_MMA(1, 0, At, B0); PG8_BAR; PG8_SCHED;
            PG8_STAGE(PG8_SB(0, 1), b2 + hstep, voffB);
            PG8_WAIT_V(6); PG8_BAR; PG8_MMA(1, 1, At, B1); PG8_BAR;
            PG8_LDB(B0, 1, 0); PG8_SCHED; PG8_LDA(At, 1, 0); PG8_STAGE(PG8_SA(0, 1), a2 + hstep, voffA);
            PG8_WAIT_L(8); PG8_BAR; PG8_WAIT_L(0); PG8_MMA(0, 0, At, B0); PG8_BAR; PG8_SCHED;
            PG8_LDB(B1, 1, 1); PG8_STAGE(PG8_SB(1, 0), b3, voffB);
            PG8_BAR; PG8_WAIT_L(0); PG8_MMA(0, 1, At, B1); PG8_BAR;
            PG8_LDA(At, 1, 1); PG8_STAGE(PG8_SA(1, 0), a3, voffA);
            PG8_BAR; PG8_WAIT_L(0); PG8_MMA(1, 0, At, B0); PG8_BAR; PG8_SCHED;
            PG8_STAGE(PG8_SB(1, 1), b3 + hstep, voffB);
            PG8_WAIT_V(6); PG8_BAR; PG8_MMA(1, 1, At, B1); PG8_BAR;
        }
        bool keep = false;
        if constexpr (Epi::CARRY) keep = E.carry(acc, cur, wr, wc, fr, fq); else E(acc, cur, wr, wc, fr, fq);
        if (!has_next) break;
        if (!keep) {
#pragma unroll
        for (int a = 0; a < 2; ++a)
#pragma unroll
            for (int b = 0; b < 2; ++b)
#pragma unroll
                for (int m = 0; m < 4; ++m)
#pragma unroll
                    for (int n = 0; n < 2; ++n) acc[a][b][m][n] = (f32x4){0.f, 0.f, 0.f, 0.f}; }
        cur = nxt; cA = nA; cB = nB; ++ui;
    }
    PG8_WAIT_V(0);
    if (wr == 0) PG8_BAR;
    PG8_BAR;
#undef PG8_SA
#undef PG8_SB
#undef PG8_STAGE
#undef PG8_LDA
#undef PG8_LDB
#undef PG8_MMA
#undef PG8_WAIT_V
#undef PG8_WAIT_L
#undef PG8_BAR
#undef PG8_SCHED
}

#ifndef WGM_MOE
#define WGM_MOE 4
#endif
#ifndef WGM_INP
#define WGM_INP 4
#endif
constexpr int NXCD = 8, WGM = 4;
struct StaticOrder {
    int nM, nN, nwg, G, c, rep, wgm; const char* A; const char* Bt; size_t tstep;
    __device__ void init(const void* A_, const void* Bt_, int M, int N, int K, int G_, int c_, int rep_ = 1, int wgm_ = WGM) { nM = M / BM; nN = N / BM; nwg = nM * nN; G = G_; c = c_; rep = rep_; wgm = wgm_; A = (const char*)A_; Bt = (const char*)Bt_; tstep = (size_t)BM * K * 2; }
    __device__ bool next(int i, Unit& u) const {
        const long L = (long)i * G + c; if (L >= (long)nwg * rep) return false;
        map((int)(L % nwg), u); u.kind = 0; return true;
    }
    __device__ void map(int wgid, Unit& u) const {
        { const int q = nwg / NXCD, r = nwg % NXCD, xcd = wgid % NXCD, off = wgid / NXCD; wgid = (xcd < r ? xcd * (q + 1) : r * (q + 1) + (xcd - r) * q) + off; }
        const int nig = wgm * nN, gid = wgid / nig, fm = gid * wgm, gsz = (nM - fm) < wgm ? (nM - fm) : wgm;
        u.pm = fm + ((wgid % nig) % gsz); u.pn = (wgid % nig) / gsz; u.a = A + (size_t)u.pm * tstep; u.b = Bt + (size_t)u.pn * tstep;
    }
};
struct DualOrder {
    StaticOrder S1, S2;
    __device__ bool next(int i, Unit& u) const {
        const int L = i * S1.G + S1.c; if (L < S1.nwg) { S1.map(L, u); u.kind = 0; return true; }
        if (L - S1.nwg < S2.nwg) { S2.map(L - S1.nwg, u); u.kind = 1; return true; }
        return false;
    }
};
struct PairOrder {
    StaticOrder S0; const char* A1; const char* Bt1;
    __device__ bool next(int i, Unit& u) const {
        const int w = (i >> 1) * S0.G + S0.c; if (w >= S0.nwg) return false;
        S0.map(w, u); u.kind = i & 1;
        if (i & 1) { u.a = A1 + (size_t)u.pm * S0.tstep; u.b = Bt1 + (size_t)u.pn * S0.tstep; }
        return true;
    }
};
struct SplitKOrder {
    int pm0, nN, nT, S, G, c; const char* A; const char* Bt; size_t tstep, kbytes;
    __device__ bool next(int i, Unit& u) const {
        const int L = i * G + c; if (L >= nT * S) return false;
        const int un = L / S, ks = L - un * S; u.pm = pm0 + un / nN; u.pn = un % nN; u.kind = ks;
        u.a = A + (size_t)u.pm * tstep + (size_t)ks * kbytes; u.b = Bt + (size_t)u.pn * tstep + (size_t)ks * kbytes; return true;
    }
};
struct MoeOrder {
    const LAS int* tab; int nN, G, c, rep, wgm; const char* A; const char* W; size_t a_estride, a_tstep, w_estride, w_tstep; bool a_by_slot;
    __device__ bool next(int i, Unit& u) const {
        int L = i * G + c; const int total = tab[16] * nN; if (L >= total * rep) return false; if (L >= total) L -= total;
        int e = 0;
#pragma unroll
        for (int k = 1; k < 8; ++k) e += (L >= tab[8 + k] * nN) ? 1 : 0;
        const int te = tab[e], ts = tab[8 + e]; const int ne = te * nN; int idx = L - ts * nN;
        { const int q = ne / NXCD, r = ne % NXCD, xcd = idx % NXCD, off = idx / NXCD; idx = (xcd < r ? xcd * (q + 1) : r * (q + 1) + (xcd - r) * q) + off; }
        const int nig = wgm * nN, gid = idx / nig, fm = gid * wgm, gsz = (te - fm) < wgm ? (te - fm) : wgm;
        const int r = fm + ((idx % nig) % gsz), pn = (idx % nig) / gsz;
        const int ee = __builtin_amdgcn_readfirstlane(e), pnn = __builtin_amdgcn_readfirstlane(pn), rr = __builtin_amdgcn_readfirstlane(r), tss = __builtin_amdgcn_readfirstlane(ts);
        u.pm = tss + rr; u.pn = pnn; u.kind = 0;
        u.a = a_by_slot ? A + (size_t)u.pm * a_tstep : A + (size_t)ee * a_estride + (size_t)rr * a_tstep;
        u.b = W + (size_t)ee * w_estride + (size_t)pnn * w_tstep; return true;
    }
};
}

namespace att {
constexpr int D = 128, DV = 256, NW = 8, QBLK = 32, KVBLK = 32;
constexpr float SCALE = 0.088388347648318440f;
constexpr float THR = 8.f;
#ifndef ATT_SDEPTH
#define ATT_SDEPTH 1
#endif
constexpr int SDEPTH = ATT_SDEPTH;
constexpr int LDQ = DM, LDK = DM, LDO = 4096;
constexpr size_t SHM_V = KVBLK * DV * 2, SHM_K = KVBLK * D * 2, SHM_Q0 = 2 * SHM_V + 2 * SHM_K + NW * 64 * 4, SHM_ATTN = SHM_Q0 + NW * 8192;
#define KSWZ(row, colB) ((row) * 256 + ((colB) ^ (((row) & 7) << 4)))
#define SBAR() __builtin_amdgcn_sched_barrier(0)
__device__ __forceinline__ int crow(int r, int hi) { return (r & 3) + 8 * (r >> 2) + 4 * hi; }
__device__ __forceinline__ unsigned cvtpk(float lo, float hi) { unsigned r; asm volatile("v_cvt_pk_bf16_f32 %0, %1, %2" : "=v"(r) : "v"(lo), "v"(hi)); return r; }
__device__ __forceinline__ void partialSM(f32x16& p0, float& m_reg, float& mn, float& alpha) {
  constexpr float C = SCALE * 1.4426950408889634f;
  float pmax = p0[0]; for (int r = 1; r < 16; ++r) pmax = fmaxf(pmax, p0[r]);
  { auto rr = __builtin_amdgcn_permlane32_swap(__float_as_uint(pmax), __float_as_uint(pmax), false, false);
    pmax = fmaxf(__uint_as_float(rr[0]), __uint_as_float(rr[1])); }
  if (__builtin_expect(__all(pmax - m_reg <= THR / SCALE), 1)) { mn = m_reg; alpha = 1.f; }
  else { mn = fmaxf(m_reg, pmax); alpha = __builtin_amdgcn_exp2f((m_reg - mn) * C); m_reg = mn; }
  float mnC = -mn * C;
  for (int r = 0; r < 16; ++r) p0[r] = fmaf(p0[r], C, mnC);
  for (int r = 0; r < 8; ++r) p0[r] = __builtin_amdgcn_exp2f(p0[r]);
}
__device__ __forceinline__ void finishSM(f32x16& p0, float alpha, float& l_reg, bf16x8& pa0, bf16x8& pa1) {
  for (int r = 8; r < 16; ++r) p0[r] = __builtin_amdgcn_exp2f(p0[r]);
  float ps = 0; for (int r = 0; r < 16; ++r) ps += p0[r];
  { auto rr = __builtin_amdgcn_permlane32_swap(__float_as_uint(ps), __float_as_uint(ps), false, false);
    ps = __uint_as_float(rr[0]) + __uint_as_float(rr[1]); }
  l_reg = l_reg * alpha + ps;
#define PK4(P, BASE, OUT) do { unsigned a0 = cvtpk(P[BASE + 0], P[BASE + 1]), a1 = cvtpk(P[BASE + 2], P[BASE + 3]);   \
    unsigned b0 = cvtpk(P[BASE + 4], P[BASE + 5]), b1 = cvtpk(P[BASE + 6], P[BASE + 7]);                              \
    auto r0 = __builtin_amdgcn_permlane32_swap(a0, b0, false, false); auto r1 = __builtin_amdgcn_permlane32_swap(a1, b1, false, false); \
    u32x4 w = {r0[0], r1[0], r0[1], r1[1]}; OUT = *reinterpret_cast<bf16x8*>(&w); } while (0)
  PK4(p0, 0, pa0); PK4(p0, 8, pa1);
#undef PK4
}
#ifndef ATT_QLDS
#define ATT_QLDS 0
#endif
#if ATT_QLDS
typedef const char* qfrag_t;
#define QV(d0) (*reinterpret_cast<const bf16x8*>(qp + (d0) * 1024))
#else
typedef const bf16x8* qfrag_t;
#define QV(d0) (qp[d0])
#endif
__device__ __forceinline__ void qkt(f32x16& p0, const bf16_t* Ks, qfrag_t qp, int r32, int hi) {
  p0 = f32x16{};
  for (int d0 = 0; d0 < 8; ++d0) { int cb = (d0 * 16 + hi * 8) * 2; const bf16x8 qv = QV(d0);
    bf16x8 b0 = *reinterpret_cast<const bf16x8*>((const char*)Ks + KSWZ(r32, cb));
    p0 = __builtin_amdgcn_mfma_f32_32x32x16_bf16(b0, qv, p0, 0, 0, 0); }
}
__device__ __forceinline__ int v_st(int k, int c) { const int kk = (k & ~0xC) | ((k & 4) << 1) | ((k & 8) >> 1); return ((kk >> 3) * 8 + (c >> 5)) * 512 + ((kk & 7) * 32 + (c & 31)) * 2; }
__device__ __forceinline__ int v_rd_base(int lane) { return ((lane & 3) << 3) | (((lane >> 2) & 3) << 6) | (((lane >> 4) & 1) << 5) | (((lane >> 5) & 1) << 8); }
constexpr int v_rd_off(int d0, int ks, int half) { return d0 * 512 + ks * 8192 + half * 4096; }
template <int OFF> __device__ __forceinline__ s16x4 tr_read(int vb) {
  s16x4 r; asm volatile("ds_read_b64_tr_b16 %0, %1 offset:%2" : "=&v"(r) : "v"(vb), "i"(OFF) : "memory"); return r;
}
template <int D0> __device__ __forceinline__ void pv_two(f32x16& oa, f32x16& ob, int vb, bf16x8 pa0, bf16x8 pa1) {
  const s16x4 l0 = tr_read<v_rd_off(D0, 0, 0)>(vb), h0 = tr_read<v_rd_off(D0, 0, 1)>(vb), l1 = tr_read<v_rd_off(D0, 1, 0)>(vb), h1 = tr_read<v_rd_off(D0, 1, 1)>(vb);
  const s16x4 l2 = tr_read<v_rd_off(D0 + 1, 0, 0)>(vb), h2 = tr_read<v_rd_off(D0 + 1, 0, 1)>(vb), l3 = tr_read<v_rd_off(D0 + 1, 1, 0)>(vb), h3 = tr_read<v_rd_off(D0 + 1, 1, 1)>(vb);
  asm volatile("s_waitcnt lgkmcnt(0)" ::: "memory"); SBAR();
#define PK(L, H) (bf16x8){L[0], L[1], L[2], L[3], H[0], H[1], H[2], H[3]}
  oa = __builtin_amdgcn_mfma_f32_32x32x16_bf16(pa0, PK(l0, h0), oa, 0, 0, 0);
  oa = __builtin_amdgcn_mfma_f32_32x32x16_bf16(pa1, PK(l1, h1), oa, 0, 0, 0);
  ob = __builtin_amdgcn_mfma_f32_32x32x16_bf16(pa0, PK(l2, h2), ob, 0, 0, 0);
  ob = __builtin_amdgcn_mfma_f32_32x32x16_bf16(pa1, PK(l3, h3), ob, 0, 0, 0);
#undef PK
}
#ifndef ATT_PV1
#define ATT_PV1 1
#endif
template <int D0> __device__ __forceinline__ void pv_one(f32x16& oa, int vb, bf16x8 pa0, bf16x8 pa1) {
  const s16x4 l0 = tr_read<v_rd_off(D0, 0, 0)>(vb), h0 = tr_read<v_rd_off(D0, 0, 1)>(vb), l1 = tr_read<v_rd_off(D0, 1, 0)>(vb), h1 = tr_read<v_rd_off(D0, 1, 1)>(vb);
  asm volatile("s_waitcnt lgkmcnt(0)" ::: "memory"); SBAR();
#define PK(L, H) (bf16x8){L[0], L[1], L[2], L[3], H[0], H[1], H[2], H[3]}
  oa = __builtin_amdgcn_mfma_f32_32x32x16_bf16(pa0, PK(l0, h0), oa, 0, 0, 0);
  oa = __builtin_amdgcn_mfma_f32_32x32x16_bf16(pa1, PK(l1, h1), oa, 0, 0, 0);
#undef PK
}
#ifndef ATT_PVPIPE
#define ATT_PVPIPE 1
#endif
#define PVR(D0, l0, h0, l1, h1) do { l0 = tr_read<v_rd_off(D0, 0, 0)>(vb); h0 = tr_read<v_rd_off(D0, 0, 1)>(vb); l1 = tr_read<v_rd_off(D0, 1, 0)>(vb); h1 = tr_read<v_rd_off(D0, 1, 1)>(vb); } while (0)
#define PVM(OA, l0, h0, l1, h1) do { OA = __builtin_amdgcn_mfma_f32_32x32x16_bf16(pa0, ((bf16x8){l0[0], l0[1], l0[2], l0[3], h0[0], h0[1], h0[2], h0[3]}), OA, 0, 0, 0); \
    OA = __builtin_amdgcn_mfma_f32_32x32x16_bf16(pa1, ((bf16x8){l1[0], l1[1], l1[2], l1[3], h1[0], h1[1], h1[2], h1[3]}), OA, 0, 0, 0); } while (0)
#define PIN(x) asm volatile("" : "+v"(x))
#define PVW(n) do { asm volatile("s_waitcnt lgkmcnt(" #n ")" ::: "memory"); SBAR(); } while (0)
__device__ __forceinline__ void pv_all_pipe(f32x16* o, int vb, bf16x8 pa0, bf16x8 pa1) {
  s16x4 a0, a1, a2, a3, b0, b1, b2, b3;
  PVR(0, a0, a1, a2, a3);
  PVR(1, b0, b1, b2, b3); PVW(4); PVM(o[0], a0, a1, a2, a3);
  PVR(2, a0, a1, a2, a3); PVW(4); PVM(o[1], b0, b1, b2, b3);
  PVR(3, b0, b1, b2, b3); PVW(4); PVM(o[2], a0, a1, a2, a3);
  PVR(4, a0, a1, a2, a3); PVW(4); PVM(o[3], b0, b1, b2, b3);
  PVR(5, b0, b1, b2, b3); PVW(4); PVM(o[4], a0, a1, a2, a3);
  PVR(6, a0, a1, a2, a3); PVW(4); PVM(o[5], b0, b1, b2, b3);
  PVR(7, b0, b1, b2, b3); PVW(4); PVM(o[6], a0, a1, a2, a3);
  PVW(0); PVM(o[7], b0, b1, b2, b3);
}
__device__ __forceinline__ void pv_all_sm(f32x16& o0, f32x16& o1, f32x16& o2, f32x16& o3, f32x16& o4, f32x16& o5, f32x16& o6, f32x16& o7, int vb, bf16x8 pa0, bf16x8 pa1,
                                          f32x16& p0, float& m_reg, float& mn, float& alpha) {
  constexpr float C = SCALE * 1.4426950408889634f;
  s16x4 a0, a1, a2, a3, b0, b1, b2, b3;
  float t0, t1, mnC;
  PVR(0, a0, a1, a2, a3);
  PVR(1, b0, b1, b2, b3);
  t0 = fmaxf(fmaxf(fmaxf(p0[0], p0[1]), fmaxf(p0[2], p0[3])), fmaxf(fmaxf(p0[4], p0[5]), fmaxf(p0[6], p0[7]))); PIN(t0);
  PVW(4); PVM(o0, a0, a1, a2, a3);
  PVR(2, a0, a1, a2, a3);
  t1 = fmaxf(fmaxf(fmaxf(p0[8], p0[9]), fmaxf(p0[10], p0[11])), fmaxf(fmaxf(p0[12], p0[13]), fmaxf(p0[14], p0[15])));
  t0 = fmaxf(t0, t1);
  { auto rr = __builtin_amdgcn_permlane32_swap(__float_as_uint(t0), __float_as_uint(t0), false, false); t0 = fmaxf(__uint_as_float(rr[0]), __uint_as_float(rr[1])); } PIN(t0);
  PVW(4); PVM(o1, b0, b1, b2, b3);
  PVR(3, b0, b1, b2, b3);
  { const bool keep = __all(t0 - m_reg <= THR / SCALE);
    mn = keep ? m_reg : fmaxf(m_reg, t0); alpha = keep ? 1.f : __builtin_amdgcn_exp2f((m_reg - mn) * C); m_reg = mn; mnC = -mn * C; PIN(alpha); PIN(mnC); }
  PVW(4); PVM(o2, a0, a1, a2, a3);
  PVR(4, a0, a1, a2, a3);
#pragma unroll
  for (int r = 0; r < 8; ++r) { p0[r] = fmaf(p0[r], C, mnC); PIN(p0[r]); }
  PVW(4); PVM(o3, b0, b1, b2, b3);
  PVR(5, b0, b1, b2, b3);
#pragma unroll
  for (int r = 8; r < 16; ++r) { p0[r] = fmaf(p0[r], C, mnC); PIN(p0[r]); }
  PVW(4); PVM(o4, a0, a1, a2, a3);
  PVR(6, a0, a1, a2, a3);
#pragma unroll
  for (int r = 0; r < 3; ++r) { p0[r] = __builtin_amdgcn_exp2f(p0[r]); PIN(p0[r]); }
  PVW(4); PVM(o5, b0, b1, b2, b3);
  PVR(7, b0, b1, b2, b3);
#pragma unroll
  for (int r = 3; r < 6; ++r) { p0[r] = __builtin_amdgcn_exp2f(p0[r]); PIN(p0[r]); }
  PVW(4); PVM(o6, a0, a1, a2, a3);
#pragma unroll
  for (int r = 6; r < 8; ++r) { p0[r] = __builtin_amdgcn_exp2f(p0[r]); PIN(p0[r]); }
  PVW(0); PVM(o7, b0, b1, b2, b3);
}
__device__ __forceinline__ void qkt_fsm(f32x16& pn, const bf16_t* Ks, const bf16x8 (&q)[8], int r32, int hi, f32x16& p0, float alpha, float& l_reg, bf16x8& pa0, bf16x8& pa1) {
  pn = f32x16{};
  const char* kbp = (const char*)Ks;
  bf16x8 kf[2];
  kf[0] = *reinterpret_cast<const bf16x8*>(kbp + KSWZ(r32, (hi * 8) * 2));
  float ps = 0.f; unsigned c0 = 0, c1 = 0, c2 = 0, c3 = 0, e0 = 0, e1 = 0, e2 = 0, e3 = 0;
#define QSTEP(d0, ...) do { if ((d0) < 7) kf[((d0) + 1) & 1] = *reinterpret_cast<const bf16x8*>(kbp + KSWZ(r32, (((d0) + 1) * 16 + hi * 8) * 2)); \
    pn = __builtin_amdgcn_mfma_f32_32x32x16_bf16(kf[(d0) & 1], q[d0], pn, 0, 0, 0); __VA_ARGS__; SBAR(); } while (0)
  QSTEP(0, { p0[8] = __builtin_amdgcn_exp2f(p0[8]); p0[9] = __builtin_amdgcn_exp2f(p0[9]); PIN(p0[8]); PIN(p0[9]); });
  QSTEP(1, { p0[10] = __builtin_amdgcn_exp2f(p0[10]); p0[11] = __builtin_amdgcn_exp2f(p0[11]); PIN(p0[10]); PIN(p0[11]); });
  QSTEP(2, { p0[12] = __builtin_amdgcn_exp2f(p0[12]); p0[13] = __builtin_amdgcn_exp2f(p0[13]); PIN(p0[12]); PIN(p0[13]); });
  QSTEP(3, { p0[14] = __builtin_amdgcn_exp2f(p0[14]); p0[15] = __builtin_amdgcn_exp2f(p0[15]); PIN(p0[14]); PIN(p0[15]); });
  QSTEP(4, { ps = ((p0[0] + p0[1]) + (p0[2] + p0[3])) + ((p0[4] + p0[5]) + (p0[6] + p0[7])); PIN(ps); });
  QSTEP(5, { ps += ((p0[8] + p0[9]) + (p0[10] + p0[11])) + ((p0[12] + p0[13]) + (p0[14] + p0[15]));
    { auto rr = __builtin_amdgcn_permlane32_swap(__float_as_uint(ps), __float_as_uint(ps), false, false); ps = __uint_as_float(rr[0]) + __uint_as_float(rr[1]); }
    l_reg = l_reg * alpha + ps; PIN(l_reg); });
  QSTEP(6, { c0 = cvtpk(p0[0], p0[1]); c1 = cvtpk(p0[2], p0[3]); c2 = cvtpk(p0[4], p0[5]); c3 = cvtpk(p0[6], p0[7]);
    auto r0 = __builtin_amdgcn_permlane32_swap(c0, c2, false, false); auto r1 = __builtin_amdgcn_permlane32_swap(c1, c3, false, false);
    u32x4 w = {r0[0], r1[0], r0[1], r1[1]}; PIN(w); pa0 = *reinterpret_cast<bf16x8*>(&w); });
  QSTEP(7, { e0 = cvtpk(p0[8], p0[9]); e1 = cvtpk(p0[10], p0[11]); e2 = cvtpk(p0[12], p0[13]); e3 = cvtpk(p0[14], p0[15]);
    auto r0 = __builtin_amdgcn_permlane32_swap(e0, e2, false, false); auto r1 = __builtin_amdgcn_permlane32_swap(e1, e3, false, false);
    u32x4 w = {r0[0], r1[0], r0[1], r1[1]}; PIN(w); pa1 = *reinterpret_cast<bf16x8*>(&w); });
#undef QSTEP
}
#undef PVR
#undef PVM
#undef PVW
#undef PIN
__device__ __forceinline__ void pv_all(f32x16* o, int vb, bf16x8 pa0, bf16x8 pa1) {
#if ATT_PVPIPE
  pv_all_pipe(o, vb, pa0, pa1);
#elif ATT_PV1
  pv_one<0>(o[0], vb, pa0, pa1); pv_one<1>(o[1], vb, pa0, pa1); pv_one<2>(o[2], vb, pa0, pa1); pv_one<3>(o[3], vb, pa0, pa1);
  pv_one<4>(o[4], vb, pa0, pa1); pv_one<5>(o[5], vb, pa0, pa1); pv_one<6>(o[6], vb, pa0, pa1); pv_one<7>(o[7], vb, pa0, pa1);
#else
  pv_two<0>(o[0], o[1], vb, pa0, pa1); pv_two<2>(o[2], o[3], vb, pa0, pa1); pv_two<4>(o[4], o[5], vb, pa0, pa1); pv_two<6>(o[6], o[7], vb, pa0, pa1);
#endif
}
__device__ __forceinline__ void attn_dense_body(const bf16_t* __restrict__ Qb, const bf16_t* __restrict__ Kh, const bf16_t* __restrict__ Vh,
                                                unsigned* __restrict__ Ob, int seq, char* lds, int wave_) {
  const int tid = hw_tid(wave_), wid = tid >> 6, lane = tid & 63, r32 = lane & 31, hi = lane >> 5;
#ifndef ATT_DMA3
#define ATT_DMA3 1
#endif
#if ATT_DMA3
  constexpr int NVB = 4, NKB = 3;
  static_assert(!ATT_QLDS, "the LDS-DMA body keeps Q in registers");
#else
  constexpr int NVB = 2, NKB = 2;
#endif
  bf16_t* V_lds = (bf16_t*)lds; bf16_t* K_lds = (bf16_t*)(lds + NVB * SHM_V);
  float* ws = (float*)(lds + NVB * SHM_V + NKB * SHM_K) + wid * 64; float* li_l = ws; float* al_l = ws + 32;
  float m_reg = -1e30f, l_reg = 0; f32x16 o[8] = {};
#if ATT_QLDS
  char* qr = lds + SHM_Q0 + wid * 8192 + lane * 16;
#else
  bf16x8 qr[8];
#endif
  const bf16_t* Qw = Qb + (long)(wid * QBLK + r32) * LDQ + hi * 8;
#pragma unroll
#if ATT_QLDS
  for (int d0 = 0; d0 < 8; ++d0) *reinterpret_cast<bf16x8*>(qr + d0 * 1024) = *reinterpret_cast<const bf16x8*>(Qw + d0 * 16);
#else
  for (int d0 = 0; d0 < 8; ++d0) qr[d0] = *reinterpret_cast<const bf16x8*>(Qw + d0 * 16);
#endif
  const int vb0 = (int)(uintptr_t)V_lds + v_rd_base(lane);
#define RESC(a) do { if (__any((a) < 1.f)) { if (hi == 0) al_l[r32] = (a); asm volatile("s_waitcnt lgkmcnt(0)" ::: "memory"); \
    for (int d = 0; d < 8; ++d) for (int r = 0; r < 16; ++r) o[d][r] *= al_l[crow(r, hi)]; } } while (0)
#if ATT_DMA3
  const int widu = __builtin_amdgcn_readfirstlane(wid);
  const unsigned kdl = (unsigned)(uintptr_t)(LAS unsigned char*)K_lds + ((unsigned)widu << 10), vdl = (unsigned)(uintptr_t)(LAS unsigned char*)V_lds + ((unsigned)widu << 10);
  const unsigned kofs = (unsigned)(((tid >> 4) * LDK + ((((tid & 15) ^ ((tid >> 4) & 7))) << 3)) * 2);
  unsigned vofs[2];
#pragma unroll
  for (int i = 0; i < 2; ++i) { const int sl = tid + 512 * i, sub = sl >> 5, w = sl & 31, kk = (sub >> 3) * 8 + (w >> 2), c = (sub & 7) * 32 + (w & 3) * 8, k = (kk & ~0xC) | ((kk & 4) << 1) | ((kk & 8) >> 1);
    vofs[i] = (unsigned)((k * LDK + c) * 2); }
  const int NT = seq / KVBLK;
#define DMA(t, kb, vbi) do { const int t_ = (t) < NT ? (t) : NT - 1; const char* kt_ = (const char*)(Kh + (long)t_ * (KVBLK * LDK)); const char* vt_ = (const char*)(Vh + (long)t_ * (KVBLK * LDK)); \
    __builtin_amdgcn_global_load_lds((const unsigned*)(kt_ + kofs), (LAS unsigned*)(kdl + (unsigned)(kb) * (unsigned)SHM_K), 16, 0, 0); \
    __builtin_amdgcn_global_load_lds((const unsigned*)(vt_ + vofs[0]), (LAS unsigned*)(vdl + (unsigned)(vbi) * (unsigned)SHM_V), 16, 0, 0); \
    __builtin_amdgcn_global_load_lds((const unsigned*)(vt_ + vofs[1]), (LAS unsigned*)(vdl + (unsigned)(vbi) * (unsigned)SHM_V + 8192u), 16, 0, 0); } while (0)
#define LAND() do { asm volatile("s_waitcnt vmcnt(3)" ::: "memory"); __builtin_amdgcn_s_barrier(); asm volatile("" ::: "memory"); } while (0)
#define KB(i) ((bf16_t*)((char*)K_lds + (i) * (int)SHM_K))
#ifndef ATT_QKV
#define ATT_QKV 6
#endif
#define QK_SCHED() do { _Pragma("unroll") for (int i_ = 0; i_ < 8; ++i_) { __builtin_amdgcn_sched_group_barrier(0x100, 1, 0); __builtin_amdgcn_sched_group_barrier(0x008, 1, 0); \
    __builtin_amdgcn_sched_group_barrier(0x002, ATT_QKV, 0); } } while (0)
  f32x16 pA, pB; float mnA, mnB, alA, alB; bf16x8 pa0, pa1;
  DMA(0, 0, 0); DMA(1, 1, 1); LAND();
  qkt(pA, KB(0), qr, r32, hi); partialSM(pA, m_reg, mnA, alA);
  DMA(2, 2, 2); LAND();
  int k1 = 1;
  for (int j = 1; j + 1 < NT; j += 2) {
    const int kA = k1, kB = (kA == 2 ? 0 : kA + 1), kC = (kB == 2 ? 0 : kB + 1);
    SBAR(); qkt_fsm(pB, KB(kA), qr, r32, hi, pA, alA, l_reg, pa0, pa1);
    DMA(j + 2, kC, (j + 2) & 3); SBAR();
    pv_all_sm(o[0], o[1], o[2], o[3], o[4], o[5], o[6], o[7], vb0 + ((j - 1) & 3) * (int)SHM_V, pa0, pa1, pB, m_reg, mnB, alB);
    LAND(); RESC(alB);
    SBAR(); qkt_fsm(pA, KB(kB), qr, r32, hi, pB, alB, l_reg, pa0, pa1);
    DMA(j + 3, kA, (j + 3) & 3); SBAR();
    pv_all_sm(o[0], o[1], o[2], o[3], o[4], o[5], o[6], o[7], vb0 + (j & 3) * (int)SHM_V, pa0, pa1, pA, m_reg, mnA, alA);
    LAND(); RESC(alA);
    k1 = kC;
  }
  SBAR(); qkt(pB, KB(k1), qr, r32, hi);
  finishSM(pA, alA, l_reg, pa0, pa1); SBAR();
  pv_all(o, vb0 + ((NT - 2) & 3) * (int)SHM_V, pa0, pa1); partialSM(pB, m_reg, mnB, alB);
  RESC(alB);
  finishSM(pB, alB, l_reg, pa0, pa1); SBAR();
  pv_all(o, vb0 + ((NT - 1) & 3) * (int)SHM_V, pa0, pa1);
  asm volatile("s_waitcnt vmcnt(0)" ::: "memory");
#undef DMA
#undef LAND
#undef KB
#undef QK_SCHED
#else
  const int sr = tid >> 4, sc = (tid & 15) * 8, vst0 = v_st(sr, sc), vst1 = v_st(sr, 128 + sc);
#ifndef ATT_KDMA
#define ATT_KDMA 1
#endif
#if ATT_KDMA
  struct { bf16x8 vs0, vs1; } sr_[SDEPTH];
  const int kdc = (((tid & 15) ^ (sr & 7)) << 3);
  const unsigned kdl = (unsigned)(uintptr_t)(LAS unsigned char*)K_lds + ((unsigned)__builtin_amdgcn_readfirstlane(wid) << 10);
#define KDMA(b, k0) __builtin_amdgcn_global_load_lds((const unsigned*)(Kh + (long)((k0) + sr) * LDK + kdc), (LAS unsigned*)(kdl + (b) * (unsigned)SHM_K), 16, 0, 0)
#define SLOAD(i, k0, b) do { sr_[i].vs0 = *reinterpret_cast<const bf16x8*>(&Vh[(long)((k0) + sr) * LDK + sc]); sr_[i].vs1 = *reinterpret_cast<const bf16x8*>(&Vh[(long)((k0) + sr) * LDK + 128 + sc]); KDMA(b, k0); } while (0)
#define SWRITE(b, i) do { *(bf16x8*)((char*)V_lds + (b) * SHM_V + vst0) = sr_[i].vs0;          \
    *(bf16x8*)((char*)V_lds + (b) * SHM_V + vst1) = sr_[i].vs1; } while (0)
#else
  struct { bf16x8 vs0, vs1, ks0; } sr_[SDEPTH];
#define SLOAD(i, k0, b) do { sr_[i].vs0 = *reinterpret_cast<const bf16x8*>(&Vh[(long)((k0) + sr) * LDK + sc]); sr_[i].vs1 = *reinterpret_cast<const bf16x8*>(&Vh[(long)((k0) + sr) * LDK + 128 + sc]); \
    sr_[i].ks0 = *reinterpret_cast<const bf16x8*>(&Kh[(long)((k0) + sr) * LDK + sc]); } while (0)
#define SWRITE(b, i) do { *(bf16x8*)((char*)V_lds + (b) * SHM_V + vst0) = sr_[i].vs0;          \
    *(bf16x8*)((char*)V_lds + (b) * SHM_V + vst1) = sr_[i].vs1;                                 \
    *(bf16x8*)((char*)K_lds + (b) * SHM_K + KSWZ(sr, sc * 2)) = sr_[i].ks0; } while (0)
#endif
#define SWAIT() do { if constexpr (SDEPTH == 2) asm volatile("s_waitcnt vmcnt(3)" ::: "memory"); else asm volatile("s_waitcnt vmcnt(0)" ::: "memory"); } while (0)
  f32x16 pA, pB; float mnA, mnB, alA, alB; bf16x8 pa0, pa1; const int NT = seq / KVBLK;
  constexpr int SE = 0, SO = SDEPTH - 1;
  SLOAD(SE, 0, 0); asm volatile("s_waitcnt vmcnt(0)" ::: "memory"); SWRITE(0, SE); __syncthreads();
  qkt(pA, K_lds, qr, r32, hi); partialSM(pA, m_reg, mnA, alA);
  SLOAD(SO, KVBLK, 1); if constexpr (SDEPTH == 2) { if (2 < NT) SLOAD(SE, 2 * KVBLK, 0); }
  SWAIT(); SWRITE(1, SO); __syncthreads();
  for (int j = 1; j + 1 < NT; j += 2) {
    SBAR(); qkt(pB, (bf16_t*)((char*)K_lds + SHM_K), qr, r32, hi);
    finishSM(pA, alA, l_reg, pa0, pa1); SBAR();
    SLOAD(SO, (j + SDEPTH) * KVBLK, 0); SBAR();
    pv_all(o, vb0, pa0, pa1); partialSM(pB, m_reg, mnB, alB);
    __syncthreads(); SWAIT(); SWRITE(0, SE);
    RESC(alB); __syncthreads();
    SBAR(); qkt(pA, K_lds, qr, r32, hi);
    finishSM(pB, alB, l_reg, pa0, pa1); SBAR();
    if (SDEPTH == 1 || j + 3 < NT) SLOAD(SE, (j + 1 + SDEPTH) * KVBLK, 1); SBAR();
    pv_all(o, vb0 + (int)SHM_V, pa0, pa1); partialSM(pA, m_reg, mnA, alA);
    __syncthreads(); SWAIT(); SWRITE(1, SO);
    RESC(alA); __syncthreads();
  }
  SBAR(); qkt(pB, (bf16_t*)((char*)K_lds + SHM_K), qr, r32, hi);
  finishSM(pA, alA, l_reg, pa0, pa1); SBAR();
  pv_all(o, vb0, pa0, pa1); partialSM(pB, m_reg, mnB, alB);
  __syncthreads(); RESC(alB);
  finishSM(pB, alB, l_reg, pa0, pa1); SBAR();
  pv_all(o, vb0 + (int)SHM_V, pa0, pa1);
#undef SLOAD
#undef SWRITE
#undef SWAIT
#ifdef KDMA
#undef KDMA
#endif
#endif
  if (hi == 0) li_l[r32] = l_reg; asm volatile("s_waitcnt lgkmcnt(0)" ::: "memory");
  float rli[16];
#pragma unroll
  for (int r = 0; r < 16; ++r) rli[r] = __builtin_amdgcn_rcpf(li_l[crow(r, hi)]);
  unsigned* Ow = Ob + (long)(wid * QBLK) * (LDO / 2);
#pragma unroll
  for (int r = 0; r < 16; ++r) { int orow = crow(r, hi);
    for (int k = 0; k < 4; ++k) Ow[(long)orow * (LDO / 2) + k * 32 + r32] = cvtpk(o[2 * k][r] * rli[r], o[2 * k + 1][r] * rli[r]); }
#undef RESC
}
#undef KSWZ
#undef SBAR
#undef QV
}

struct Args { const float* in[38]; float* out; unsigned char* ws; int ph_lo, ph_hi; };
enum { I_X = 0, I_C, I_CTX, I_CCTX, I_WADA, I_BADA, I_NORM1, I_NORM2, I_WIN, I_BGATE, I_QNORM, I_KNORM, I_LQ1, I_LK1, I_LQ2, I_LK2, I_SUBN, I_HCW, I_HCB,
       I_HW1, I_HB1, I_HW2, I_HB2, I_HW3, I_HB3, I_HW4, I_HFREQ, I_HBIAS, I_WBRA, I_WBRB, I_WOUT, I_FW1, I_FW3, I_FW2, I_ROUTER, I_MW1, I_MW3, I_MW2 };

struct Frame {
    LAS unsigned char* lds; char* ldsg;
    const float* const* in; float* out; unsigned char* ws;
    int tid, lane, wave, G, bid, gw, NGW;
};

__device__ __forceinline__ Frame enter(const Frame& F0) {
    Frame F = F0; __attribute__((address_space(1))) unsigned char* w = (__attribute__((address_space(1))) unsigned char*)F0.ws; asm volatile("" : "+s"(w)); F.ws = (unsigned char*)w;
    const int t = hw_tid(F0.wave); F.tid = t; F.lane = t & 63; return F;
}
__host__ __device__ __forceinline__ int qk_perm(int d) { const int axis = d >> 6, half = (d >> 5) & 1, f = d & 31; return 32 * (2 * axis + (f >> 4)) + 8 * ((f >> 2) & 3) + 4 * half + (f & 3); }
__device__ __forceinline__ void transpose_item(const float* W, int K, int N, bf16_t* WT, int kb, int nb, int dst_row0, LAS float* scr, int lane, bool qkperm = false) {
    const int k0 = 64 * kb, n0 = 32 * nb;
    { f32x4 v[8]; const float* wp = W + (size_t)(k0 + (lane >> 3)) * N + n0 + 4 * (lane & 7);
#pragma unroll
      for (int i = 0; i < 8; ++i) v[i] = __builtin_nontemporal_load((const f32x4*)(wp + (size_t)(8 * i) * N));
#pragma unroll
      for (int i = 0; i < 8; ++i) { LAS float* d = scr + (8 * i + (lane >> 3)) * 33 + 4 * (lane & 7); d[0] = v[i].x; d[1] = v[i].y; d[2] = v[i].z; d[3] = v[i].w; } }
    LDS_WAIT(); asm volatile("" ::: "memory");
    const int c = lane & 7;
#pragma unroll
    for (int j = 0; j < 4; ++j) { const int n = (lane >> 3) + 8 * j; const LAS float* s = scr + (8 * c) * 33 + n;
        u32x4 o; o.x = cvt_pk_bf16(s[0 * 33], s[1 * 33]); o.y = cvt_pk_bf16(s[2 * 33], s[3 * 33]); o.z = cvt_pk_bf16(s[4 * 33], s[5 * 33]); o.w = cvt_pk_bf16(s[6 * 33], s[7 * 33]);
        const int drow = qkperm ? ((n0 + n) & ~127) + qk_perm((n0 + n) & 127) : dst_row0 + n;
        __builtin_nontemporal_store(o, (u32x4*)(WT + (size_t)drow * K + k0 + 8 * c)); }
    LDS_WAIT(); asm volatile("" ::: "memory");
}
__device__ __forceinline__ float silu_f(float v) { return v / (1.f + __expf(-v)); }

namespace zt {
constexpr int L_WIN = 32 * 512, L_BR = 3 * 32 * 64, L_UP1 = 2 * 32 * 176, L_DN1 = 88 * 64;
constexpr int L_DENSE = L_WIN + L_BR + L_UP1 + L_DN1, L_MOE = L_WIN + L_BR + 8 * (L_UP1 + L_DN1);
constexpr int Z1 = L_DENSE, Z2 = Z1 + L_MOE, Z3 = Z2 + L_DENSE, ZEND = Z3 + L_MOE;
#ifndef ZT_NH
#define ZT_NH 16
#endif
#ifndef ZT_NI
#define ZT_NI 7
#endif
constexpr int BUSY = 32, WORKERS = (256 - BUSY) * NWAVES, CH = ZT_NH * WORKERS, CI = ZT_NI * WORKERS, CL = CH + CI;
constexpr int ZB0 = Z1, ZB1 = ZB0 + CL, ZB2 = Z2 + L_WIN + L_BR;
static_assert(ZB1 + CL <= Z2 && ZB2 + CL <= ZEND, "tail ranges");
__device__ __forceinline__ bool deferred(int G) { return G == 256 && CL > 0; }
}
__device__ __forceinline__ void transpose_z(const Frame& F, int z, LAS float* scr) {
    const int l = z < zt::Z1 ? 0 : (z < zt::Z2 ? 1 : (z < zt::Z3 ? 2 : 3)); int r = z - (l == 0 ? 0 : (l == 1 ? zt::Z1 : (l == 2 ? zt::Z2 : zt::Z3)));
    const float* src; bf16_t* dst; int K, N, kb, nb, dr; bool qp = false;
    if (r < zt::L_WIN) { kb = r / 512; nb = r % 512; const int n0 = 32 * nb; K = DM; N = NIN;
        dr = n0 < 6144 ? n0 : (n0 < 12288 ? NQKVG + (n0 - 6144) : 6144 + (n0 - 12288)); qp = n0 < 4096;
        src = F.in[I_WIN] + (size_t)l * DM * NIN; dst = (bf16_t*)(F.ws + WS_WIN) + (size_t)l * NIN * DM; }
    else if ((r -= zt::L_WIN) < zt::L_BR) { const int w = r / 2048, q = r % 2048; kb = q / 64; nb = q % 64; K = DM; N = DM; dr = 32 * nb;
        src = F.in[w == 0 ? I_WBRA : (w == 1 ? I_WBRB : I_WOUT)] + (size_t)l * DM * DM;
        dst = (bf16_t*)(F.ws + (w == 0 ? WS_WBRA : (w == 1 ? WS_WBRB : WS_WOUT))) + (size_t)l * DM * DM; }
    else { r -= zt::L_BR; const bool moe = (l & 1) != 0; const int ns = moe ? 8 : 1, slot0 = moe ? 2 + (l >> 1) * 8 : (l >> 1);
        if (r < ns * zt::L_UP1) { const int slot = slot0 + r / zt::L_UP1, q0 = r % zt::L_UP1, which = q0 / (32 * 176), q = q0 % (32 * 176); kb = q / 176; nb = q % 176; const int n0 = 32 * nb; K = DM; N = DFF;
            dr = (n0 / 128) * 256 + which * 128 + (n0 % 128);
            src = slot < 2 ? F.in[which ? I_FW3 : I_FW1] + (size_t)slot * DM * DFF : F.in[which ? I_MW3 : I_MW1] + (size_t)(slot - 2) * DM * DFF;
            dst = (bf16_t*)(F.ws + WS_WUP) + (size_t)slot * 2 * DFF * DM; }
        else { r -= ns * zt::L_UP1; const int slot = slot0 + r / zt::L_DN1, q = r % zt::L_DN1; kb = q / 64; nb = q % 64; K = DFF; N = DM; dr = 32 * nb;
            src = slot < 2 ? F.in[I_FW2] + (size_t)slot * DFF * DM : F.in[I_MW2] + (size_t)(slot - 2) * DFF * DM;
            dst = (bf16_t*)(F.ws + WS_WDN) + (size_t)slot * DM * DFF; } }
    transpose_item(src, K, N, dst, kb, nb, dr, scr, F.lane, qp);
}
__device__ __forceinline__ void phase_tail_transposes(const Frame& F0, int l, int which) {
    Frame F = enter(F0);
    if (!zt::deferred(F.G) || F.bid < zt::BUSY || l >= DEPTH - 1) return;
    LAS float* scr = (LAS float*)(F.lds + F.wave * 16384);
    const int zlo = (l == 0 ? zt::ZB0 : (l == 1 ? zt::ZB1 : zt::ZB2)) + (which ? zt::CH : 0), zhi = zlo + (which ? zt::CI : zt::CH);
    for (int z = zlo + (F.bid - zt::BUSY) * NWAVES + F.wave; z < zhi; z += zt::WORKERS) transpose_z(F, z, scr);
}
__device__ __forceinline__ void phase_prologue0(const Frame& F0) {
    Frame F = enter(F0);
    LAS float* scr = (LAS float*)(F.lds + F.wave * 16384);
    {
        const bool defer = zt::deferred(F.G);
        const int n0 = defer ? zt::ZB0 : zt::ZEND, n1 = defer ? zt::ZB2 - (zt::ZB1 + zt::CL) : 0, n2 = defer ? zt::ZEND - (zt::ZB2 + zt::CL) : 0, np = n0 + n1 + n2;
        for (int px = F.gw; px < np * ((PROBE == 4) ? 2 : 1); px += F.NGW) { const int p = px % np;
            const int z = p < n0 ? p : (p < n0 + n1 ? zt::ZB1 + zt::CL + (p - n0) : zt::ZB2 + zt::CL + (p - n0 - n1));
            transpose_z(F, z, scr); }
    }
    {
        LAS float* zb = (LAS float*)(F.lds + F.wave * 16384);
        const int l = F.gw & 3, j = F.lane;
        float w1c[33], w2c[64], w3c[64];
#pragma unroll
        for (int i = 0; i < 33; ++i) w1c[i] = F.in[I_HW1][((size_t)l * 33 + i) * 64 + j];
#pragma unroll
        for (int i = 0; i < 64; ++i) { w2c[i] = F.in[I_HW2][((size_t)l * 64 + i) * 64 + j]; w3c[i] = F.in[I_HW3][((size_t)l * 64 + i) * 64 + j]; }
        const float fr = F.in[I_HFREQ][l * 64 + j], b1 = F.in[I_HB1][l * 64 + j], b2 = F.in[I_HB2][l * 64 + j], b3 = F.in[I_HB3][l * 64 + j];
        const int nq = 4352 * ((PROBE == 12) ? 2 : 1);
        for (int qx = F.gw >> 2; qx < nq; qx += F.NGW >> 2) {
            const int q = qx % 4352; const int var = q >= 4096, t = var ? q - 4096 : q, L = var ? 256 : 4096;
            float z = 0.f;
            if (j == 0) z = (float)t / (float)(L - 1);
            else if (j < 33) { const int k = (j - 1) & 15; const float w = 6.283185307179586f * (float)t / (float)L; const float f = 1e-4f + (float)k * ((15.f - 1e-4f) / 15.f);
                z = (j < 17) ? cosf(w * f) : -sinf(w * f); }
            zb[j] = z; LDS_WAIT(); asm volatile("" ::: "memory");
            float a = b1;
#pragma unroll
            for (int i = 0; i < 33; ++i) a += zb[i] * w1c[i];
            float h = sinf(fr * a);
            zb[64 + j] = h; LDS_WAIT(); asm volatile("" ::: "memory");
            a = b2;
#pragma unroll
            for (int i = 0; i < 64; ++i) a += zb[64 + i] * w2c[i];
            h = sinf(fr * a);
            zb[j] = h; LDS_WAIT(); asm volatile("" ::: "memory");
            a = b3;
#pragma unroll
            for (int i = 0; i < 64; ++i) a += zb[i] * w3c[i];
            h = sinf(fr * a);
            float* dst = var ? (float*)(F.ws + WS_HIDC) + ((size_t)l * 256 + t) * 64 : (float*)(F.ws + WS_HID) + ((size_t)l * 4096 + t) * 64;
            dst[j] = h;
            LDS_WAIT(); asm volatile("" ::: "memory");
        }
    }
    if (F.bid == 0 && F.wave < 4) {
        const int l = F.wave; const int j = F.lane;
        float s1 = F.in[I_LQ1][l * 128 + j] * F.in[I_LK1][l * 128 + j] + F.in[I_LQ1][l * 128 + 64 + j] * F.in[I_LK1][l * 128 + 64 + j];
        float s2 = F.in[I_LQ2][l * 128 + j] * F.in[I_LK2][l * 128 + j] + F.in[I_LQ2][l * 128 + 64 + j] * F.in[I_LK2][l * 128 + 64 + j];
        s1 = wave_sum(s1, j); s2 = wave_sum(s2, j);
        const float lam_init = 0.8f - 0.6f * expf(-0.3f * (float)l);
        if (j == 0) ((float*)(F.ws + WS_LAM))[l] = expf(s1) - expf(s2) + lam_init;
    }
    if (F.bid == 1 % F.G) {
        for (int i = F.tid; i < 2048; i += NTHR) { const int pos = i >> 5, f = i & 31; const float inv = expf(-(float)f * (9.210340371976184f / 32.f)); const float ang = (float)pos * inv;
            ((float*)(F.ws + WS_ROPE))[i] = cosf(ang); ((float*)(F.ws + WS_ROPE))[2048 + i] = sinf(ang); }
    }
    __syncthreads();
    {
        LAS float* sv = (LAS float*)F.lds;
        LAS float* red = (LAS float*)(F.lds + 65536);
        bool have = false;
        const int half = F.lane >> 5, l4 = (F.lane & 31) * 4;
        for (int itx = F.bid; itx < 4 * 96 * ((PROBE == 13) ? 2 : 1); itx += F.G) { const int it = itx % (4 * 96);
            if (!have) { for (int i = F.tid; i < 5 * DM; i += NTHR) { const int v = i / DM, k = i % DM; const float cv = v < 4 ? F.in[I_C][v * DM + k] : F.in[I_CCTX][k]; sv[i] = silu_f(cv); } have = true; __syncthreads(); }
            const int l = it / 96, cc = it % 96;
            const float* W = F.in[I_WADA] + (size_t)l * DM * 12288 + cc * 128 + l4;
            f32x4 acc[5];
#pragma unroll
            for (int v = 0; v < 5; ++v) acc[v] = (f32x4){0.f, 0.f, 0.f, 0.f};
            const int k0 = F.wave * 256 + half;
#pragma unroll 8
            for (int kk = 0; kk < 128; ++kk) { const int k = k0 + 2 * kk; const f32x4 w = *(const f32x4*)(W + (size_t)k * 12288);
#pragma unroll
                for (int v = 0; v < 5; ++v) acc[v] += w * sv[v * DM + k]; }
#pragma unroll
            for (int v = 0; v < 5; ++v)
#pragma unroll
                for (int q = 0; q < 4; ++q) acc[v][q] += shx(acc[v][q], 32, F.lane);
            if (half == 0) {
#pragma unroll
                for (int v = 0; v < 5; ++v) *(LAS f32x4*)(red + (F.wave * 5 + v) * 128 + l4) = acc[v]; }
            __syncthreads();
            for (int i = F.tid; i < 5 * 128; i += NTHR) { const int v = i / 128, c = i % 128; float sm = 0.f;
#pragma unroll
                for (int w = 0; w < 8; ++w) sm += red[(w * 5 + v) * 128 + c];
                ((float*)(F.ws + WS_MOD))[((size_t)l * 5 + v) * 12288 + cc * 128 + c] = sm + F.in[I_BADA][l * 12288 + cc * 128 + c]; }
            __syncthreads();
        }
    }
}

__device__ __forceinline__ void split8(const float (&x)[8], bf16x8& hi, bf16x8& lo) {
    u32x4 h, l;
#pragma unroll
    for (int k = 0; k < 4; ++k) { const unsigned hw = cvt_pk_bf16(x[2 * k], x[2 * k + 1]); h[k] = hw; l[k] = cvt_pk_bf16(x[2 * k] - bf_lo(hw), x[2 * k + 1] - bf_hi(hw)); }
    hi = *reinterpret_cast<bf16x8*>(&h); lo = *reinterpret_cast<bf16x8*>(&l);
}
__device__ __forceinline__ void phase_prologue1(const Frame& F0) {
    Frame F = enter(F0);
    const int n = F.lane & 31, hi = F.lane >> 5;
    for (int it = F.gw; it < 4 * 256 * 2; it += F.NGW) {
        const int l = it >> 9, cb = (it >> 1) & 255, half = it & 1;
        const int col0 = cb * 32, f = col0 >> 12, dir = (col0 >> 11) & 1, c0 = col0 & 2047;
        const float* w4 = F.in[I_HW4] + (size_t)l * 64 * 8192 + col0 + n;
        bf16x8 Ah[4], Al[4];
#pragma unroll
        for (int ks = 0; ks < 4; ++ks) { float xv[8];
#pragma unroll
            for (int i = 0; i < 8; ++i) xv[i] = w4[(size_t)(16 * ks + 8 * hi + i) * 8192];
            split8(xv, Ah[ks], Al[ks]); }
        const float da = -3.0701134573253945f, db = -15.350567286626972f;
#pragma unroll
        for (int var = 0; var < 2; ++var) {
            if (var == 1 && half != 0) continue;
            const int L = var ? 256 : 4096, ntb = var ? 8 : 64, tb0 = var ? 0 : half * 64;
            const float invL = 1.f / (float)(L - 1);
            float base[16], step[16];
#pragma unroll
            for (int r = 0; r < 16; ++r) { const int ch = c0 + (r & 3) + 8 * (r >> 2) + 4 * hi; const float delta = fabsf(da + (float)ch * ((db - da) / 2047.f));
                base[r] = expf(-delta * (float)(tb0 * 32 + n) * invL); step[r] = expf(-delta * 32.f * invL); }
            const float* hsrc = (var ? (const float*)(F.ws + WS_HIDC) + (size_t)l * 256 * 64 : (const float*)(F.ws + WS_HID) + (size_t)l * 4096 * 64) + (size_t)(tb0 * 32 + n) * 64 + 8 * hi;
            bf16_t* Rl = var ? (bf16_t*)(F.ws + WS_RC) + (((size_t)l * 2 + f) * 2048 + c0 + 4 * hi) * 1024 + 512 : (bf16_t*)(F.ws + WS_R) + (((size_t)l * 2 + f) * 2048 + c0 + 4 * hi) * 8704 + 4352;
            const int rstride = var ? 1024 : 8704;
            f32x4 hn[8];
#pragma unroll
            for (int ks = 0; ks < 4; ++ks) { hn[2 * ks] = *(const f32x4*)(hsrc + 16 * ks); hn[2 * ks + 1] = *(const f32x4*)(hsrc + 16 * ks + 4); }
            for (int tb = 0; tb < ntb; ++tb) {
                f32x16 acc = f32x16{};
                f32x4 hc[8];
#pragma unroll
                for (int k = 0; k < 8; ++k) hc[k] = hn[k];
                { const int tn = tb + 1 < ntb ? tb + 1 : tb;
#pragma unroll
                  for (int ks = 0; ks < 4; ++ks) { hn[2 * ks] = *(const f32x4*)(hsrc + (size_t)tn * 2048 + 16 * ks); hn[2 * ks + 1] = *(const f32x4*)(hsrc + (size_t)tn * 2048 + 16 * ks + 4); } }
#pragma unroll
                for (int ks = 0; ks < 4; ++ks) { const f32x4 b0 = hc[2 * ks], b1 = hc[2 * ks + 1];
                    const float xv[8] = {b0.x, b0.y, b0.z, b0.w, b1.x, b1.y, b1.z, b1.w}; bf16x8 Bh, Bl; split8(xv, Bh, Bl);
                    acc = __builtin_amdgcn_mfma_f32_32x32x16_bf16(Ah[ks], Bh, acc, 0, 0, 0);
                    acc = __builtin_amdgcn_mfma_f32_32x32x16_bf16(Ah[ks], Bl, acc, 0, 0, 0);
                    acc = __builtin_amdgcn_mfma_f32_32x32x16_bf16(Al[ks], Bh, acc, 0, 0, 0); }
                const int t = (tb0 + tb) * 32 + n;
#pragma unroll
                for (int r = 0; r < 16; ++r) { const float val = acc[r] * base[r]; base[r] *= step[r];
                    bf16_t* Rr = Rl + (size_t)((r & 3) + 8 * (r >> 2)) * rstride;
                    const bf16_t bv = (bf16_t)(cvt_pk_bf16(val, 0.f) & 0xffffu);
                    if (dir == 0) Rr[-t] = bv; else if (t >= 1) Rr[t] = bv; }
            }
        }
    }
    for (int it = F.gw; it < 4 * 2 * 2048; it += F.NGW) {
        bf16_t* R = (bf16_t*)(F.ws + WS_R) + (size_t)it * 8704; bf16_t* Rc = (bf16_t*)(F.ws + WS_RC) + (size_t)it * 1024;
        for (int x = F.lane; x < 257; x += 64) { R[x] = 0; Rc[x] = 0; }
        for (int x = F.lane; x < 256; x += 64) { R[8448 + x] = 0; Rc[768 + x] = 0; }
    }
}

__device__ __forceinline__ void ffn_row_load(Frame& F, int lp, int row, f32x4 (&f)[8]) {
    const bf16_t* ys = (const bf16_t*)(F.ws + AR_YS);
    if ((lp & 1) == 0) {
        if (row < ML) { const u32x2* p = (const u32x2*)(ys + (size_t)row * DM) + F.lane;
#pragma unroll
            for (int j = 0; j < 8; ++j) { const u32x2 w = __builtin_nontemporal_load(p + 64 * j); f[j] = (f32x4){bf_lo(w.x), bf_hi(w.x), bf_lo(w.y), bf_hi(w.y)}; }
        } else { const f32x4* p = (const f32x4*)((const float*)(F.ws + AR_YSC) + (size_t)(row - ML) * DM) + F.lane;
#pragma unroll
            for (int j = 0; j < 8; ++j) f[j] = ((p[64 * j] + p[64 * j + MC * DM / 4]) + p[64 * j + 2 * (MC * DM / 4)]) + p[64 * j + 3 * (MC * DM / 4)]; }
    } else {
        const int* ti = (const int*)(F.ws + WS_TOK) + (size_t)row * 8;
        const int e1 = ti[0], p1 = ti[1], e2 = ti[2], p2 = ti[3]; const float w1 = __int_as_float(ti[4]), w2 = __int_as_float(ti[5]);
        const unsigned* cnt = (const unsigned*)(F.ws + WS_CTL) + CW_CNT + (lp >> 1) * 8 * 64;
        int s1 = 0, s2 = 0;
#pragma unroll
        for (int e = 0; e < 8; ++e) { const int tl = ((int)cnt[e * 64] + 255) >> 8; s1 += (e < e1) ? tl : 0; s2 += (e < e2) ? tl : 0; }
        const u32x2* pa = (const u32x2*)(ys + (size_t)(s1 * 256 + p1) * DM) + F.lane;
        const u32x2* pb = (const u32x2*)(ys + (size_t)(s2 * 256 + p2) * DM) + F.lane;
#pragma unroll
        for (int j = 0; j < 8; ++j) { const u32x2 a = __builtin_nontemporal_load(pa + 64 * j), b = __builtin_nontemporal_load(pb + 64 * j);
            f[j] = (f32x4){w1 * bf_lo(a.x) + w2 * bf_lo(b.x), w1 * bf_hi(a.x) + w2 * bf_hi(b.x), w1 * bf_lo(a.y) + w2 * bf_lo(b.y), w1 * bf_hi(a.y) + w2 * bf_hi(b.y)}; }
    }
}
__device__ __forceinline__ void fill_mod_tables(const Frame& F, LAS f32x4* tab, const float* shift, const float* scale) {
    for (int i = F.tid; i < 4 * 512; i += NTHR) { const int v = i >> 9, c = i & 511;
        const f32x4 sc = *((const f32x4*)(scale + (size_t)v * 12288) + c), sh = *((const f32x4*)(shift + (size_t)v * 12288) + c);
        tab[(v * 2 + 0) * 512 + c] = sc + 1.f; tab[(v * 2 + 1) * 512 + c] = sh; }
}
__device__ __forceinline__ void phase_normmod1(const Frame& F0, int l, int npass = 1) {
    Frame F = enter(F0);
#pragma nounroll
    for (int pass = 0; pass < npass; ++pass) { const bool dry = pass + 1 < npass;
    float* X = (float*)(F.ws + WS_X); bf16_t* H = (bf16_t*)(F.ws + (dry ? AR_O : AR_H)); float* Xw = dry ? (float*)(F.ws + AR_O + 68 * MiB) : X;
    const float* mod = (const float*)(F.ws + WS_MOD);
    LAS f32x4* mtab = (LAS f32x4*)F.lds; LAS f32x4* g2tab = (LAS f32x4*)(F.lds + 65536);
    fill_mod_tables(F, mtab, mod + (size_t)l * 5 * 12288, mod + (size_t)l * 5 * 12288 + DM);
    if (l != 0) for (int i = F.tid; i < 4 * 512; i += NTHR) g2tab[i] = *((const f32x4*)(mod + ((size_t)(l - 1) * 5 + (i >> 9)) * 12288 + 5 * DM) + (i & 511));
    LAS f32x4* gtab = (LAS f32x4*)(F.lds + 98304);
    for (int i = F.tid; i < 512; i += NTHR) gtab[i] = *((const f32x4*)(F.in[I_NORM1] + (size_t)l * DM) + i);
    __syncthreads();
    f32x4 xn[8];
    { const int row = F.gw; const f32x4* src = (const f32x4*)(l == 0 ? (row < ML ? F.in[I_X] + (size_t)row * DM : F.in[I_CTX] + (size_t)(row - ML) * DM) : X + (size_t)row * DM) + F.lane;
#pragma unroll
      for (int j = 0; j < 8; ++j) xn[j] = src[64 * j]; }
    for (int row = F.gw; row < MT; row += F.NGW) {
        const int v = row < ML ? row / SEQ : 4;
        f32x4 x[8];
#pragma unroll
        for (int j = 0; j < 8; ++j) x[j] = xn[j];
        { const int rn = row + F.NGW < MT ? row + F.NGW : row;
          const f32x4* src = (const f32x4*)(l == 0 ? (rn < ML ? F.in[I_X] + (size_t)rn * DM : F.in[I_CTX] + (size_t)(rn - ML) * DM) : X + (size_t)rn * DM) + F.lane;
#pragma unroll
          for (int j = 0; j < 8; ++j) xn[j] = __builtin_nontemporal_load(src + 64 * j); }
        if (l != 0) {
            const f32x4* g2 = (const f32x4*)(mod + ((size_t)(l - 1) * 5 + v) * 12288 + 5 * DM) + F.lane;
            f32x4 f[8]; ffn_row_load(F, l - 1, row, f);
#pragma unroll
            for (int j = 0; j < 8; ++j) x[j] = x[j] + (v < 4 ? g2tab[v * 512 + F.lane + 64 * j] : g2[64 * j]) * f[j];
        }
        { f32x4* dst = (f32x4*)(Xw + (size_t)row * DM) + F.lane;
#pragma unroll
            for (int j = 0; j < 8; ++j) __builtin_nontemporal_store(x[j], dst + 64 * j); }
        float ss = 0.f;
#pragma unroll
        for (int j = 0; j < 8; ++j) ss += (x[j].x * x[j].x + x[j].y * x[j].y) + (x[j].z * x[j].z + x[j].w * x[j].w);
        const float rstd = 1.f / sqrtf(wave_sum(ss, F.lane) * (1.f / DM) + EPS);
        const f32x4* gn = (const f32x4*)(F.in[I_NORM1] + (size_t)l * DM) + F.lane;
        const f32x4* sh = (const f32x4*)(mod + ((size_t)l * 5 + v) * 12288) + F.lane;
        const f32x4* sc = (const f32x4*)(mod + ((size_t)l * 5 + v) * 12288 + DM) + F.lane;
        u32x2* o = (u32x2*)(H + (size_t)row * DM) + F.lane;
#pragma unroll
        for (int j = 0; j < 8; ++j) { const f32x4 y = (x[j] * rstd) * gtab[F.lane + 64 * j];
            const f32x4 h = v < 4 ? y * mtab[(v * 2) * 512 + F.lane + 64 * j] + mtab[(v * 2 + 1) * 512 + F.lane + 64 * j] : y * (sc[64 * j] + 1.f) + sh[64 * j];
            u32x2 w; w.x = cvt_pk_bf16(h.x, h.y); w.y = cvt_pk_bf16(h.z, h.w); o[64 * j] = w; }
    }
    }
}
__device__ __forceinline__ void phase_final(const Frame& F0) {
    Frame F = enter(F0);
    const float* X = (const float*)(F.ws + WS_X); const float* mod = (const float*)(F.ws + WS_MOD);
    LAS f32x4* g2tab = (LAS f32x4*)F.lds;
    for (int i = F.tid; i < 4 * 512; i += NTHR) g2tab[i] = *((const f32x4*)(mod + ((size_t)3 * 5 + (i >> 9)) * 12288 + 5 * DM) + (i & 511));
    __syncthreads();
    for (int row = F.gw; row < ML; row += F.NGW) {
        const int v = row / SEQ;
        const f32x4* src = (const f32x4*)(X + (size_t)row * DM) + F.lane;
        f32x4 f[8]; ffn_row_load(F, 3, row, f);
        f32x4* dst = (f32x4*)(F.out + (size_t)row * DM) + F.lane;
#pragma unroll
        for (int j = 0; j < 8; ++j) __builtin_nontemporal_store(__builtin_nontemporal_load(src + 64 * j) + g2tab[v * 512 + F.lane + 64 * j] * f[j], dst + 64 * j);
    }
}
__device__ __forceinline__ void phase_normmod2(const Frame& F0, int l) {
    Frame F = enter(F0);
    const float* X = (const float*)(F.ws + WS_X); const float* mod = (const float*)(F.ws + WS_MOD);
    const bool moe = (l & 1) != 0; const int nrows = (l == DEPTH - 1) ? ML : MT;
    bf16_t* H = (bf16_t*)(F.ws + AR_H); bf16_t* H2S = (bf16_t*)(F.ws + AR_H2S);
    unsigned* cnt = (unsigned*)(F.ws + WS_CTL) + CW_CNT + (l >> 1) * 8 * 64;
    const float* router = F.in[I_ROUTER] + (size_t)(l >> 1) * DM * 8;
    if (moe) {
        LAS f32x4* rl = (LAS f32x4*)F.lds; const f32x4* rg = (const f32x4*)router;
        for (int idx = F.tid; idx < 4096; idx += NTHR) { const int k = idx >> 1, h = idx & 1, ln = (k >> 2) & 63, j = k >> 8, i = k & 3; rl[(h * 32 + j * 4 + i) * 64 + ln] = rg[idx]; }
        __syncthreads(); }
    LAS f32x4* mtab = (LAS f32x4*)(F.lds + 65536);
    fill_mod_tables(F, mtab, mod + (size_t)l * 5 * 12288 + 3 * DM, mod + (size_t)l * 5 * 12288 + 4 * DM);
    f32x4 gnr[8];
#pragma unroll
    for (int j = 0; j < 8; ++j) gnr[j] = *((const f32x4*)(F.in[I_NORM2] + (size_t)l * DM) + F.lane + 64 * j);
    __syncthreads();
    f32x4 xn[8];
    { const f32x4* src = (const f32x4*)(X + (size_t)(F.gw < nrows ? F.gw : 0) * DM) + F.lane;
#pragma unroll
      for (int j = 0; j < 8; ++j) xn[j] = src[64 * j]; }
    for (int row = F.gw; row < nrows; row += F.NGW) {
        const int v = row < ML ? row / SEQ : 4;
        f32x4 x[8]; float ss = 0.f;
#pragma unroll
        for (int j = 0; j < 8; ++j) { x[j] = xn[j]; ss += (x[j].x * x[j].x + x[j].y * x[j].y) + (x[j].z * x[j].z + x[j].w * x[j].w); }
        { const int rn = row + F.NGW < nrows ? row + F.NGW : row; const f32x4* src = (const f32x4*)(X + (size_t)rn * DM) + F.lane;
#pragma unroll
          for (int j = 0; j < 8; ++j) xn[j] = __builtin_nontemporal_load(src + 64 * j); }
        const float rstd = 1.f / sqrtf(wave_sum(ss, F.lane) * (1.f / DM) + EPS);
        const f32x4* gn = (const f32x4*)(F.in[I_NORM2] + (size_t)l * DM) + F.lane;
        const f32x4* sh = (const f32x4*)(mod + ((size_t)l * 5 + v) * 12288 + 3 * DM) + F.lane;
        const f32x4* sc = (const f32x4*)(mod + ((size_t)l * 5 + v) * 12288 + 4 * DM) + F.lane;
        u32x2 hw[8];
#pragma unroll
        for (int j = 0; j < 8; ++j) {
            const f32x4 y = (x[j] * rstd) * gnr[j];
            if (v < 4) x[j] = y * mtab[(v * 2) * 512 + F.lane + 64 * j] + mtab[(v * 2 + 1) * 512 + F.lane + 64 * j];
            else x[j] = y * (sc[64 * j] + 1.f) + sh[64 * j];
            hw[j].x = cvt_pk_bf16(x[j].x, x[j].y); hw[j].y = cvt_pk_bf16(x[j].z, x[j].w); }
        if (!moe) {
            u32x2* o = (u32x2*)(H + (size_t)row * DM) + F.lane;
#pragma unroll
            for (int j = 0; j < 8; ++j) o[64 * j] = hw[j];
        } else {
            float lg[8];
#pragma unroll
            for (int e = 0; e < 8; ++e) lg[e] = 0.f;
#pragma unroll
            for (int j = 0; j < 8; ++j) {
                const LAS f32x4* rp = (const LAS f32x4*)F.lds + (j * 4) * 64 + F.lane;
#pragma unroll
                for (int i = 0; i < 4; ++i) { const f32x4 r0 = rp[i * 64], r1 = rp[(32 + i) * 64]; const float xv = x[j][i];
                    lg[0] += xv * r0.x; lg[1] += xv * r0.y; lg[2] += xv * r0.z; lg[3] += xv * r0.w; lg[4] += xv * r1.x; lg[5] += xv * r1.y; lg[6] += xv * r1.z; lg[7] += xv * r1.w; }
            }
#pragma unroll
            for (int e = 0; e < 8; ++e) lg[e] = wave_sum(lg[e], F.lane);
            float v1 = lg[0]; int i1 = 0;
#pragma unroll
            for (int e = 1; e < 8; ++e) if (lg[e] > v1) { v1 = lg[e]; i1 = e; }
            float v2 = -3.0e38f; int i2 = -1;
#pragma unroll
            for (int e = 0; e < 8; ++e) if (e != i1 && lg[e] > v2) { v2 = lg[e]; i2 = e; }
            const float w2 = 1.f / (1.f + expf(v1 - v2)), w1 = 1.f - w2;
            int p1 = 0, p2 = 0;
            if (F.lane == 0) { p1 = (int)__hip_atomic_fetch_add(cnt + i1 * 64, 1u, __ATOMIC_RELAXED, __HIP_MEMORY_SCOPE_AGENT); p2 = (int)__hip_atomic_fetch_add(cnt + i2 * 64, 1u, __ATOMIC_RELAXED, __HIP_MEMORY_SCOPE_AGENT); }
            p1 = __builtin_amdgcn_readfirstlane(p1); p2 = __builtin_amdgcn_readfirstlane(p2);
            if (F.lane == 0) { int* ti = (int*)(F.ws + WS_TOK) + (size_t)row * 8; ti[0] = i1; ti[1] = p1; ti[2] = i2; ti[3] = p2; ti[4] = __float_as_int(w1); ti[5] = __float_as_int(w2); }
            u32x2* oa = (u32x2*)(H2S + ((size_t)i1 * CAP + p1) * DM) + F.lane;
            u32x2* ob = (u32x2*)(H2S + ((size_t)i2 * CAP + p2) * DM) + F.lane;
#pragma unroll
            for (int j = 0; j < 8; ++j) { oa[64 * j] = hw[j]; ob[64 * j] = hw[j]; }
        }
    }
}
__device__ __forceinline__ void phase_combine_transpose(const Frame& F0, int l) {
    Frame F = enter(F0);
    const bool last = (l == DEPTH - 1); const int nrows = last ? ML : MT;
    const unsigned* O = (const unsigned*)(F.ws + AR_O); bf16_t* YA = (bf16_t*)(F.ws + AR_YAN);
    const float lam = ((const float*)(F.ws + WS_LAM))[l];
    const float lam_init = 0.8f - 0.6f * expf(-0.3f * (float)l);
    const int c0 = 64 * (F.lane >> 4) + 2 * (F.lane & 15);
    const float* gs = F.in[I_SUBN] + l * 256;
    const float g00 = gs[c0], g01 = gs[c0 + 32], g10 = gs[c0 + 1], g11 = gs[c0 + 33];
    for (int it = F.gw; it < nrows * 8; it += F.NGW) {
        const int row = it >> 3, d = it & 7;
        const u32x2 a = __builtin_nontemporal_load((const u32x2*)(O + (size_t)row * 2048 + (2 * d) * 128) + F.lane), b = __builtin_nontemporal_load((const u32x2*)(O + (size_t)row * 2048 + (2 * d + 1) * 128) + F.lane);
        const float o00 = bf_lo(a.x) - lam * bf_lo(b.x), o01 = bf_hi(a.x) - lam * bf_hi(b.x), o10 = bf_lo(a.y) - lam * bf_lo(b.y), o11 = bf_hi(a.y) - lam * bf_hi(b.y);
        const float ss = wave_sum((o00 * o00 + o01 * o01) + (o10 * o10 + o11 * o11), F.lane);
        const float rstd = (1.f - lam_init) / sqrtf(ss * (1.f / 256.f) + EPS);
        bf16_t* yp = YA + (size_t)row * DM + d * 256 + c0;
        *(unsigned*)yp = cvt_pk_bf16(o00 * rstd * g00, o10 * rstd * g10);
        *(unsigned*)(yp + 32) = cvt_pk_bf16(o01 * rstd * g01, o11 * rstd * g11);
    }
    const bf16_t* YBT = (const bf16_t*)(F.ws + AR_YBT); bf16_t* YB = (bf16_t*)(F.ws + AR_YB);
    LAS bf16_t* scr = (LAS bf16_t*)(F.lds + F.wave * 16384);
    const int ntt = nrows / 64;
    for (int it = F.gw; it < 32 * ntt; it += F.NGW) {
        const int cb = it / ntt, tb = it % ntt;
#pragma unroll
        for (int i = 0; i < 8; ++i) { const int c = 8 * i + (F.lane >> 3), tq = F.lane & 7;
            const u32x4 w = *(const u32x4*)(YBT + (size_t)(cb * 64 + c) * MT + tb * 64 + tq * 8);
            LAS unsigned* d = (LAS unsigned*)(scr + c * 66 + tq * 8); d[0] = w.x; d[1] = w.y; d[2] = w.z; d[3] = w.w; }
        LDS_WAIT(); asm volatile("" ::: "memory");
#pragma unroll
        for (int i = 0; i < 8; ++i) { const int t = 8 * i + (F.lane >> 3), cq = F.lane & 7;
            unsigned short e[8];
#pragma unroll
            for (int k = 0; k < 8; ++k) e[k] = scr[(cq * 8 + k) * 66 + t];
            u32x4 o; o.x = e[0] | ((unsigned)e[1] << 16); o.y = e[2] | ((unsigned)e[3] << 16); o.z = e[4] | ((unsigned)e[5] << 16); o.w = e[6] | ((unsigned)e[7] << 16);
            *(u32x4*)(YB + (size_t)(tb * 64 + t) * DM + cb * 64 + cq * 8) = o; }
        LDS_WAIT(); asm volatile("" ::: "memory");
    }
}

namespace hy {
constexpr int UST = 4616, UBYTES = 4 * UST * 2, RLEN = 8704, RBYTES = RLEN * 2, CH_BYTES = UBYTES + RBYTES;
__device__ __forceinline__ int crow(int r, int hi) { return (r & 3) + 8 * (r >> 2) + 4 * hi; }

__device__ __forceinline__ void conv_pass(const LAS unsigned char* U, const LAS unsigned char* R, int j0, int lane, f32x16 (&acc)[4]) {
    const int n = lane & 31, hi = lane >> 5, b = n & 3, qp = n >> 2;
#pragma unroll
    for (int j = 0; j < 4; ++j) acc[j] = f32x16{};
    const int xl = 4352 - n + 8 * hi - 256 * j0 - 768;
    const unsigned sh = (unsigned)(xl & 1) << 4;
    const int ub = (b * UST + 256 + 32 * qp + 8 * hi) * 2;
#ifndef HY_PF
#define HY_PF 1
#endif
    for (int dp = 0; dp < 16; ++dp) {
        const LAS unsigned char* pG = U + ub - 32 * dp;
        const LAS unsigned* pA = (const LAS unsigned*)R + ((xl - 16 * dp) >> 1);
        bf16x8 Gw[6];
        unsigned ra[HY_PF + 1][5];
#pragma unroll
        for (int p = 0; p < HY_PF; ++p) {
            Gw[p] = *(const LAS bf16x8*)(pG + 512 * p);
#pragma unroll
            for (int k = 0; k < 5; ++k) ra[p][k] = pA[128 * p + k];
        }
#pragma unroll
        for (int e2 = 0; e2 < 20; ++e2) {
            if (e2 + HY_PF < 20) {
#pragma unroll
                for (int k = 0; k < 5; ++k) ra[(e2 + HY_PF) % (HY_PF + 1)][k] = pA[128 * (e2 + HY_PF) + k];
                if (e2 + HY_PF <= 16) Gw[(e2 + HY_PF) % 6] = *(const LAS bf16x8*)(pG + 512 * (e2 + HY_PF));
            }
            const unsigned (&rc)[5] = ra[e2 % (HY_PF + 1)];
            u32x4 w; w.x = __builtin_amdgcn_alignbit(rc[1], rc[0], sh); w.y = __builtin_amdgcn_alignbit(rc[2], rc[1], sh); w.z = __builtin_amdgcn_alignbit(rc[3], rc[2], sh); w.w = __builtin_amdgcn_alignbit(rc[4], rc[3], sh);
            const bf16x8 A = *reinterpret_cast<const bf16x8*>(&w);
#pragma unroll
            for (int j = 0; j < 4; ++j) { const int J = j + e2 - 3; if (J >= 0 && J <= 16) acc[j] = __builtin_amdgcn_mfma_f32_32x32x16_bf16(A, Gw[J % 6], acc[j], 0, 0, 0); }
            __builtin_amdgcn_sched_barrier(0);
        }
    }
}

__device__ __forceinline__ void conv4(const bf16_t* seq, int s0, int Ls, float w0, float w1, float w2, float bb, float (&y)[4]) {
    const u32x2 w = *(const u32x2*)(seq + s0);
    const float l = s0 > 0 ? bf2f(seq[s0 - 1]) : 0.f, r = (s0 + 4 < Ls) ? bf2f(seq[s0 + 4]) : 0.f;
    const float x0 = bf_lo(w.x), x1 = bf_hi(w.x), x2 = bf_lo(w.y), x3 = bf_hi(w.y);
    y[0] = l * w0 + x0 * w1 + x1 * w2 + bb; y[1] = x0 * w0 + x1 * w1 + x2 * w2 + bb; y[2] = x1 * w0 + x2 * w1 + x3 * w2 + bb; y[3] = x2 * w0 + x3 * w1 + r * w2 + bb;
}
__device__ __forceinline__ u32x4 conv8_pk(const bf16_t* seq, int s0, int Ls, float w0, float w1, float w2, float bb) {
    const u32x4 w = *(const u32x4*)(seq + s0);
    const float left = s0 > 0 ? bf2f(seq[s0 - 1]) : 0.f, right = (s0 + 8 < Ls) ? bf2f(seq[s0 + 8]) : 0.f;
    const float xv[10] = {left, bf_lo(w.x), bf_hi(w.x), bf_lo(w.y), bf_hi(w.y), bf_lo(w.z), bf_hi(w.z), bf_lo(w.w), bf_hi(w.w), right};
    float y[8];
#pragma unroll
    for (int k = 0; k < 8; ++k) y[k] = xv[k] * w0 + xv[k + 1] * w1 + xv[k + 2] * w2 + bb;
    u32x4 o; o.x = cvt_pk_bf16(y[0], y[1]); o.y = cvt_pk_bf16(y[2], y[3]); o.z = cvt_pk_bf16(y[4], y[5]); o.w = cvt_pk_bf16(y[6], y[7]); return o;
}
typedef unsigned u32x4_a4 __attribute__((ext_vector_type(4), aligned(4)));
__device__ __forceinline__ u32x4 conv4_load(const bf16_t* seq, int s0) { const u32x4_a4 w = *(const u32x4_a4*)(seq + s0 - 2); return (u32x4){w.x, w.y, w.z, w.w}; }
__device__ __forceinline__ void conv4_eval(const u32x4 w, int s0, int Ls, float w0, float w1, float w2, float bb, float (&y)[4]) {
    const float l = s0 > 0 ? bf_hi(w.x) : 0.f, r = (s0 + 4 < Ls) ? bf_lo(w.w) : 0.f;
    const float x0 = bf_lo(w.y), x1 = bf_hi(w.y), x2 = bf_lo(w.z), x3 = bf_hi(w.z);
    y[0] = l * w0 + x0 * w1 + x1 * w2 + bb; y[1] = x0 * w0 + x1 * w1 + x2 * w2 + bb; y[2] = x1 * w0 + x2 * w1 + x3 * w2 + bb; y[3] = x2 * w0 + x3 * w1 + r * w2 + bb;
}
struct Conv8Raw { u32x4 w; unsigned lw, rw; };
__device__ __forceinline__ Conv8Raw conv8_load(const bf16_t* seq, int s0) { Conv8Raw r; r.w = *(const u32x4*)(seq + s0); r.lw = *(const unsigned*)(seq + s0 - 2); r.rw = *(const unsigned*)(seq + s0 + 8); return r; }
__device__ __forceinline__ u32x4 conv8_eval(const Conv8Raw& q, int s0, int Ls, float w0, float w1, float w2, float bb) {
    const u32x4 w = q.w;
    const float left = s0 > 0 ? bf_hi(q.lw) : 0.f, right = (s0 + 8 < Ls) ? bf_lo(q.rw) : 0.f;
    const float xv[10] = {left, bf_lo(w.x), bf_hi(w.x), bf_lo(w.y), bf_hi(w.y), bf_lo(w.z), bf_hi(w.z), bf_lo(w.w), bf_hi(w.w), right};
    float y[8];
#pragma unroll
    for (int k = 0; k < 8; ++k) y[k] = xv[k] * w0 + xv[k + 1] * w1 + xv[k + 2] * w2 + bb;
    u32x4 o; o.x = cvt_pk_bf16(y[0], y[1]); o.y = cvt_pk_bf16(y[2], y[3]); o.z = cvt_pk_bf16(y[4], y[5]); o.w = cvt_pk_bf16(y[6], y[7]); return o;
}
struct ConvW { float w0, w1, w2, bb; };
__device__ __forceinline__ ConvW conv_w(const Frame& F, int l, int cc) {
    ConvW w; w.w0 = F.in[I_HCW][((size_t)l * 3 + 0) * HYW + cc]; w.w1 = F.in[I_HCW][((size_t)l * 3 + 1) * HYW + cc]; w.w2 = F.in[I_HCW][((size_t)l * 3 + 2) * HYW + cc]; w.bb = F.in[I_HCB][(size_t)l * HYW + cc]; return w;
}

__device__ __forceinline__ void pair_body(Frame& F, int l, int c0, bool first) {
    const int tidq = opaque(F.tid); const int ch = F.wave >> 2, j0 = 4 * (F.wave & 3), c = c0 + ch, ltid = tidq & 255, lane = tidq & 63;
    LAS unsigned char* U = F.lds + ch * CH_BYTES; LAS unsigned char* R = U + UBYTES;
    const bf16_t* uT = (const bf16_t*)(F.ws + AR_UT);
    const bf16_t* vrow = uT + (size_t)c * MT, *x1row = uT + (size_t)(2048 + c) * MT, *x2row = uT + (size_t)(4096 + c) * MT;
    const bf16_t* Rg = (const bf16_t*)(F.ws + WS_R) + (((size_t)l * 2 + 0) * 2048 + c) * RLEN;
    const bf16_t* Rg2 = (const bf16_t*)(F.ws + WS_R) + (((size_t)l * 2 + 1) * 2048 + c) * RLEN;
    const float bias0 = F.in[I_HBIAS][((size_t)l * 2 + 0) * 2048 + c], bias1 = F.in[I_HBIAS][((size_t)l * 2 + 1) * 2048 + c];
    if (first) {
        for (int i = ltid; i < 4 * 65; i += 256) { const int b = i / 65, k = i % 65; const int el = k < 32 ? k * 8 : 4352 + (k - 32) * 8;
            *(LAS u32x4*)(U + (b * UST + el) * 2) = (u32x4){0u, 0u, 0u, 0u}; }
    }
    { const ConvW cw = conv_w(F, l, c); Conv8Raw raw[8];
#pragma unroll
      for (int k = 0; k < 8; ++k) { const int q = ltid + 256 * k, tok = 8 * q, b = tok >> 12, s = tok & 4095; raw[k] = conv8_load(vrow + b * SEQ, s); }
#pragma unroll
      for (int k = 0; k < 8; ++k) { const int q = ltid + 256 * k, tok = 8 * q, b = tok >> 12, s = tok & 4095;
        *(LAS u32x4*)(U + (b * UST + 256 + s) * 2) = conv8_eval(raw[k], s, SEQ, cw.w0, cw.w1, cw.w2, cw.bb); } }
    { u32x4 rr[5];
#pragma unroll
      for (int k = 0; k < 5; ++k) { const int q = ltid + 256 * k; if (q < RBYTES / 16) rr[k] = *(const u32x4*)((const char*)Rg + q * 16); }
#pragma unroll
      for (int k = 0; k < 5; ++k) { const int q = ltid + 256 * k; if (q < RBYTES / 16) *(LAS u32x4*)(R + q * 16) = rr[k]; } }
    __syncthreads();
    f32x16 acc[4];
    conv_pass(U, R, j0, lane, acc);
    const int n = lane & 31, hi = lane >> 5, b = n & 3, qp = n >> 2;
    u32x2 zp[4][4];
    { const ConvW cw = conv_w(F, l, 2048 + c); u32x4 xr[4][4];
#pragma unroll
    for (int j = 0; j < 4; ++j)
#pragma unroll
        for (int g = 0; g < 4; ++g) xr[j][g] = conv4_load(x1row + b * SEQ, 32 * (8 * (j0 + j) + qp) + 8 * g + 4 * hi);
#pragma unroll
    for (int j = 0; j < 4; ++j)
#pragma unroll
        for (int g = 0; g < 4; ++g) {
            const int t0 = 32 * (8 * (j0 + j) + qp) + 8 * g + 4 * hi;
            const u32x2 vv = *(const LAS u32x2*)(U + (b * UST + 256 + t0) * 2);
            float xx[4]; conv4_eval(xr[j][g], t0, SEQ, cw.w0, cw.w1, cw.w2, cw.bb, xx);
            const float z0 = xx[0] * (acc[j][4 * g + 0] + bias0 * bf_lo(vv.x)), z1 = xx[1] * (acc[j][4 * g + 1] + bias0 * bf_hi(vv.x));
            const float z2 = xx[2] * (acc[j][4 * g + 2] + bias0 * bf_lo(vv.y)), z3 = xx[3] * (acc[j][4 * g + 3] + bias0 * bf_hi(vv.y));
            zp[j][g].x = cvt_pk_bf16(z0, z1); zp[j][g].y = cvt_pk_bf16(z2, z3);
        } }
    __syncthreads();
#pragma unroll
    for (int j = 0; j < 4; ++j)
#pragma unroll
        for (int g = 0; g < 4; ++g) { const int t0 = 32 * (8 * (j0 + j) + qp) + 8 * g + 4 * hi; *(LAS u32x2*)(U + (b * UST + 256 + t0) * 2) = zp[j][g]; }
    { u32x4 rr[5];
#pragma unroll
      for (int k = 0; k < 5; ++k) { const int q = ltid + 256 * k; if (q < RBYTES / 16) rr[k] = *(const u32x4*)((const char*)Rg2 + q * 16); }
#pragma unroll
      for (int k = 0; k < 5; ++k) { const int q = ltid + 256 * k; if (q < RBYTES / 16) *(LAS u32x4*)(R + q * 16) = rr[k]; } }
    __syncthreads();
    conv_pass(U, R, j0, lane, acc);
    bf16_t* yrow = (bf16_t*)(F.ws + AR_YBT) + (size_t)c * MT;
    { const ConvW cw = conv_w(F, l, 4096 + c); u32x4 xr[4][4];
#pragma unroll
    for (int j = 0; j < 4; ++j)
#pragma unroll
        for (int g = 0; g < 4; ++g) xr[j][g] = conv4_load(x2row + b * SEQ, 32 * (8 * (j0 + j) + qp) + 8 * g + 4 * hi);
#pragma unroll
    for (int j = 0; j < 4; ++j)
#pragma unroll
        for (int g = 0; g < 4; ++g) {
            const int t0 = 32 * (8 * (j0 + j) + qp) + 8 * g + 4 * hi;
            const u32x2 zz = *(const LAS u32x2*)(U + (b * UST + 256 + t0) * 2);
            float xx[4]; conv4_eval(xr[j][g], t0, SEQ, cw.w0, cw.w1, cw.w2, cw.bb, xx);
            const float y0 = xx[0] * (acc[j][4 * g + 0] + bias1 * bf_lo(zz.x)), y1 = xx[1] * (acc[j][4 * g + 1] + bias1 * bf_hi(zz.x));
            const float y2 = xx[2] * (acc[j][4 * g + 2] + bias1 * bf_lo(zz.y)), y3 = xx[3] * (acc[j][4 * g + 3] + bias1 * bf_hi(zz.y));
            u32x2 o; o.x = cvt_pk_bf16(y0, y1); o.y = cvt_pk_bf16(y2, y3);
            *(u32x2*)(yrow + b * SEQ + t0) = o;
        } }
    __syncthreads();
}
constexpr int UCST = 776, UCBYTES = 4 * UCST * 2;
__device__ __forceinline__ f32x16 ctx_conv_pass(const LAS unsigned char* U, const LAS unsigned char* R, int lane) {
    const int n = lane & 31, hi = lane >> 5, b = n & 3, qp = n >> 2;
    f32x16 acc = f32x16{};
    const int xl = 512 + 240 - n + 8 * hi;
    const unsigned sh = (unsigned)(xl & 1) << 4;
    const LAS unsigned* pA = (const LAS unsigned*)R + (xl >> 1);
    const LAS unsigned char* pG = U + (b * UCST + 256 + 240 + 32 * qp + 8 * hi) * 2;
#pragma unroll
    for (int e = 0; e < 31; ++e) {
        const LAS unsigned* p = pA - 8 * e;
        const unsigned d0 = p[0], d1 = p[1], d2 = p[2], d3 = p[3], d4 = p[4];
        u32x4 w; w.x = __builtin_amdgcn_alignbit(d1, d0, sh); w.y = __builtin_amdgcn_alignbit(d2, d1, sh); w.z = __builtin_amdgcn_alignbit(d3, d2, sh); w.w = __builtin_amdgcn_alignbit(d4, d3, sh);
        const bf16x8 G = *(const LAS bf16x8*)(pG - 32 * e);
        acc = __builtin_amdgcn_mfma_f32_32x32x16_bf16(*reinterpret_cast<const bf16x8*>(&w), G, acc, 0, 0, 0);
    }
    return acc;
}
__device__ __forceinline__ void ctx_body(Frame& F, int l, int c) {
    const int lane = opaque(F.tid) & 63;
    LAS unsigned char* U = F.lds + F.wave * 16384; LAS unsigned char* R = U + UCBYTES;
    const bf16_t* uT = (const bf16_t*)(F.ws + AR_UT);
    const bf16_t* vrow = uT + (size_t)c * MT + ML, *x1row = uT + (size_t)(2048 + c) * MT + ML, *x2row = uT + (size_t)(4096 + c) * MT + ML;
    const bf16_t* R1 = (const bf16_t*)(F.ws + WS_RC) + (((size_t)l * 2 + 0) * 2048 + c) * 1024, *R2 = (const bf16_t*)(F.ws + WS_RC) + (((size_t)l * 2 + 1) * 2048 + c) * 1024;
    const float bias0 = F.in[I_HBIAS][((size_t)l * 2 + 0) * 2048 + c], bias1 = F.in[I_HBIAS][((size_t)l * 2 + 1) * 2048 + c];
    for (int i = lane; i < 4 * 65; i += 64) { const int b = i / 65, k = i % 65; const int el = k < 32 ? k * 8 : 512 + (k - 32) * 8;
        *(LAS u32x4*)(U + (b * UCST + el) * 2) = (u32x4){0u, 0u, 0u, 0u}; }
    { const ConvW cw = conv_w(F, l, c);
#pragma unroll
      for (int k = 0; k < 2; ++k) { const int q = lane + 64 * k, b = q >> 5, s = (q & 31) * 8;
        *(LAS u32x4*)(U + (b * UCST + 256 + s) * 2) = conv8_pk(vrow + b * LC, s, LC, cw.w0, cw.w1, cw.w2, cw.bb); } }
#pragma unroll
    for (int k = 0; k < 2; ++k) *(LAS u32x4*)(R + (lane + 64 * k) * 16) = *(const u32x4*)((const char*)R1 + (lane + 64 * k) * 16);
    LDS_WAIT(); asm volatile("" ::: "memory");
    f32x16 acc = ctx_conv_pass(U, R, lane);
    const int n = lane & 31, hi = lane >> 5, b = n & 3, qp = n >> 2;
    u32x2 zp[4];
    { const ConvW cw = conv_w(F, l, 2048 + c);
#pragma unroll
      for (int g = 0; g < 4; ++g) { const int t0 = 32 * qp + 8 * g + 4 * hi;
        const u32x2 vv = *(const LAS u32x2*)(U + (b * UCST + 256 + t0) * 2);
        float xx[4]; conv4(x1row + b * LC, t0, LC, cw.w0, cw.w1, cw.w2, cw.bb, xx);
        zp[g].x = cvt_pk_bf16(xx[0] * (acc[4 * g + 0] + bias0 * bf_lo(vv.x)), xx[1] * (acc[4 * g + 1] + bias0 * bf_hi(vv.x)));
        zp[g].y = cvt_pk_bf16(xx[2] * (acc[4 * g + 2] + bias0 * bf_lo(vv.y)), xx[3] * (acc[4 * g + 3] + bias0 * bf_hi(vv.y))); } }
    LDS_WAIT(); asm volatile("" ::: "memory");
#pragma unroll
    for (int g = 0; g < 4; ++g) { const int t0 = 32 * qp + 8 * g + 4 * hi; *(LAS u32x2*)(U + (b * UCST + 256 + t0) * 2) = zp[g]; }
#pragma unroll
    for (int k = 0; k < 2; ++k) *(LAS u32x4*)(R + (lane + 64 * k) * 16) = *(const u32x4*)((const char*)R2 + (lane + 64 * k) * 16);
    LDS_WAIT(); asm volatile("" ::: "memory");
    acc = ctx_conv_pass(U, R, lane);
    bf16_t* yrow = (bf16_t*)(F.ws + AR_YBT) + (size_t)c * MT + ML;
    { const ConvW cw = conv_w(F, l, 4096 + c);
#pragma unroll
      for (int g = 0; g < 4; ++g) { const int t0 = 32 * qp + 8 * g + 4 * hi;
        const u32x2 zz = *(const LAS u32x2*)(U + (b * UCST + 256 + t0) * 2);
        float xx[4]; conv4(x2row + b * LC, t0, LC, cw.w0, cw.w1, cw.w2, cw.bb, xx);
        u32x2 o; o.x = cvt_pk_bf16(xx[0] * (acc[4 * g + 0] + bias1 * bf_lo(zz.x)), xx[1] * (acc[4 * g + 1] + bias1 * bf_hi(zz.x)));
        o.y = cvt_pk_bf16(xx[2] * (acc[4 * g + 2] + bias1 * bf_lo(zz.y)), xx[3] * (acc[4 * g + 3] + bias1 * bf_hi(zz.y)));
        *(u32x2*)(yrow + b * LC + t0) = o; } }
    LDS_WAIT(); asm volatile("" ::: "memory");
}
}

__device__ __forceinline__ void phase_mixers(const Frame& F0, int l) {
    Frame F = enter(F0);
    const bool last = (l == DEPTH - 1);
    const bf16_t* Q = (const bf16_t*)(F.ws + AR_Q); const bf16_t* Kc = (const bf16_t*)(F.ws + AR_KC); const bf16_t* Vc = (const bf16_t*)(F.ws + AR_VC); unsigned* O = (unsigned*)(F.ws + AR_O);
#ifndef NO_ATT
    const int nitems = NB * 16 * 16 + (last ? 0 : NB * 16);
    const int nrep_a = (PROBE == 1) ? 2 : 1;
    for (int itx = F.bid; itx < nitems * nrep_a; itx += F.G) { const int it = itx % nitems;
        int h, b, seq; size_t row0;
        if (it < 1024) {
            const int x = it & 7, rk = (it >> 3) & 31, qb = rk & 15; h = 2 * x + (rk >> 4); b = it >> 8; row0 = (size_t)b * SEQ + qb * 256; seq = SKV; }
        else { const int i2 = it - 1024; h = i2 & 15; b = i2 >> 4; row0 = (size_t)ML + b * LC; seq = LC; }
        att::attn_dense_body(Q + row0 * DM + h * 128, Kc + (size_t)b * SKV * DM + h * 128, Vc + (size_t)b * SKV * DM + (h >> 1) * 256, O + row0 * 2048 + h * 128, seq, F.ldsg, F.wave);
        __syncthreads();
    }
#endif
#ifndef NO_HY
    bool first = true;
    const int nrep_h = (PROBE == 2) ? 2 : 1;
    for (int itx = F.bid; itx < 1024 * nrep_h; itx += F.G) { const int it = itx & 1023; hy::pair_body(F, l, 2 * it, first); first = false; }
#ifndef NO_HYC
    if (!last) for (int cx = F.gw; cx < 2048 * ((PROBE == 9) ? 2 : 1); cx += F.NGW) { const int c = cx & 2047; hy::ctx_body(F, l, c); }
#endif
#endif
}

using pg8::Unit;
constexpr int HALF = 128;
struct EpiBf16Plain {
    static constexpr bool PERM = true, CARRY = false;
    bf16_t* O; int ldc;
    __device__ __forceinline__ void operator()(const f32x4 (&acc)[2][2][4][2], const Unit& u, int wr, int wc, int fr, int fq) const {
        const int row0 = u.pm * 256 + wr * 64 + fr, col0 = u.pn * 256 + wc * 32 + 8 * fq;
#pragma unroll
        for (int ai = 0; ai < 2; ++ai)
#pragma unroll
            for (int m = 0; m < 4; ++m) { bf16_t* rowp = O + (size_t)(row0 + ai * HALF + m * 16) * ldc + col0;
#pragma unroll
                for (int bj = 0; bj < 2; ++bj) { const f32x4 v0 = acc[ai][bj][m][0], v1 = acc[ai][bj][m][1];
                    u32x4 w; w.x = cvt_pk_bf16(v0[0], v0[1]); w.y = cvt_pk_bf16(v0[2], v0[3]); w.z = cvt_pk_bf16(v1[0], v1[1]); w.w = cvt_pk_bf16(v1[2], v1[3]);
                    __builtin_nontemporal_store(w, (u32x4*)(rowp + bj * HALF)); } }
    }
};
struct EpiInProj {
    static constexpr bool PERM = true, CARRY = false;
    bf16_t *Q, *K, *V, *G; const float* bgate; const float* qgain; const float* kgain; const LAS float* rope; LAS unsigned char* lds;
    __device__ __forceinline__ void operator()(const f32x4 (&acc)[2][2][4][2], const Unit& u, int wr, int wc, int fr, int fq) const {
        const int pn = u.pn;
        if (pn < 16) {
            const bool isk = pn >= 8; const bool lat = u.pm < 64;
            LAS float* P = (LAS float*)lds;
#pragma unroll
            for (int ai = 0; ai < 2; ++ai)
#pragma unroll
                for (int m = 0; m < 4; ++m)
#pragma unroll
                    for (int bj = 0; bj < 2; ++bj) { const f32x4 a = acc[ai][bj][m][0], b = acc[ai][bj][m][1];
                        float ss = (a[0] * a[0] + a[1] * a[1]) + (a[2] * a[2] + a[3] * a[3]) + (b[0] * b[0] + b[1] * b[1]) + (b[2] * b[2] + b[3] * b[3]);
                        ss += shx(ss, 16, fr + 16 * fq); ss += shx(ss, 32, fr + 16 * fq);
                        if (fq == 0) P[((wr * 2 + bj) * 128 + ai * 64 + m * 16 + fr) * 4 + wc] = ss; }
            asm volatile("s_waitcnt lgkmcnt(0)" ::: "memory"); __builtin_amdgcn_s_barrier(); asm volatile("" ::: "memory");
            const int axis = wc >> 1, f0 = 16 * (wc & 1) + 4 * fq, d0 = 64 * axis + f0;
            const float* gp = isk ? kgain : qgain;
            const f32x4 g0 = *(const f32x4*)(gp + d0), g1 = *(const f32x4*)(gp + d0 + 32);
            const int rowt = isk ? (lat ? (u.pm >> 4) * SKV + LC + (u.pm & 15) * 256 : (u.pm - 64) * SKV) : u.pm * 256;
            bf16_t* base = (isk ? K : Q) + (size_t)(rowt + wr * 64 + fr) * DM + (isk ? pn - 8 : pn) * 256 + wc * 32 + 8 * fq;
#pragma unroll
            for (int ai = 0; ai < 2; ++ai)
#pragma unroll
                for (int m = 0; m < 4; ++m) {
                    f32x4 cs = (f32x4){1.f, 1.f, 1.f, 1.f}, sn = (f32x4){0.f, 0.f, 0.f, 0.f};
                    if (lat) { const int pos = axis ? (16 * m + fr) : (4 * (u.pm & 15) + 2 * ai + wr); cs = *(const LAS f32x4*)(rope + pos * 32 + f0); sn = *(const LAS f32x4*)(rope + 2048 + pos * 32 + f0); }
#pragma unroll
                    for (int bj = 0; bj < 2; ++bj) {
                        const f32x4 pp = *(const LAS f32x4*)(P + ((wr * 2 + bj) * 128 + ai * 64 + m * 16 + fr) * 4);
                        const float rstd = __builtin_amdgcn_rsqf(((pp[0] + pp[1]) + (pp[2] + pp[3])) * (1.f / 128.f) + EPS);
                        const f32x4 a = (acc[ai][bj][m][0] * rstd) * g0, b = (acc[ai][bj][m][1] * rstd) * g1;
                        const f32x4 ra = a * cs - b * sn, rb = a * sn + b * cs;
                        u32x4 w; w.x = cvt_pk_bf16(ra[0], ra[1]); w.y = cvt_pk_bf16(ra[2], ra[3]); w.z = cvt_pk_bf16(rb[0], rb[1]); w.w = cvt_pk_bf16(rb[2], rb[3]);
                        *(u32x4*)(base + (size_t)(ai * HALF + m * 16) * DM + bj * HALF) = w; } }
            return;
        }
        bf16_t* basep; int ldc = DM, colt; int rowt = u.pm * 256; const bool gate = pn >= 24;
        if (pn < 24) { basep = V; colt = (pn - 16) * 256; rowt = u.pm < 64 ? (u.pm >> 4) * SKV + LC + (u.pm & 15) * 256 : (u.pm - 64) * SKV; }
        else { basep = G; colt = (pn - 24) * 256; ldc = 4096; }
        const int row0 = rowt + wr * 64 + fr, col0 = colt + wc * 32 + 8 * fq;
        f32x4 bv[2][2];
#pragma unroll
        for (int bj = 0; bj < 2; ++bj)
#pragma unroll
            for (int n = 0; n < 2; ++n) bv[bj][n] = gate ? *(const f32x4*)(bgate + col0 + bj * HALF + 4 * n) : (f32x4){0.f, 0.f, 0.f, 0.f};
#pragma unroll
        for (int ai = 0; ai < 2; ++ai)
#pragma unroll
            for (int m = 0; m < 4; ++m) { bf16_t* rowp = basep + (size_t)(row0 + ai * HALF + m * 16) * ldc + col0;
#pragma unroll
                for (int bj = 0; bj < 2; ++bj) { f32x4 v0 = acc[ai][bj][m][0] + bv[bj][0], v1 = acc[ai][bj][m][1] + bv[bj][1];
                    if (gate) { v0 = v0 * -1.4426950408889634f; v1 = v1 * -1.4426950408889634f;
#pragma unroll
                        for (int i = 0; i < 4; ++i) { v0[i] = __builtin_amdgcn_exp2f(v0[i]); v1[i] = __builtin_amdgcn_exp2f(v1[i]); }
                        v0 = v0 + 1.f; v1 = v1 + 1.f;
#pragma unroll
                        for (int i = 0; i < 4; ++i) { v0[i] = __builtin_amdgcn_rcpf(v0[i]); v1[i] = __builtin_amdgcn_rcpf(v1[i]); } }
                    u32x4 w; w.x = cvt_pk_bf16(v0[0], v0[1]); w.y = cvt_pk_bf16(v0[2], v0[3]); w.z = cvt_pk_bf16(v1[0], v1[1]); w.w = cvt_pk_bf16(v1[2], v1[3]);
                    *(u32x4*)(rowp + bj * HALF) = w; } }
    }
};
struct EpiMergePair {
    static constexpr bool PERM = true, CARRY = true;
    const bf16_t* gates; bf16_t* Mo;
    __device__ __forceinline__ bool carry(f32x4 (&acc)[2][2][4][2], const Unit& u, int wr, int wc, int fr, int fq) const {
        const int row0 = u.pm * 256 + wr * 64 + fr, col0 = u.pn * 256 + wc * 32 + 8 * fq;
        const bf16_t* gbase = gates + (size_t)row0 * 4096 + col0;
#define MP_ROW(i) ((size_t)((((i) >> 3) * HALF) + (((i) >> 1) & 3) * 16))
#define MP_G(i, off) (*(const u32x4*)(gbase + MP_ROW(i) * 4096 + ((i) & 1) * HALF + (off)))
#define MP_UNPK(WV, FV) const float FV[8] = {bf_lo(WV.x), bf_hi(WV.x), bf_lo(WV.y), bf_hi(WV.y), bf_lo(WV.z), bf_hi(WV.z), bf_lo(WV.w), bf_hi(WV.w)}
        if (u.kind == 0) {
            u32x4 ga_[2][4], gb_[2][4];
#pragma unroll
            for (int k = 0; k < 4; ++k) { ga_[0][k] = MP_G(k, 0); gb_[0][k] = MP_G(k, DM); }
#pragma unroll
            for (int b = 0; b < 4; ++b) {
                if (b + 1 < 4) {
#pragma unroll
                    for (int k = 0; k < 4; ++k) { ga_[(b + 1) & 1][k] = MP_G(4 * (b + 1) + k, 0); gb_[(b + 1) & 1][k] = MP_G(4 * (b + 1) + k, DM); } }
#pragma unroll
                for (int k = 0; k < 4; ++k) { const int i = 4 * b + k, ai = i >> 3, m = (i >> 1) & 3, bj = i & 1;
                    MP_UNPK(ga_[b & 1][k], ga); MP_UNPK(gb_[b & 1][k], gb);
#pragma unroll
                    for (int e = 0; e < 4; ++e) { acc[ai][bj][m][0][e] *= ga[e] * __builtin_amdgcn_rcpf(gb[e]); acc[ai][bj][m][1][e] *= ga[4 + e] * __builtin_amdgcn_rcpf(gb[4 + e]); } }
            }
            return true;
        }
        u32x4 gb_[2][4];
#pragma unroll
        for (int k = 0; k < 4; ++k) gb_[0][k] = MP_G(k, DM);
        bf16_t* mbase = Mo + (size_t)row0 * DM + col0;
#pragma unroll
        for (int b = 0; b < 4; ++b) {
            if (b + 1 < 4) {
#pragma unroll
                for (int k = 0; k < 4; ++k) gb_[(b + 1) & 1][k] = MP_G(4 * (b + 1) + k, DM); }
#pragma unroll
            for (int k = 0; k < 4; ++k) { const int i = 4 * b + k, ai = i >> 3, m = (i >> 1) & 3, bj = i & 1;
                MP_UNPK(gb_[b & 1][k], gb); const f32x4 v0 = acc[ai][bj][m][0], v1 = acc[ai][bj][m][1];
                u32x4 w; w.x = cvt_pk_bf16(v0[0] * gb[0], v0[1] * gb[1]); w.y = cvt_pk_bf16(v0[2] * gb[2], v0[3] * gb[3]); w.z = cvt_pk_bf16(v1[0] * gb[4], v1[1] * gb[5]); w.w = cvt_pk_bf16(v1[2] * gb[6], v1[3] * gb[7]);
                *(u32x4*)(mbase + MP_ROW(i) * DM + bj * HALF) = w; }
        }
        return false;
#undef MP_ROW
#undef MP_G
#undef MP_UNPK
    }
};
struct EpiInProjDual {
    static constexpr bool PERM = true, CARRY = false;
    EpiInProj e1; EpiBf16Plain e2;
    __device__ __forceinline__ void operator()(const f32x4 (&acc)[2][2][4][2], const Unit& u, int wr, int wc, int fr, int fq) const { if (u.kind == 0) e1(acc, u, wr, wc, fr, fq); else e2(acc, u, wr, wc, fr, fq); }
};
struct EpiOut {
    static constexpr bool PERM = false, CARRY = false;
    float* X; const float* mod_l;
    __device__ __forceinline__ void operator()(const f32x4 (&acc)[2][2][4][2], const Unit& u, int wr, int wc, int fr, int fq) const {
        const int row0 = u.pm * 256 + wr * 64 + fr, col0 = u.pn * 256 + wc * 32 + 4 * fq;
        const int v = u.pm < 64 ? (u.pm >> 4) : 4; const float* g1 = mod_l + (size_t)v * 12288 + 2 * DM;
        f32x4 gv[2][2];
#pragma unroll
        for (int bj = 0; bj < 2; ++bj)
#pragma unroll
            for (int n = 0; n < 2; ++n) gv[bj][n] = *(const f32x4*)(g1 + col0 + bj * HALF + n * 16);
        float* base = X + (size_t)row0 * DM + col0;
        f32x4 xa[8], xb[8];
#define EO_P(b, c, bj, n) ((f32x4*)(base + (size_t)((((2 * (b) + (c)) >> 2) * HALF) + ((2 * (b) + (c)) & 3) * 16) * DM + (bj) * HALF + (n) * 16))
#define EO_LOAD(b, dst) do { _Pragma("unroll") for (int c = 0; c < 2; ++c) _Pragma("unroll") for (int bj = 0; bj < 2; ++bj) _Pragma("unroll") for (int n = 0; n < 2; ++n) dst[c * 4 + bj * 2 + n] = *EO_P(b, c, bj, n); } while (0)
#define EO_STORE(b, src) do { _Pragma("unroll") for (int c = 0; c < 2; ++c) _Pragma("unroll") for (int bj = 0; bj < 2; ++bj) _Pragma("unroll") for (int n = 0; n < 2; ++n) \
        *EO_P(b, c, bj, n) = src[c * 4 + bj * 2 + n] + gv[bj][n] * acc[(2 * (b) + c) >> 2][bj][(2 * (b) + c) & 3][n]; } while (0)
        EO_LOAD(0, xa);
        EO_LOAD(1, xb); EO_STORE(0, xa);
        EO_LOAD(2, xa); EO_STORE(1, xb);
        EO_LOAD(3, xb); EO_STORE(2, xa);
        EO_STORE(3, xb);
#undef EO_P
#undef EO_LOAD
#undef EO_STORE
    }
};
struct EpiDownSlab {
    static constexpr bool PERM = false, CARRY = false;
    float* YSC;
    __device__ __forceinline__ void operator()(const f32x4 (&acc)[2][2][4][2], const Unit& u, int wr, int wc, int fr, int fq) const {
        const int row0 = (u.pm - 64) * 256 + wr * 64 + fr, col0 = u.pn * 256 + wc * 32 + 4 * fq; float* base = YSC + (size_t)u.kind * MC * DM;
#pragma unroll
        for (int ai = 0; ai < 2; ++ai)
#pragma unroll
            for (int m = 0; m < 4; ++m)
#pragma unroll
                for (int bj = 0; bj < 2; ++bj)
#pragma unroll
                    for (int n = 0; n < 2; ++n) *(f32x4*)(base + (size_t)(row0 + ai * HALF + m * 16) * DM + col0 + bj * HALF + n * 16) = acc[ai][bj][m][n];
    }
};
struct EpiUp {
    static constexpr bool PERM = true, CARRY = false;
    bf16_t* act;
    __device__ __forceinline__ void operator()(const f32x4 (&acc)[2][2][4][2], const Unit& u, int wr, int wc, int fr, int fq) const {
        const int row0 = u.pm * 256 + wr * 64 + fr, col0 = u.pn * 128 + wc * 32 + 8 * fq;
#pragma unroll
        for (int ai = 0; ai < 2; ++ai)
#pragma unroll
            for (int m = 0; m < 4; ++m) { bf16_t* rowp = act + (size_t)(row0 + ai * HALF + m * 16) * DFF + col0;
                f32x4 r[2];
#pragma unroll
                for (int n = 0; n < 2; ++n) {
                    const f32x4 a = acc[ai][0][m][n], ab = a * acc[ai][1][m][n]; f32x4 t = a * -1.4426950408889634f;
#pragma unroll
                    for (int i = 0; i < 4; ++i) t[i] = __builtin_amdgcn_exp2f(t[i]);
                    t = t + 1.f;
#pragma unroll
                    for (int i = 0; i < 4; ++i) t[i] = __builtin_amdgcn_rcpf(t[i]);
                    r[n] = ab * t; }
                u32x4 w; w.x = cvt_pk_bf16(r[0][0], r[0][1]); w.y = cvt_pk_bf16(r[0][2], r[0][3]); w.z = cvt_pk_bf16(r[1][0], r[1][1]); w.w = cvt_pk_bf16(r[1][2], r[1][3]);
                __builtin_nontemporal_store(w, (u32x4*)rowp); }
    }
};

__device__ __forceinline__ void moe_tables(const Frame& F0, int l) {
    Frame F = enter(F0);
    LAS int* tab = (LAS int*)(F.lds + LDS_TAB);
    if (F.tid == 0) { const unsigned* cnt = (const unsigned*)(F.ws + WS_CTL) + CW_CNT + (l >> 1) * 8 * 64; int p = 0;
        for (int e = 0; e < 8; ++e) { const int t = ((int)__hip_atomic_load(cnt + e * 64, __ATOMIC_RELAXED, __HIP_MEMORY_SCOPE_AGENT) + 255) >> 8; tab[e] = t; tab[8 + e] = p; p += t; }
        tab[16] = p; }
    __syncthreads();
}

constexpr int PH_PER_LAYER = 9, N_PHASES = 2 + DEPTH * PH_PER_LAYER + 1;

__global__ void __launch_bounds__(NTHR, 2) mega(Args args) {
    extern __shared__ __attribute__((aligned(16))) unsigned char lds_raw[];
    Frame F0;
    F0.lds = (LAS unsigned char*)lds_raw; F0.ldsg = (char*)lds_raw;
    F0.in = args.in; F0.out = args.out; F0.ws = args.ws;
    F0.tid = threadIdx.x; F0.lane = F0.tid & 63; F0.wave = __builtin_amdgcn_readfirstlane(F0.tid >> 6);
    F0.G = gridDim.x; F0.bid = blockIdx.x; F0.gw = F0.bid * NWAVES + F0.wave; F0.NGW = F0.G * NWAVES;
    volatile LAS unsigned* MISC = (volatile LAS unsigned*)(F0.lds + LDS_TAB + 1024);
    if (F0.tid < 8) MISC[F0.tid] = 0u;
    __syncthreads();
#if MK_ONE_LAUNCH
    XcdBarrier bar = xcd_barrier_post((unsigned*)(F0.ws + WS_CTL) + CW_BAR, MISC, F0.wave);
#define GRID_BAR() xcd_barrier(bar)
#else
#define GRID_BAR() do {} while (0)
#endif
    const int lo = args.ph_lo, hi = args.ph_hi;
#ifndef AUDIT
#define AUDIT -1
#endif
#define INA(a, k) ((AUDIT < 0 || AUDIT == (a)) && lo <= (k) && (k) < hi)
#define IN(k) (lo <= (k) && (k) < hi)
#define INL(j) INA(2 + (j), pb + (j))
#define SEAM(k) do { if (IN((k) + 1)) { GRID_BAR(); if (PROBE == 15) GRID_BAR(); } } while (0)
    if (INA(0, 0)) { phase_prologue0(F0); SEAM(0); }
    if (INA(1, 1)) { phase_prologue1(F0); if (PROBE == 8) { GRID_BAR(); phase_prologue1(F0); } SEAM(1); }
    for (int l = 0; l < DEPTH; ++l) {
        const int pb = 2 + l * PH_PER_LAYER; const bool last = (l == DEPTH - 1);
        if (INL(0)) { phase_normmod1(F0, l, PROBE == 14 ? 2 : 1); SEAM(pb + 0); }
        if (INL(1)) { Frame F = enter(F0);
            const bf16_t* W = (const bf16_t*)(F.ws + WS_WIN) + (size_t)l * NIN * DM;
            { LAS f32x4* rl = (LAS f32x4*)(F.lds + LDS_ROPE); const f32x4* rg = (const f32x4*)(F.ws + WS_ROPE); for (int i = F.tid; i < 1024; i += NTHR) rl[i] = rg[i]; __syncthreads(); }
            pg8::DualOrder S; S.S1.init(F.ws + AR_H, W, MT, NQKVG, DM, F.G, F.bid, 1, WGM_INP); S.S2.init(W + (size_t)NQKVG * DM, F.ws + AR_H, HYW, MT, DM, F.G, F.bid, 1, WGM_INP);
            EpiInProjDual E{EpiInProj{(bf16_t*)(F.ws + AR_Q), (bf16_t*)(F.ws + AR_KC), (bf16_t*)(F.ws + AR_VC), (bf16_t*)(F.ws + AR_GATE), F.in[I_BGATE] + (size_t)l * 4096,
                          F.in[I_QNORM] + l * 128, F.in[I_KNORM] + l * 128, (const LAS float*)(F.lds + LDS_ROPE), F.lds + LDS_EPI}, EpiBf16Plain{(bf16_t*)(F.ws + AR_UT), MT}};
            pg8::gemm_phase(F.lds, F.wave, DM, S, E);
            SEAM(pb + 1);
        }
        if (INL(2)) { phase_mixers(F0, l); SEAM(pb + 2); }
        if (INL(3)) { phase_combine_transpose(F0, l); if (PROBE == 7) { GRID_BAR(); phase_combine_transpose(F0, l); } SEAM(pb + 3); }
        if (INL(4)) { Frame F = enter(F0);
            const int Mr = last ? ML : MT;
            pg8::PairOrder S; S.S0.init(F.ws + AR_YAN, (const bf16_t*)(F.ws + WS_WBRA) + (size_t)l * DM * DM, Mr, DM, DM, F.G, F.bid);
            S.A1 = (const char*)(F.ws + AR_YB); S.Bt1 = (const char*)((const bf16_t*)(F.ws + WS_WBRB) + (size_t)l * DM * DM);
            EpiMergePair E{(const bf16_t*)(F.ws + AR_GATE), (bf16_t*)(F.ws + AR_M)};
            pg8::gemm_phase(F.lds, F.wave, DM, S, E);
            phase_tail_transposes(F0, l, 0);
            SEAM(pb + 4);
        }
        if (INL(5)) { Frame F = enter(F0);
            const int Mr = last ? ML : MT;
            pg8::StaticOrder S; S.init(F.ws + AR_M, (const bf16_t*)(F.ws + WS_WOUT) + (size_t)l * DM * DM, Mr, DM, DM, F.G, F.bid);
            EpiOut E{(float*)(F.ws + WS_X), (const float*)(F.ws + WS_MOD) + (size_t)l * 5 * 12288};
            pg8::gemm_phase(F.lds, F.wave, DM, S, E);
            phase_tail_transposes(F0, l, 1);
            SEAM(pb + 5);
        }
        if (INL(6)) { phase_normmod2(F0, l); SEAM(pb + 6); }
        const int wslot = (l & 1) ? 2 + (l >> 1) * 8 : (l >> 1);
        if (INL(7)) { Frame F = enter(F0);
            const bf16_t* Wup = (const bf16_t*)(F.ws + WS_WUP) + (size_t)wslot * 2 * DFF * DM;
            EpiUp E{(bf16_t*)(F.ws + AR_ACT)};
            if (l & 1) { moe_tables(F, l);
                pg8::MoeOrder S; S.tab = (const LAS int*)(F.lds + LDS_TAB); S.nN = 44; S.G = F.G; S.c = F.bid; S.rep = (PROBE == 10) ? 2 : 1; S.wgm = WGM_MOE; S.A = (const char*)(F.ws + AR_H2S); S.W = (const char*)Wup;
                S.a_estride = (size_t)CAP * DM * 2; S.a_tstep = (size_t)256 * DM * 2; S.w_estride = (size_t)2 * DFF * DM * 2; S.w_tstep = (size_t)256 * DM * 2; S.a_by_slot = false;
                pg8::gemm_phase(F.lds, F.wave, DM, S, E);
            } else { pg8::StaticOrder S; S.init(F.ws + AR_H, Wup, last ? ML : MT, 2 * DFF, DM, F.G, F.bid, PROBE == 5 ? 2 : 1); pg8::gemm_phase(F.lds, F.wave, DM, S, E); }
            SEAM(pb + 7);
        }
        if (INL(8)) { Frame F = enter(F0);
            const bf16_t* Wdn = (const bf16_t*)(F.ws + WS_WDN) + (size_t)wslot * DM * DFF;
            EpiBf16Plain E{(bf16_t*)(F.ws + AR_YS), DM};
            if (l & 1) { moe_tables(F, l);
                pg8::MoeOrder S; S.tab = (const LAS int*)(F.lds + LDS_TAB); S.nN = 8; S.G = F.G; S.c = F.bid; S.rep = (PROBE == 11) ? 2 : 1; S.wgm = WGM_MOE; S.A = (const char*)(F.ws + AR_ACT); S.W = (const char*)Wdn;
                S.a_estride = 0; S.a_tstep = (size_t)256 * DFF * 2; S.w_estride = (size_t)DM * DFF * 2; S.w_tstep = (size_t)256 * DFF * 2; S.a_by_slot = true;
                pg8::gemm_phase(F.lds, F.wave, DFF, S, E);
            } else { { pg8::StaticOrder S; S.init(F.ws + AR_ACT, Wdn, ML, DM, DFF, F.G, F.bid, PROBE == 6 ? 2 : 1); pg8::gemm_phase(F.lds, F.wave, DFF, S, E); }
                pg8::SplitKOrder S; S.pm0 = 64; S.nN = 8; S.nT = 32; S.S = 4; S.G = F.G; S.c = F.bid; S.A = (const char*)(F.ws + AR_ACT); S.Bt = (const char*)Wdn; S.tstep = (size_t)256 * DFF * 2; S.kbytes = 1408 * 2;
                EpiDownSlab E2{(float*)(F.ws + AR_YSC)};
                pg8::gemm_phase(F.lds, F.wave, 1408, S, E2, DFF); }
            SEAM(pb + 8);
        }
    }
    if (INA(11, N_PHASES - 1)) phase_final(F0);
#undef IN
#undef INA
#undef INL
#undef SEAM
}

extern "C" void kernel_launch(void* const* d_in, const int* in_sizes, int n_in, void* d_out, int out_size, void* d_ws, size_t ws_size, hipStream_t stream) {
    static int grid = 0;
    if (grid == 0) {
        if (n_in != 38 || out_size != ML * DM || ws_size < WS_END) { fprintf(stderr, "kernel_launch: unexpected shapes: n_in %d out %d ws %zu (need %zu)\n", n_in, out_size, ws_size, (size_t)WS_END); grid = -1; return; }
        int dev = 0, cus = 0, per_cu = 0;
        if (hipGetDevice(&dev) != hipSuccess || hipDeviceGetAttribute(&cus, hipDeviceAttributeMultiprocessorCount, dev) != hipSuccess) { grid = -1; return; }
        if (hipFuncSetAttribute((const void*)mega, hipFuncAttributeMaxDynamicSharedMemorySize, LDS_BYTES) != hipSuccess) { fprintf(stderr, "kernel_launch: hipFuncSetAttribute failed\n"); grid = -1; return; }
        if (hipOccupancyMaxActiveBlocksPerMultiprocessor(&per_cu, (const void*)mega, NTHR, LDS_BYTES) != hipSuccess || per_cu < 1) fprintf(stderr, "kernel_launch: occupancy query reports %d\n", per_cu);
        (void)hipGetLastError();
        grid = cus;
    }
    if (grid < 0) return;
    static_assert((CW_CNT + 2 * 8 * 64) * 4 <= 128 * 1024 && (CW_BAR + XCD_BAR_WORDS) * 4 <= 128 * 1024, "control words inside the zeroed region");
    if (hipMemsetAsync((char*)d_ws + WS_CTL, 0, 128 * 1024, stream) != hipSuccess) return;
    Args a{};
    for (int i = 0; i < 38; ++i) a.in[i] = (const float*)d_in[i];
    a.out = (float*)d_out; a.ws = (unsigned char*)d_ws;
#if MK_ONE_LAUNCH
    a.ph_lo = 0; a.ph_hi = N_PHASES;
    hipLaunchKernelGGL(mega, dim3(grid), dim3(NTHR), LDS_BYTES, stream, a);
#else
    for (int p = 0; p < N_PHASES; ++p) { a.ph_lo = p; a.ph_hi = p + 1; hipLaunchKernelGGL(mega, dim3(grid), dim3(NTHR), LDS_BYTES, stream, a); }
#endif
}
```
